# Optimizing an MI355X kernel written in HIP

```python
import jax
import jax.numpy as jnp
from jax import lax
import numpy as np

D_MODEL = 2048
BATCH = 2
SEQ = 4096
DEPTH = 2
DEC_BATCH = 8
DEC_SEQ = 8
PAST_LEN = 16384
PAGE_SIZE = 128

N_EVEN = (DEPTH + 1) // 2
N_ODD = DEPTH // 2
SB_HEADS = 8
SB_HEAD_DIM = 128
SB_WIDTH = SB_HEADS * SB_HEAD_DIM
SB_BLOCK = 128
SB_BIAS_INIT = -6.0
GLA_HEADS = 4
GLA_DK = 128
GLA_DV = 256
GLA_K_WIDTH = GLA_HEADS * GLA_DK
GLA_V_WIDTH = GLA_HEADS * GLA_DV
GLA_GATE_RANK = 16
GLA_GATE_NORMALIZER = 16.0
GLA_CHUNK = 64
GLA_NORM_EPS = 1e-5
EVEN_SPLITS = [SB_WIDTH, 2 * SB_WIDTH, 3 * SB_WIDTH,
               3 * SB_WIDTH + GLA_K_WIDTH, 3 * SB_WIDTH + 2 * GLA_K_WIDTH,
               3 * SB_WIDTH + 2 * GLA_K_WIDTH + GLA_V_WIDTH, 3 * SB_WIDTH + 2 * GLA_K_WIDTH + 2 * GLA_V_WIDTH]
EVEN_IN_WIDTH = 3 * SB_WIDTH + 2 * GLA_K_WIDTH + 2 * GLA_V_WIDTH + GLA_GATE_RANK
EVEN_OUT_WIDTH = SB_WIDTH + GLA_V_WIDTH
RW_HEAD = 64
RW_HEADS = D_MODEL // RW_HEAD
RW_DECAY_RANK = 96
RW_A_RANK = 96
RW_GATE_RANK = 256
RW_LN_EPS = 64e-5
N_MEM = 256
MEM_HEADS = 4
MEM_HEAD_DIM = 128
MEM_WIDTH = MEM_HEADS * MEM_HEAD_DIM
FFN_HIDDEN = 5504
CONV_WIDTH = 3
LN_EPS = 1e-5
DEEPNORM_ALPHA = (2.0 * DEPTH) ** 0.25
DEEPNORM_BETA = (8.0 * DEPTH) ** -0.25

kernel_name = 'hybrid_sb_gla_rwkv7_convffn_decoder_step'


def layer_norm(x, w, b):
    xf = x.astype(jnp.float32)
    mu = jnp.mean(xf, axis=-1, keepdims=True)
    var = jnp.mean(jnp.square(xf - mu), axis=-1, keepdims=True)
    return ((xf - mu) * lax.rsqrt(var + LN_EPS) * w + b).astype(x.dtype)


def stick_breaking(q, k, v, bias, q_pos, k_pos):
    z = jnp.einsum('bthd,bshd->bhts', q, k).astype(jnp.float32) * (SB_HEAD_DIM ** -0.5)
    z = z + bias.astype(jnp.float32)[None, :, None, None]
    vis = k_pos[None, :] < q_pos[:, None]
    log_beta = jax.nn.log_sigmoid(z)
    log_keep = jnp.where(vis, jax.nn.log_sigmoid(-z), 0.0)
    tail = lax.cumsum(log_keep, axis=3, reverse=True) - log_keep
    a = jnp.where(vis, jnp.exp(log_beta + tail), 0.0)
    return jnp.einsum('bhts,bshd->bthd', a.astype(v.dtype), v)


def sb_prompt(q, k, v, bias):
    B, T, H, Dh = q.shape
    n_blk = T // SB_BLOCK
    k_pos = jnp.arange(T)
    q_blocks = q.reshape(B, n_blk, SB_BLOCK, H, Dh).transpose(1, 0, 2, 3, 4)

    def one_block(args):
        q_blk, blk = args
        q_pos = blk * SB_BLOCK + jnp.arange(SB_BLOCK)
        return stick_breaking(q_blk, k, v, bias, q_pos, k_pos)

    out = lax.map(one_block, (q_blocks, jnp.arange(n_blk)))
    return out.transpose(1, 0, 2, 3, 4).reshape(B, T, H, Dh)


def gla_chunked(q, k, v, log_a, s0):
    B, T, H, dk = q.shape
    dv = v.shape[-1]
    C = GLA_CHUNK if T % GLA_CHUNK == 0 else T
    n = T // C
    f32 = jnp.float32
    qc = q.astype(f32).reshape(B, n, C, H, dk) * (dk ** -0.5)
    kc = k.astype(f32).reshape(B, n, C, H, dk)
    vc = v.astype(f32).reshape(B, n, C, H, dv)
    b = jnp.cumsum(log_a.astype(f32).reshape(B, n, C, H, dk), axis=2)
    b_last = b[:, :, -1]
    q_dec = qc * jnp.exp(b)
    scores = jnp.einsum('bnthk,bnshk->bnhts', q_dec, kc * jnp.exp(-b))
    causal = jnp.tril(jnp.ones((C, C), dtype=bool))
    o_intra = jnp.einsum('bnhts,bnshv->bnthv', jnp.where(causal, scores, 0.0), vc)
    d_state = jnp.einsum('bnshk,bnshv->bnhkv', kc * jnp.exp(b_last[:, :, None] - b), vc)
    decay = jnp.exp(b_last)

    def step(S, inp):
        d, ds = inp
        return S * d[..., None] + ds, S

    s_new, s_in = lax.scan(step, s0.astype(f32), (decay.transpose(1, 0, 2, 3), d_state.transpose(1, 0, 2, 3, 4)))
    o_inter = jnp.einsum('bnthk,bnhkv->bnthv', q_dec, s_in.transpose(1, 0, 2, 3, 4))
    return (o_intra + o_inter).reshape(B, T, H, dv), s_new


def even_mixer(x, past_k, past_v, s0, W, j):
    B, T, _ = x.shape
    qa, ka, va, qb, kb, vb, gb, low = jnp.split(x @ W['mx_w_in'][j], EVEN_SPLITS, axis=-1)
    qa = qa.reshape(B, T, SB_HEADS, SB_HEAD_DIM)
    ka = ka.reshape(B, T, SB_HEADS, SB_HEAD_DIM)
    va = va.reshape(B, T, SB_HEADS, SB_HEAD_DIM)
    bias = W['sb_bias'][j]
    if past_k is None:
        oa = sb_prompt(qa, ka, va, bias)
    else:
        P = past_k.shape[1]
        keys = jnp.concatenate([past_k.astype(ka.dtype), ka], axis=1)
        vals = jnp.concatenate([past_v.astype(va.dtype), va], axis=1)
        oa = stick_breaking(qa, keys, vals, bias, P + jnp.arange(T), jnp.arange(P + T))
    log_a = jax.nn.log_sigmoid((low @ W['gla_w_a2'][j] + W['gla_b_a'][j]).astype(jnp.float32)) / GLA_GATE_NORMALIZER
    ob, s_new = gla_chunked(qb.reshape(B, T, GLA_HEADS, GLA_DK), kb.reshape(B, T, GLA_HEADS, GLA_DK),
                            vb.reshape(B, T, GLA_HEADS, GLA_DV), log_a.reshape(B, T, GLA_HEADS, GLA_DK), s0)
    ob = ob * lax.rsqrt(jnp.mean(jnp.square(ob), axis=-1, keepdims=True) + GLA_NORM_EPS) * W['gla_norm_w'][j]
    ob = ob * jax.nn.silu(gb.reshape(B, T, GLA_HEADS, GLA_DV).astype(jnp.float32))
    o = jnp.concatenate([oa.reshape(B, T, SB_WIDTH), ob.reshape(B, T, GLA_V_WIDTH).astype(x.dtype)], axis=-1)
    return o @ W['mx_w_out'][j], ka, va, s_new


def rwkv7_mixer(x, s0, shift0, W, j):
    B, T, D = x.shape
    H, N = RW_HEADS, RW_HEAD
    f32 = jnp.float32
    mix = W['rw_mix'][j]
    x_prev = jnp.concatenate([shift0[:, None, :].astype(x.dtype), x[:, :-1]], axis=1)
    xx = x_prev - x
    xr, xw, xk, xv, xa, xg = [x + xx * mix[m] for m in range(6)]
    w_rkv = W['rw_w_rkv'][j]
    r = (xr @ w_rkv[0]).astype(f32).reshape(B, T, H, N)
    k = (xk @ w_rkv[1]).astype(f32).reshape(B, T, H, N)
    v = (xv @ w_rkv[2]).astype(f32).reshape(B, T, H, N)
    w_log = -jax.nn.softplus(-(W['rw_w0'][j] + jnp.tanh(xw @ W['rw_w1'][j]) @ W['rw_w2'][j]).astype(f32)) - 0.5
    decay = jnp.exp(-jnp.exp(w_log)).reshape(B, T, H, N)
    a = jax.nn.sigmoid((W['rw_a0'][j] + (xa @ W['rw_a1'][j]) @ W['rw_a2'][j]).astype(f32)).reshape(B, T, H, N)
    g = (jax.nn.sigmoid(xg @ W['rw_g1'][j]) @ W['rw_g2'][j]).astype(f32)
    kk = k * W['rw_k_k'][j].reshape(H, N)
    kk = kk * lax.rsqrt(jnp.maximum(jnp.sum(jnp.square(kk), axis=-1, keepdims=True), 1e-24))
    k = k * (1.0 + (a - 1.0) * W['rw_k_a'][j].reshape(H, N))

    def step(S, inp):
        r_t, w_t, k_t, v_t, kk_t, a_t = inp
        sa = jnp.einsum('bhvk,bhk->bhv', S, -kk_t)
        S = S * w_t[:, :, None, :] + sa[..., None] * (kk_t * a_t)[:, :, None, :] + v_t[..., None] * k_t[:, :, None, :]
        return S, jnp.einsum('bhvk,bhk->bhv', S, r_t)

    seq = tuple(t.transpose(1, 0, 2, 3) for t in (r, decay, k, v, kk, a))
    s_new, y = lax.scan(step, s0.astype(f32), seq)
    y = y.transpose(1, 0, 2, 3)
    mu = jnp.mean(y, axis=-1, keepdims=True)
    var = jnp.mean(jnp.square(y - mu), axis=-1, keepdims=True)
    y = ((y - mu) * lax.rsqrt(var + RW_LN_EPS)).reshape(B, T, D) * W['rw_ln_w'][j] + W['rw_ln_b'][j]
    bonus = jnp.sum(r * k * W['rw_r_k'][j], axis=-1, keepdims=True) * v
    out = ((y + bonus.reshape(B, T, D)) * g).astype(x.dtype) @ W['rw_w_o'][j]
    return out, s_new, x[:, -1]


def memory_kv(mem, w_kv):
    B, M, _ = mem.shape
    kv = jnp.einsum('bmd,lde->lbme', mem, w_kv)
    k, v = jnp.split(kv, 2, axis=-1)
    shape = (w_kv.shape[0], B, M, MEM_HEADS, MEM_HEAD_DIM)
    return k.reshape(shape), v.reshape(shape)


def memory_attn(x, mem_k, mem_v, W, i):
    B, T, _ = x.shape
    q = (x @ W['ca_w_q'][i]).reshape(B, T, MEM_HEADS, MEM_HEAD_DIM)
    s = jnp.einsum('bthd,bmhd->bhtm', q, mem_k.astype(q.dtype)).astype(jnp.float32) * (MEM_HEAD_DIM ** -0.5)
    p = jax.nn.softmax(s, axis=-1).astype(x.dtype)
    o = jnp.einsum('bhtm,bmhd->bthd', p, mem_v.astype(x.dtype)).reshape(B, T, MEM_WIDTH)
    return o @ W['ca_w_o'][i]


def conv_ffn(x, conv0, W, i):
    T = x.shape[1]
    u = x @ W['ffn_w_up'][i]
    up = jnp.concatenate([conv0.astype(u.dtype), u], axis=1)
    cw = W['ffn_conv_w'][i]
    c = sum((cw[t] * up[:, t:t + T] for t in range(CONV_WIDTH)), W['ffn_conv_b'][i])
    val, gate = jnp.split(c, 2, axis=-1)
    return (jax.nn.silu(gate) * val) @ W['ffn_w_down'][i], up[:, T:]


def run_trunk(x, mem_k, mem_v, sb_past_k, sb_past_v, gla_s0, rw_s0, rw_shift0, conv0, W):
    new_k, new_v, new_gla, new_rw, new_shift, new_conv = [], [], [], [], [], []
    for i in range(DEPTH):
        j = i // 2
        if i % 2 == 0:
            h, k_rows, v_rows, s = even_mixer(
                x, None if sb_past_k is None else sb_past_k[j], None if sb_past_v is None else sb_past_v[j],
                gla_s0[j], W, j)
            new_k.append(k_rows)
            new_v.append(v_rows)
            new_gla.append(s)
        else:
            h, s, last = rwkv7_mixer(x, rw_s0[j], rw_shift0[j], W, j)
            new_rw.append(s)
            new_shift.append(last)
        x = layer_norm(DEEPNORM_ALPHA * x + h, W['ln_w'][i, 0], W['ln_b'][i, 0])
        x = layer_norm(DEEPNORM_ALPHA * x + memory_attn(x, mem_k[i], mem_v[i], W, i), W['ln_w'][i, 1], W['ln_b'][i, 1])
        h, c = conv_ffn(x, conv0[i], W, i)
        new_conv.append(c)
        x = layer_norm(DEEPNORM_ALPHA * x + h, W['ln_w'][i, 2], W['ln_b'][i, 2])
    return (x, jnp.stack(new_k), jnp.stack(new_v), jnp.stack(new_gla), jnp.stack(new_rw),
            jnp.stack(new_shift), jnp.stack(new_conv))


def setup_inputs(seed: int = 0) -> dict:
    key = jax.random.key(seed)
    keys = jax.random.split(key, 64)
    counter = iter(range(64))
    nrm = lambda shape, scale=1.0: jax.random.normal(keys[next(counter)], shape, jnp.float32) * scale
    uni = lambda shape, lo, hi: jax.random.uniform(keys[next(counter)], shape, jnp.float32, lo, hi)
    n_pages = PAST_LEN // PAGE_SIZE
    n_used = DEC_BATCH * n_pages
    n_phys = n_used + max(1, n_used // 4)
    perm = jax.random.permutation(keys[next(counter)], n_phys)
    page_table = perm[:n_used].reshape(DEC_BATCH, n_pages).astype(jnp.int32)
    F2 = 2 * FFN_HIDDEN
    return {
        'x_prompt': nrm((BATCH, SEQ, D_MODEL)),
        'x_sample': nrm((DEC_BATCH, DEC_SEQ, D_MODEL)),
        'mem_prompt': nrm((BATCH, N_MEM, D_MODEL)),
        'cache_sb_k': nrm((N_EVEN, n_phys, PAGE_SIZE, SB_HEADS, SB_HEAD_DIM)),
        'cache_sb_v': nrm((N_EVEN, n_phys, PAGE_SIZE, SB_HEADS, SB_HEAD_DIM)),
        'page_table': page_table,
        'state_gla': nrm((N_EVEN, DEC_BATCH, GLA_HEADS, GLA_DK, GLA_DV), 0.5),
        'state_rwkv': nrm((N_ODD, DEC_BATCH, RW_HEADS, RW_HEAD, RW_HEAD), 0.5),
        'state_rwkv_shift': nrm((N_ODD, DEC_BATCH, D_MODEL)),
        'state_ffn_conv': nrm((DEPTH, DEC_BATCH, CONV_WIDTH - 1, F2)),
        'cache_mem_k': nrm((DEPTH, DEC_BATCH, N_MEM, MEM_HEADS, MEM_HEAD_DIM)),
        'cache_mem_v': nrm((DEPTH, DEC_BATCH, N_MEM, MEM_HEADS, MEM_HEAD_DIM)),
        'mx_w_in': nrm((N_EVEN, D_MODEL, EVEN_IN_WIDTH), D_MODEL ** -0.5),
        'sb_bias': SB_BIAS_INIT + nrm((N_EVEN, SB_HEADS), 0.3),
        'gla_w_a2': nrm((N_EVEN, GLA_GATE_RANK, GLA_K_WIDTH), GLA_GATE_RANK ** -0.5),
        'gla_b_a': nrm((N_EVEN, GLA_K_WIDTH), 0.1),
        'gla_norm_w': 1.0 + nrm((N_EVEN, GLA_DV), 0.02),
        'mx_w_out': nrm((N_EVEN, EVEN_OUT_WIDTH, D_MODEL), EVEN_OUT_WIDTH ** -0.5 * DEEPNORM_BETA),
        'rw_mix': uni((N_ODD, 6, D_MODEL), 0.0, 1.0),
        'rw_w_rkv': nrm((N_ODD, 3, D_MODEL, D_MODEL), D_MODEL ** -0.5),
        'rw_w0': uni((N_ODD, D_MODEL), -6.5, -1.5),
        'rw_w1': nrm((N_ODD, D_MODEL, RW_DECAY_RANK), D_MODEL ** -0.5),
        'rw_w2': nrm((N_ODD, RW_DECAY_RANK, D_MODEL), 0.1 * RW_DECAY_RANK ** -0.5),
        'rw_a0': nrm((N_ODD, D_MODEL), 0.1),
        'rw_a1': nrm((N_ODD, D_MODEL, RW_A_RANK), D_MODEL ** -0.5),
        'rw_a2': nrm((N_ODD, RW_A_RANK, D_MODEL), RW_A_RANK ** -0.5),
        'rw_g1': nrm((N_ODD, D_MODEL, RW_GATE_RANK), D_MODEL ** -0.5),
        'rw_g2': nrm((N_ODD, RW_GATE_RANK, D_MODEL), RW_GATE_RANK ** -0.5),
        'rw_k_k': 0.85 + nrm((N_ODD, D_MODEL), 0.02),
        'rw_k_a': 1.0 + nrm((N_ODD, D_MODEL), 0.02),
        'rw_r_k': nrm((N_ODD, RW_HEADS, RW_HEAD), 0.1),
        'rw_ln_w': 1.0 + nrm((N_ODD, D_MODEL), 0.02),
        'rw_ln_b': nrm((N_ODD, D_MODEL), 0.02),
        'rw_w_o': nrm((N_ODD, D_MODEL, D_MODEL), D_MODEL ** -0.5 * DEEPNORM_BETA),
        'ca_w_q': nrm((DEPTH, D_MODEL, MEM_WIDTH), D_MODEL ** -0.5),
        'ca_w_kv': nrm((DEPTH, D_MODEL, 2 * MEM_WIDTH), D_MODEL ** -0.5),
        'ca_w_o': nrm((DEPTH, MEM_WIDTH, D_MODEL), MEM_WIDTH ** -0.5 * DEEPNORM_BETA),
        'ffn_w_up': nrm((DEPTH, D_MODEL, F2), D_MODEL ** -0.5),
        'ffn_conv_w': nrm((DEPTH, CONV_WIDTH, F2), CONV_WIDTH ** -0.5),
        'ffn_conv_b': nrm((DEPTH, F2), 0.02),
        'ffn_w_down': nrm((DEPTH, FFN_HIDDEN, D_MODEL), FFN_HIDDEN ** -0.5 * DEEPNORM_BETA),
        'ln_w': 1.0 + nrm((DEPTH, 3, D_MODEL), 0.02),
        'ln_b': nrm((DEPTH, 3, D_MODEL), 0.02),
    }


def reference(x_prompt, x_sample, mem_prompt, cache_sb_k, cache_sb_v, page_table, state_gla, state_rwkv,
              state_rwkv_shift, state_ffn_conv, cache_mem_k, cache_mem_v, mx_w_in, sb_bias, gla_w_a2, gla_b_a,
              gla_norm_w, mx_w_out, rw_mix, rw_w_rkv, rw_w0, rw_w1, rw_w2, rw_a0, rw_a1, rw_a2, rw_g1, rw_g2,
              rw_k_k, rw_k_a, rw_r_k, rw_ln_w, rw_ln_b, rw_w_o, ca_w_q, ca_w_kv, ca_w_o, ffn_w_up, ffn_conv_w,
              ffn_conv_b, ffn_w_down, ln_w, ln_b):
    W = dict(mx_w_in=mx_w_in, sb_bias=sb_bias, gla_w_a2=gla_w_a2, gla_b_a=gla_b_a, gla_norm_w=gla_norm_w,
             mx_w_out=mx_w_out, rw_mix=rw_mix, rw_w_rkv=rw_w_rkv, rw_w0=rw_w0, rw_w1=rw_w1, rw_w2=rw_w2,
             rw_a0=rw_a0, rw_a1=rw_a1, rw_a2=rw_a2, rw_g1=rw_g1, rw_g2=rw_g2, rw_k_k=rw_k_k, rw_k_a=rw_k_a,
             rw_r_k=rw_r_k, rw_ln_w=rw_ln_w, rw_ln_b=rw_ln_b, rw_w_o=rw_w_o, ca_w_q=ca_w_q, ca_w_kv=ca_w_kv,
             ca_w_o=ca_w_o, ffn_w_up=ffn_w_up, ffn_conv_w=ffn_conv_w, ffn_conv_b=ffn_conv_b,
             ffn_w_down=ffn_w_down, ln_w=ln_w, ln_b=ln_b)
    B = x_prompt.shape[0]
    mem_k_p, mem_v_p = memory_kv(mem_prompt, ca_w_kv)
    gla0 = jnp.zeros((N_EVEN, B, GLA_HEADS, GLA_DK, GLA_DV), jnp.float32)
    rw0 = jnp.zeros((N_ODD, B, RW_HEADS, RW_HEAD, RW_HEAD), jnp.float32)
    sh0 = jnp.zeros((N_ODD, B, D_MODEL), x_prompt.dtype)
    cv0 = jnp.zeros((DEPTH, B, CONV_WIDTH - 1, 2 * FFN_HIDDEN), x_prompt.dtype)
    y_prompt, sbk_p, sbv_p, gla_p, rw_p, sh_p, conv_p = run_trunk(
        x_prompt, mem_k_p, mem_v_p, None, None, gla0, rw0, sh0, cv0, W)
    DB = x_sample.shape[0]
    n_even = cache_sb_k.shape[0]
    past_k = cache_sb_k[:, page_table].reshape(n_even, DB, -1, SB_HEADS, SB_HEAD_DIM)
    past_v = cache_sb_v[:, page_table].reshape(n_even, DB, -1, SB_HEADS, SB_HEAD_DIM)
    y_sample, sbk_s, sbv_s, gla_s, rw_s, sh_s, conv_s = run_trunk(
        x_sample, cache_mem_k, cache_mem_v, past_k, past_v, state_gla, state_rwkv, state_rwkv_shift,
        state_ffn_conv, W)
    return (y_prompt, y_sample, sbk_p, sbv_p, gla_p, rw_p, sh_p, conv_p, mem_k_p, mem_v_p,
            sbk_s, sbv_s, gla_s, rw_s, sh_s, conv_s)
```

```cpp
#define MK_CHECK 0
#define MK_FUSED 1
#include <hip/hip_runtime.h>
#include <cstdio>
#include <cstdint>

#define GAS __attribute__((address_space(1)))
#define LAS __attribute__((address_space(3)))
#define DI __device__ __forceinline__
typedef unsigned short bf16;
typedef short bf16x8 __attribute__((ext_vector_type(8)));
typedef short s16x4 __attribute__((ext_vector_type(4)));
typedef float f32x2 __attribute__((ext_vector_type(2)));
typedef float f32x4 __attribute__((ext_vector_type(4)));
typedef float f32x16 __attribute__((ext_vector_type(16)));
typedef unsigned u32x2 __attribute__((ext_vector_type(2)));
typedef unsigned u32x4 __attribute__((ext_vector_type(4)));

constexpr int D = 2048, TP = 4096, BP = 2, MPR = BP * TP;
constexpr int DB = 8, TS = 8, MSR = DB * TS;
constexpr int MR = MPR + MSR;
constexpr int M = MPR + 256;
constexpr int NPAGES = 128, PAGE = 128, PAST = 16384;
constexpr int SBH = 8, HD = 128, SBW = 1024;
constexpr int GH = 4, GDK = 128, GDV = 256, GKW = 512, GVW = 1024, GRANK = 16;
constexpr int NIN = 6144, NIN_FULL = 6160;
constexpr int RWH = 32, RWN = 64;
constexpr int NMEM = 256, MH = 4, MW = 512;
constexpr int FF = 5504, F2 = 11008;
constexpr float LN_EPS = 1e-5f, GLA_EPS = 1e-5f, RW_LN_EPS = 64e-5f;
constexpr float ALPHA = 1.4142135623730951f;
constexpr float LOG2E = 1.4426950408889634f;
constexpr int NUNITS_G = BP * 64 * GH + DB * GH;

constexpr size_t O_YP = 0, O_YS = O_YP + (size_t)MPR * D, O_SBKP = O_YS + (size_t)MSR * D, O_SBVP = O_SBKP + (size_t)MPR * SBW,
    O_GLAP = O_SBVP + (size_t)MPR * SBW, O_RWP = O_GLAP + (size_t)BP * GH * GDK * GDV, O_SHP = O_RWP + (size_t)BP * RWH * 64 * 64, O_CONVP = O_SHP + (size_t)BP * D,
    O_MKP = O_CONVP + (size_t)2 * BP * 2 * F2, O_MVP = O_MKP + (size_t)2 * BP * NMEM * MW, O_SBKS = O_MVP + (size_t)2 * BP * NMEM * MW, O_SBVS = O_SBKS + (size_t)MSR * SBW,
    O_GLAS = O_SBVS + (size_t)MSR * SBW, O_RWS = O_GLAS + (size_t)DB * GH * GDK * GDV, O_SHS = O_RWS + (size_t)DB * RWH * 64 * 64, O_CONVS = O_SHS + (size_t)DB * D,
    O_END = O_CONVS + (size_t)2 * DB * 2 * F2;

constexpr size_t MiB = 1u << 20;
constexpr size_t al(size_t x) { return (x + 255) & ~(size_t)255; }
constexpr size_t WS_CTL = 0, CTL_ZERO_BYTES = 1 * MiB;
constexpr size_t WS_WIN = 2 * MiB;
constexpr size_t WS_WOUT = WS_WIN + al((size_t)NIN * D * 2);
constexpr size_t WS_WRKV = WS_WOUT + al((size_t)D * D * 2);
constexpr size_t WS_WL2 = WS_WRKV + al((size_t)6912 * D * 2);
constexpr size_t WS_WO = WS_WL2 + al((size_t)6144 * 256 * 2);
constexpr size_t WS_WQ = WS_WO + al((size_t)D * D * 2);
constexpr size_t WS_WKV = WS_WQ + al((size_t)2 * MW * D * 2);
constexpr size_t WS_WCO = WS_WKV + al((size_t)2048 * D * 2);
constexpr size_t WS_WUP = WS_WCO + al((size_t)2 * D * MW * 2);
constexpr size_t WS_WDN = WS_WUP + al((size_t)2 * F2 * D * 2);
constexpr size_t WS_XB = WS_WDN + al((size_t)2 * D * FF * 2);
constexpr size_t WS_XF = WS_XB + al((size_t)M * D * 2);
constexpr size_t WS_HPRE = WS_XF + al((size_t)M * D * 4);
constexpr size_t WS_PROJ = WS_HPRE + al((size_t)M * D * 4);
constexpr size_t WS_ATT = WS_PROJ + al((size_t)M * NIN * 2);
constexpr size_t WS_QM = WS_ATT + al((size_t)M * D * 2);
constexpr size_t WS_OM = WS_QM + al((size_t)M * MW * 2);
constexpr size_t WS_MEMB = WS_OM + al((size_t)M * MW * 2);
constexpr size_t WS_MEMKV = WS_MEMB + al((size_t)512 * D * 2);
constexpr size_t WS_CMK = WS_MEMKV + al((size_t)512 * D * 2);
constexpr size_t WS_CMV = WS_CMK + al((size_t)2 * DB * NMEM * MW * 2);
constexpr size_t WS_U = WS_CMV + al((size_t)2 * DB * NMEM * MW * 2);
constexpr size_t WS_ACT = WS_U + al((size_t)M * F2 * 2);
constexpr size_t WS_MIX = WS_ACT + al((size_t)M * FF * 2);
constexpr size_t WS_L1 = WS_MIX + al((size_t)6 * M * D * 2);
constexpr size_t WS_L2 = WS_L1 + al((size_t)M * 768 * 2);
constexpr size_t WS_Y = WS_L2 + al((size_t)3 * M * D * 4);
constexpr size_t WS_BON = WS_Y + al((size_t)M * D * 4);
constexpr size_t WS_LOW = WS_BON + al((size_t)M * D * 4);
constexpr size_t WS_DST = WS_LOW + al((size_t)M * 16 * 4);
constexpr size_t WS_DEC = WS_DST + al((size_t)NUNITS_G * GDV * GDK * 4);
constexpr size_t WS_GO = WS_DEC + al((size_t)NUNITS_G * GDK * 4);
constexpr size_t WS_SIN = WS_GO + al((size_t)M * GVW * 4);
constexpr size_t WS_QD = WS_SIN + al((size_t)NUNITS_G * GDV * GDK * 2);
constexpr size_t WS_PO = WS_QD + al((size_t)M * GKW * 2);
constexpr size_t WS_PL = WS_PO + al((size_t)DB * NPAGES * SBH * TS * HD * 4);
constexpr size_t WS_END = WS_PL + al((size_t)DB * NPAGES * SBH * TS * 4);
constexpr int CW_BAR = 4096;
constexpr int CW_ERR = 16384;
namespace pg8 {
#define PG8_LAS __attribute__((address_space(3)))
typedef unsigned short bf16_t;
typedef short bf16x8 __attribute__((ext_vector_type(8)));
typedef float f32x4 __attribute__((ext_vector_type(4)));
typedef unsigned u32x4 __attribute__((ext_vector_type(4)));
constexpr int BM = 256, BK = 64, HALF = 128, HTB = HALF * BK * 2, STAGE_BYTES = 8 * HTB, NXCD = 8, WGM = 8;
__host__ __device__ __forceinline__ int lds_byte(int r, int c) { const int st = (r >> 4) * 2 + (c >> 5), rr = r & 15, cc = c & 31, ob = rr * 64 + cc * 2; return st * 1024 + (ob ^ (((ob >> 9) & 1) << 5)); }
__host__ __device__ __forceinline__ void stage_rc(int b, int& R, int& C) { const int st = b / 1024, sb = b % 1024, swz = sb ^ (((sb >> 9) & 1) << 5); R = (st >> 1) * 16 + swz / 64; C = (st & 1) * 32 + (swz % 64) / 2; }
__host__ __device__ __forceinline__ int perm32(int rho) { const int n = rho >> 4, i = rho & 15; return 8 * (i >> 2) + 4 * n + (i & 3); }
struct Unit { int pm, pn; };
struct Gemm { const bf16_t* A; const bf16_t* Bt; int M, N, K, lda; };
struct StaticOrder {
    int nM, nN, nwg, G, c;
    __host__ __device__ void init(int M, int N, int G_, int c_) { nM = M / BM; nN = N / BM; nwg = nM * nN; G = G_; c = c_; }
    __host__ __device__ bool next(int i, Unit& u) const {
        const long L = (long)i * G + c; if (L >= nwg) return false;
        int wgid = (int)L; { const int q = nwg / NXCD, r = nwg % NXCD, xcd = wgid % NXCD, off = wgid / NXCD; wgid = (xcd < r ? xcd * (q + 1) : r * (q + 1) + (xcd - r) * q) + off; }
        const int nig = WGM * nN, gid = wgid / nig, fm = gid * WGM, gsz = (nM - fm) < WGM ? (nM - fm) : WGM;
        u.pm = fm + ((wgid % nig) % gsz); u.pn = (wgid % nig) / gsz; return true;
    }
    __device__ __forceinline__ void a_ready(const Unit&) const {}
    __device__ __forceinline__ void done(const Unit&) const {}
    __device__ __forceinline__ size_t a_off(int) const { return 0; }
};
__device__ __forceinline__ unsigned cvt_pk_bf16(float lo, float hi) { unsigned r; asm volatile("v_cvt_pk_bf16_f32 %0, %1, %2" : "=v"(r) : "v"(lo), "v"(hi)); return r; }

template <class F> struct Epi8 {
    static constexpr bool PERM = true, AFTER_DRAIN = false; F f;
    __device__ __forceinline__ void operator()(const f32x4 (&acc)[2][2][4][2], const Unit& u, int wr, int wc, int fr, int fq) const {
        const int row0 = u.pm * BM + wr * 64 + fr, col0 = u.pn * BM + wc * 32 + 8 * fq;
#pragma unroll
        for (int ai = 0; ai < 2; ++ai)
#pragma unroll
            for (int m = 0; m < 4; ++m)
#pragma unroll
                for (int bj = 0; bj < 2; ++bj) f(row0 + ai * HALF + m * 16, col0 + bj * HALF, acc[ai][bj][m][0], acc[ai][bj][m][1], u.pn);
    }
};
template <class F> struct Epi4 {
    static constexpr bool PERM = false, AFTER_DRAIN = false; F f;
    __device__ __forceinline__ void operator()(const f32x4 (&acc)[2][2][4][2], const Unit& u, int wr, int wc, int fr, int fq) const {
        const int row0 = u.pm * BM + wr * 64 + fr, col0 = u.pn * BM + wc * 32 + 4 * fq;
#pragma unroll
        for (int ai = 0; ai < 2; ++ai)
#pragma unroll
            for (int m = 0; m < 4; ++m)
#pragma unroll
                for (int bj = 0; bj < 2; ++bj)
#pragma unroll
                    for (int n = 0; n < 2; ++n) f(row0 + ai * HALF + m * 16, col0 + bj * HALF + n * 16, acc[ai][bj][m][n], u.pn);
    }
};
template <class Epi, class Sched, bool ALIGN_EPI = false, bool SP2 = false>
__device__ __forceinline__ void gemm_phase(PG8_LAS unsigned char* lds, const Gemm g, const Sched& S, const Epi& E, const int tid) {
    const int wid = __builtin_amdgcn_readfirstlane(tid >> 6), lane = tid & 63, wr = wid >> 2, wc = wid & 3, fr = lane & 15, fq = lane >> 4;
    const int K = g.K, nt = K / BK;
    unsigned voffA[2], voffB[2];
#pragma unroll
    for (int i = 0; i < 2; ++i) { int R, C; stage_rc(tid * 16 + i * 8192, R, C); const int Rb = Epi::PERM ? ((R & ~31) + perm32(R & 31)) : R;
        voffA[i] = (unsigned)(R * g.lda + C) * 2u; voffB[i] = (unsigned)(Rb * K + C) * 2u; }
    const size_t kstep = (size_t)(BK * 2);
    const size_t hstepB = (size_t)HALF * K * 2, hstepA = (size_t)HALF * g.lda * 2;
    const size_t tstepB = 2 * hstepB, tstepA = 2 * hstepA;
    const unsigned ldsw = (unsigned)wid * 1024u;
    const int aoff = lds_byte(wr * 64 + fr, fq * 8), boff = lds_byte(wc * 32 + fr, fq * 8);
#define PG8_SA(b, h) (((b) * 2 + (h)) * HTB)
#define PG8_SB(b, h) ((4 + (b) * 2 + (h)) * HTB)
#define PG8_STAGE(bufoff, gbase, voff) do { _Pragma("unroll") for (int _i = 0; _i < 2; ++_i) \
        __builtin_amdgcn_global_load_lds((const unsigned*)((const char*)(gbase) + (voff)[_i]), (PG8_LAS unsigned*)(lds + (bufoff) + ldsw + _i * 8192), 16, 0, 0); } while (0)
#define PG8_LDA(dst, b, h) do { _Pragma("unroll") for (int m = 0; m < 4; ++m) _Pragma("unroll") for (int k = 0; k < 2; ++k) dst[m][k] = *(const PG8_LAS bf16x8*)(lds + PG8_SA(b, h) + aoff + m * 2048 + k * 1024); } while (0)
#define PG8_LDB(dst, b, h) do { _Pragma("unroll") for (int n = 0; n < 2; ++n) _Pragma("unroll") for (int k = 0; k < 2; ++k) dst[n][k] = *(const PG8_LAS bf16x8*)(lds + PG8_SB(b, h) + boff + n * 2048 + k * 1024); } while (0)
#define PG8_MMA(ai, bj, At, Bt) do { __builtin_amdgcn_s_setprio(1); _Pragma("unroll") for (int m = 0; m < 4; ++m) _Pragma("unroll") for (int n = 0; n < 2; ++n) _Pragma("unroll") for (int k = 0; k < 2; ++k) \
        acc[ai][bj][m][n] = __builtin_amdgcn_mfma_f32_16x16x32_bf16(Bt[n][k], At[m][k], acc[ai][bj][m][n], 0, 0, 0); __builtin_amdgcn_s_setprio(0); } while (0)
#define PG8_WAIT_V(n) asm volatile("s_waitcnt vmcnt(" #n ")" ::: "memory")
#define PG8_WAIT_L(n) asm volatile("s_waitcnt lgkmcnt(" #n ")" ::: "memory")
#define PG8_BAR __builtin_amdgcn_s_barrier()
#define PG8_SCHED __builtin_amdgcn_sched_barrier(0)
    Unit cur, nxt; int ui = 0;
    if (!S.next(0, cur)) return;
    f32x4 acc[2][2][4][2];
#pragma unroll
    for (int a = 0; a < 2; ++a)
#pragma unroll
        for (int b = 0; b < 2; ++b)
#pragma unroll
            for (int m = 0; m < 4; ++m)
#pragma unroll
                for (int n = 0; n < 2; ++n) acc[a][b][m][n] = (f32x4){0.f, 0.f, 0.f, 0.f};
    bf16x8 At[4][2], B0[2][2], B1[2][2];
    const char* cA = (const char*)g.A + S.a_off(cur.pn) + (size_t)cur.pm * tstepA; const char* cB = (const char*)g.Bt + (size_t)cur.pn * tstepB;
    S.a_ready(cur);
    if constexpr (SP2) {
        PG8_STAGE(PG8_SB(0, 0), cB, voffB); PG8_STAGE(PG8_SB(0, 1), cB + hstepB, voffB); PG8_STAGE(PG8_SA(0, 0), cA, voffA); PG8_STAGE(PG8_SA(0, 1), cA + hstepA, voffA);
        if (wr == 1) PG8_BAR;
        PG8_WAIT_V(2); PG8_BAR;
        PG8_STAGE(PG8_SB(1, 0), cB + kstep, voffB); PG8_STAGE(PG8_SA(1, 0), cA + kstep, voffA); PG8_STAGE(PG8_SB(1, 1), cB + hstepB + kstep, voffB);
        PG8_WAIT_V(6); PG8_BAR;
    } else {
        PG8_STAGE(PG8_SB(0, 0), cB, voffB); PG8_STAGE(PG8_SA(0, 0), cA, voffA); PG8_STAGE(PG8_SB(0, 1), cB + hstepB, voffB); PG8_STAGE(PG8_SA(0, 1), cA + hstepA, voffA);
        if (wr == 1) PG8_BAR;
        PG8_WAIT_V(4); PG8_BAR;
        PG8_STAGE(PG8_SB(1, 0), cB + kstep, voffB); PG8_STAGE(PG8_SA(1, 0), cA + kstep, voffA); PG8_STAGE(PG8_SB(1, 1), cB + hstepB + kstep, voffB);
        PG8_WAIT_V(6); PG8_BAR;
    }
    for (;;) {
        const bool has_next = S.next(ui + 1, nxt);
        const char* nA = has_next ? (const char*)g.A + S.a_off(nxt.pn) + (size_t)nxt.pm * tstepA : cA; const char* nB = has_next ? (const char*)g.Bt + (size_t)nxt.pn * tstepB : cB;
#pragma nounroll
        for (int t = 0; t < nt; t += 2) {
            const bool last = (t == nt - 2);
            const char* a1 = cA + (size_t)(t + 1) * kstep;
            const char* a2 = last ? nA : cA + (size_t)(t + 2) * kstep; const char* b2 = last ? nB : cB + (size_t)(t + 2) * kstep;
            const char* a3 = a2 + kstep; const char* b3 = b2 + kstep;
            if (last && has_next) S.a_ready(nxt);
            if constexpr (SP2) {
            PG8_LDB(B0, 0, 0); PG8_LDB(B1, 0, 1); PG8_SCHED; PG8_LDA(At, 0, 0); PG8_STAGE(PG8_SA(1, 1), a1 + hstepA, voffA);
            PG8_WAIT_V(8); PG8_WAIT_L(0); PG8_BAR; PG8_MMA(0, 0, At, B0); PG8_MMA(0, 1, At, B1); PG8_BAR; PG8_SCHED;
            PG8_LDA(At, 0, 1); PG8_STAGE(PG8_SB(0, 0), b2, voffB); PG8_STAGE(PG8_SB(0, 1), b2 + hstepB, voffB); PG8_STAGE(PG8_SA(0, 0), a2, voffA);
            PG8_WAIT_V(8); PG8_WAIT_L(0); PG8_BAR; PG8_MMA(1, 0, At, B0); PG8_MMA(1, 1, At, B1); PG8_BAR; PG8_SCHED;
            PG8_LDB(B0, 1, 0); PG8_LDB(B1, 1, 1); PG8_SCHED; PG8_LDA(At, 1, 0); PG8_STAGE(PG8_SA(0, 1), a2 + hstepA, voffA);
            PG8_WAIT_V(8); PG8_WAIT_L(0); PG8_BAR; PG8_MMA(0, 0, At, B0); PG8_MMA(0, 1, At, B1); PG8_BAR; PG8_SCHED;
            PG8_LDA(At, 1, 1); PG8_STAGE(PG8_SB(1, 0), b3, voffB); PG8_STAGE(PG8_SB(1, 1), b3 + hstepB, voffB); PG8_STAGE(PG8_SA(1, 0), a3, voffA);
            PG8_WAIT_V(8); PG8_WAIT_L(0); PG8_BAR; PG8_MMA(1, 0, At, B0); PG8_MMA(1, 1, At, B1); PG8_BAR; PG8_SCHED;
            } else {
            PG8_LDB(B0, 0, 0); PG8_SCHED; PG8_LDA(At, 0, 0); PG8_STAGE(PG8_SA(1, 1), a1 + hstepA, voffA);
            PG8_WAIT_L(8); PG8_BAR; PG8_WAIT_L(0); PG8_MMA(0, 0, At, B0); PG8_BAR; PG8_SCHED;
            PG8_LDB(B1, 0, 1); PG8_STAGE(PG8_SB(0, 0), b2, voffB);
            PG8_BAR; PG8_WAIT_L(0); PG8_MMA(0, 1, At, B1); PG8_BAR;
            PG8_LDA(At, 0, 1); PG8_STAGE(PG8_SA(0, 0), a2, voffA);
            PG8_BAR; PG8_WAIT_L(0); PG8_MMA(1, 0, At, B0); PG8_BAR; PG8_SCHED;
            PG8_STAGE(PG8_SB(0, 1), b2 + hstepB, voffB);
            PG8_WAIT_V(6); PG8_BAR; PG8_MMA(1, 1, At, B1); PG8_BAR;
            PG8_LDB(B0, 1, 0); PG8_SCHED; PG8_LDA(At, 1, 0); PG8_STAGE(PG8_SA(0, 1), a2 + hstepA, voffA);
            PG8_WAIT_L(8); PG8_BAR; PG8_WAIT_L(0); PG8_MMA(0, 0, At, B0); PG8_BAR; PG8_SCHED;
            PG8_LDB(B1, 1, 1); PG8_STAGE(PG8_SB(1, 0), b3, voffB);
            PG8_BAR; PG8_WAIT_L(0); PG8_MMA(0, 1, At, B1); PG8_BAR;
            PG8_LDA(At, 1, 1); PG8_STAGE(PG8_SA(1, 0), a3, voffA);
            PG8_BAR; PG8_WAIT_L(0); PG8_MMA(1, 0, At, B0); PG8_BAR; PG8_SCHED;
            PG8_STAGE(PG8_SB(1, 1), b3 + hstepB, voffB);
            PG8_WAIT_V(6); PG8_BAR; PG8_MMA(1, 1, At, B1); PG8_BAR;
            }
        }
        if constexpr (ALIGN_EPI) { if (wr == 0) PG8_BAR; }
        if constexpr (!Epi::AFTER_DRAIN) { E(acc, cur, wr, wc, fr, fq); S.done(cur); }
        if (!has_next) break;
#pragma unroll
        for (int a = 0; a < 2; ++a)
#pragma unroll
            for (int b = 0; b < 2; ++b)
#pragma unroll
                for (int m = 0; m < 4; ++m)
#pragma unroll
                    for (int n = 0; n < 2; ++n) acc[a][b][m][n] = (f32x4){0.f, 0.f, 0.f, 0.f};
        cur = nxt; cA = nA; cB = nB; ++ui;
        if constexpr (ALIGN_EPI) { if (wr == 1) PG8_BAR; }
    }
    PG8_WAIT_V(0);
    if constexpr (!ALIGN_EPI) { if (wr == 0) PG8_BAR; }
    PG8_BAR;
    if constexpr (Epi::AFTER_DRAIN) { E.fused(acc, cur, wr, wc, fr, fq, lds, wid, lane); S.done(cur); }
#undef PG8_SA
#undef PG8_SB
#undef PG8_STAGE
#undef PG8_LDA
#undef PG8_LDB
#undef PG8_MMA
#undef PG8_WAIT_V
#undef PG8_WAIT_L
#undef PG8_BAR
#undef PG8_SCHED
}}
#define XB_TMO      128
#define XB_XCNT(j)  (256  + 64 * (j))
#define XB_XSUB(j)  (1280 + 64 * (j))
#define XB_XGEN(j)  (2304 + 64 * (j))
#define XB_TOP      3328
#define XB_TOPGEN   3392
#define XCD_BAR_WORDS 3456
#define XB_SPIN_CAP (1u << 18)

__device__ __forceinline__ unsigned xb_ld(unsigned* p)              { return __hip_atomic_load(p, __ATOMIC_RELAXED, __HIP_MEMORY_SCOPE_AGENT); }
__device__ __forceinline__ unsigned xb_add(unsigned* p, unsigned v) { return __hip_atomic_fetch_add(p, v, __ATOMIC_RELAXED, __HIP_MEMORY_SCOPE_AGENT); }
__device__ __forceinline__ unsigned xb_xcc_id() { return (unsigned)__builtin_amdgcn_s_getreg((3 << 11) | 20) & 0xFu; }
#define XB_SPIN(cond, bar) do { unsigned _sp = 0; while (cond) { __builtin_amdgcn_s_sleep(1); \
    if ((++_sp & 255u) == 0u) { if (xb_ld(&(bar)[XB_TMO])) break; if (_sp > XB_SPIN_CAP) { atomicAdd(&(bar)[XB_TMO], 1u); break; } } } } while (0)

struct XcdBarrier {
    unsigned* bar; unsigned x;
    volatile LAS unsigned* st;
};

__device__ __forceinline__ XcdBarrier xcd_barrier_post(unsigned* bar, volatile LAS unsigned* st) {
    XcdBarrier b; b.bar = bar; b.x = xb_xcc_id(); b.st = st;
    if (threadIdx.x == 0) (void)xb_add(&bar[XB_XCNT(b.x)], 1u);
    return b;
}
__device__ __forceinline__ void xcd_barrier_complete(unsigned* bar, unsigned x, unsigned& nloc, unsigned& nx) {
    const unsigned G = gridDim.x * gridDim.y * gridDim.z;
    unsigned sum, cnt, mine, sp = 0u;
    for (;;) {
        sum = 0u; cnt = 0u; mine = 0u;
#pragma unroll
        for (unsigned j = 0; j < 16; ++j) { const unsigned c = xb_ld(&bar[XB_XCNT(j)]); sum += c; cnt += (c > 0u) ? 1u : 0u; mine = (j == x) ? c : mine; }
        if (sum == G) break;
        __builtin_amdgcn_s_sleep(1);
        if ((++sp & 255u) == 0u) { if (xb_ld(&bar[XB_TMO])) break; if (sp > XB_SPIN_CAP) { atomicAdd(&bar[XB_TMO], 1u); break; } }
    }
    nloc = mine > 0u ? mine : 1u; nx = cnt > 0u ? cnt : 1u;
}

__device__ __forceinline__ void xcd_barrier(const XcdBarrier& b) {
    asm volatile("s_waitcnt vmcnt(0)" ::: "memory");
    __syncthreads();
    if (threadIdx.x == 0) {
        unsigned* bar = b.bar;
        __builtin_amdgcn_s_waitcnt(0);
        unsigned nloc = b.st[0], nx = b.st[1];
        if (nloc == 0u) { xcd_barrier_complete(bar, b.x, nloc, nx); b.st[0] = nloc; b.st[1] = nx; }
        const unsigned old = xb_add(&bar[XB_XSUB(b.x)], 1u);
        const unsigned gen = old / nloc;
        if (old + 1u == (gen + 1u) * nloc) {
            __builtin_amdgcn_fence(__ATOMIC_RELEASE, "agent");
            asm volatile("s_waitcnt vmcnt(0)" ::: "memory");
            const unsigned og = xb_add(&bar[XB_TOP], 1u);
            const unsigned tg = og / nx;
            if (og + 1u == (tg + 1u) * nx) xb_add(&bar[XB_TOPGEN], 1u);
            else XB_SPIN(xb_ld(&bar[XB_TOPGEN]) == tg, bar);
            __builtin_amdgcn_fence(__ATOMIC_ACQUIRE, "agent");
            xb_add(&bar[XB_XGEN(b.x)], 1u);
            asm volatile("s_waitcnt vmcnt(0)" ::: "memory");
        } else {
            XB_SPIN(xb_ld(&bar[XB_XGEN(b.x)]) == gen, bar);
            __builtin_amdgcn_fence(__ATOMIC_ACQUIRE, "agent");
            asm volatile("s_waitcnt vmcnt(0)" ::: "memory");
        }
    }
    __syncthreads();
}

extern __shared__ __attribute__((aligned(16))) unsigned char lds_raw[];
constexpr int MISC_OFF = 131072, PTRS_OFF = MISC_OFF + 256, XCH_OFF = MISC_OFF + 1024, LDS_BYTES = 147456;
DI const float* inp(int k) {
    volatile LAS unsigned* P = (volatile LAS unsigned*)((LAS unsigned char*)lds_raw + PTRS_OFF);
    const unsigned lo = __builtin_amdgcn_readfirstlane(P[2 * k]), hi = __builtin_amdgcn_readfirstlane(P[2 * k + 1]);
    return (const float*)(((unsigned long long)hi << 32) | lo);
}
DI int lane_id() { int l; asm volatile("v_mbcnt_lo_u32_b32 %0, -1, 0\n\tv_mbcnt_hi_u32_b32 %0, -1, %0" : "=v"(l)); return l; }
#define LDS_WAIT() asm volatile("s_waitcnt lgkmcnt(0)" ::: "memory")
#define VM_WAIT() asm volatile("s_waitcnt vmcnt(0)" ::: "memory")
DI unsigned pk2(float lo, float hi) { return pg8::cvt_pk_bf16(lo, hi); }
DI float bf2f(unsigned short h) { return __uint_as_float(((unsigned)h) << 16); }
DI float bflo(unsigned w) { return __uint_as_float(w << 16); }
DI float bfhi(unsigned w) { return __uint_as_float(w & 0xffff0000u); }
DI float wave_sum(float v) {
#pragma unroll
    for (int o = 1; o < 64; o <<= 1) v += __shfl_xor(v, o);
    return v;
}
DI float ex2(float x) { return __builtin_amdgcn_exp2f(x); }
DI float lg2(float x) { return __builtin_amdgcn_logf(x); }
DI float rcpf_(float x) { return __builtin_amdgcn_rcpf(x); }
DI float sigmoidf_(float x) { return rcpf_(1.f + ex2(-x * LOG2E)); }
DI float siluf_(float x) { return x * sigmoidf_(x); }
DI float softplusf_(float x) { return fmaxf(x, 0.f) + lg2(1.f + ex2(-fabsf(x) * LOG2E)) * 0.6931471805599453f; }
DI float tanhf_(float x) { const float e = ex2(-2.f * fabsf(x) * LOG2E); const float t = (1.f - e) * rcpf_(1.f + e); return x < 0.f ? -t : t; }

struct TrDesc { const float* W; bf16* WT; int ldw, Kr, Nr, ldt, nblk, start; };
constexpr int NTR = 23;
DI void tr_item(const TrDesc& d, LAS float* scr, int item, int lane) {
    const int kb = item / d.nblk, nb = item % d.nblk, k0 = 64 * kb, n0 = 32 * nb;
    const int n = n0 + (lane & 31);
#pragma unroll 8
    for (int i = 0; i < 32; ++i) { const int kk = 2 * i + (lane >> 5); const int k = k0 + kk;
        scr[kk * 33 + (lane & 31)] = (k < d.Kr && n < d.Nr) ? d.W[(size_t)k * d.ldw + n] : 0.f; }
    LDS_WAIT(); asm volatile("" ::: "memory");
    const int c = lane & 7;
#pragma unroll
    for (int j = 0; j < 4; ++j) { const int nn = (lane >> 3) + 8 * j; const LAS float* s = scr + (8 * c) * 33 + nn;
        u32x4 o; o.x = pk2(s[0 * 33], s[1 * 33]); o.y = pk2(s[2 * 33], s[3 * 33]); o.z = pk2(s[4 * 33], s[5 * 33]); o.w = pk2(s[6 * 33], s[7 * 33]);
        *(GAS u32x4*)(d.WT + (size_t)(n0 + nn) * d.ldt + k0 + 8 * c) = o; }
    LDS_WAIT(); asm volatile("" ::: "memory");
}
DI void row_to_bf16(const float* src, bf16* ob, float* of, int lane) {
    const GAS f32x4* xr = (const GAS f32x4*)src + lane;
    GAS u32x2* o8 = (GAS u32x2*)ob + lane;
#pragma unroll
    for (int j = 0; j < 8; ++j) { const f32x4 v = xr[64 * j]; u32x2 w; w.x = pk2(v.x, v.y); w.y = pk2(v.z, v.w); o8[64 * j] = w;
        if (of) ((GAS f32x4*)of)[lane + 64 * j] = v; }
}
DI void ln_row(const float* src, const float* gw, const float* gb, float* of, bf16* ob, int lane) {
    const GAS f32x4* xr = (const GAS f32x4*)src + lane;
    f32x4 v[8]; float s = 0.f;
#pragma unroll
    for (int j = 0; j < 8; ++j) { v[j] = xr[64 * j]; s += (v[j].x + v[j].y) + (v[j].z + v[j].w); }
    const float mean = wave_sum(s) * (1.f / D); float s2 = 0.f;
#pragma unroll
    for (int j = 0; j < 8; ++j) { v[j] = v[j] - mean; s2 += (v[j].x * v[j].x + v[j].y * v[j].y) + (v[j].z * v[j].z + v[j].w * v[j].w); }
    const float rstd = 1.f / sqrtf(wave_sum(s2) * (1.f / D) + LN_EPS);
#pragma unroll
    for (int j = 0; j < 8; ++j) { const f32x4 g = ((const GAS f32x4*)gw)[lane + 64 * j], b = ((const GAS f32x4*)gb)[lane + 64 * j];
        const f32x4 o = v[j] * rstd * g + b;
        ((GAS f32x4*)of)[lane + 64 * j] = o;
        if (ob) { u32x2 w; w.x = pk2(o.x, o.y); w.y = pk2(o.z, o.w); ((GAS u32x2*)ob)[lane + 64 * j] = w; } }
}
#define KSWZ(row, colB) ((row) * 256 + ((colB) ^ (((row) & 7) << 4)))
#define SBAR() __builtin_amdgcn_sched_barrier(0)
#define MFMA32(a, b, c) __builtin_amdgcn_mfma_f32_32x32x16_bf16((a), (b), (c), 0, 0, 0)
DI int crow(int r, int hi) { return (r & 3) + 8 * (r >> 2) + 4 * hi; }
DI int v_st(int k, int c) { const int kk = (k & ~0xC) | ((k & 4) << 1) | ((k & 8) >> 1); return ((kk >> 3) * 4 + (c >> 5)) * 512 + ((kk & 7) * 32 + (c & 31)) * 2; }
DI int v_rd_base(int lane) { return ((lane & 3) << 3) | (((lane >> 2) & 3) << 6) | (((lane >> 4) & 1) << 5) | (((lane >> 5) & 1) << 8); }
constexpr int v_rd_off(int d0, int ks, int half) { return d0 * 512 + ks * 4096 + half * 2048; }
template <int OFF> DI s16x4 tr_read(unsigned vb) { s16x4 r; asm volatile("ds_read_b64_tr_b16 %0, %1 offset:%2" : "=&v"(r) : "v"(vb), "i"(OFF) : "memory"); return r; }
#define PKLH(L, H) (bf16x8){L[0], L[1], L[2], L[3], H[0], H[1], H[2], H[3]}
template <int D0, int KS> DI bf16x8 tr_frag(unsigned vb) { const s16x4 l = tr_read<v_rd_off(D0, KS, 0)>(vb), h = tr_read<v_rd_off(D0, KS, 1)>(vb); asm volatile("s_waitcnt lgkmcnt(0)" ::: "memory"); SBAR(); return PKLH(l, h); }
template <int D0> DI void pv_one(f32x16& od, unsigned vb, bf16x8 pa0, bf16x8 pa1, bf16x8 pa2, bf16x8 pa3) {
    const s16x4 l0 = tr_read<v_rd_off(D0, 0, 0)>(vb), h0 = tr_read<v_rd_off(D0, 0, 1)>(vb), l1 = tr_read<v_rd_off(D0, 1, 0)>(vb), h1 = tr_read<v_rd_off(D0, 1, 1)>(vb);
    const s16x4 l2 = tr_read<v_rd_off(D0, 2, 0)>(vb), h2 = tr_read<v_rd_off(D0, 2, 1)>(vb), l3 = tr_read<v_rd_off(D0, 3, 0)>(vb), h3 = tr_read<v_rd_off(D0, 3, 1)>(vb);
    asm volatile("s_waitcnt lgkmcnt(0)" ::: "memory"); SBAR();
    od = MFMA32(pa0, PKLH(l0, h0), od); od = MFMA32(pa1, PKLH(l1, h1), od); od = MFMA32(pa2, PKLH(l2, h2), od); od = MFMA32(pa3, PKLH(l3, h3), od);
}
DI void pv_d0(f32x16 (&o)[4], unsigned vb, bf16x8 pa0, bf16x8 pa1, bf16x8 pa2, bf16x8 pa3) {
    pv_one<0>(o[0], vb, pa0, pa1, pa2, pa3); pv_one<1>(o[1], vb, pa0, pa1, pa2, pa3); pv_one<2>(o[2], vb, pa0, pa1, pa2, pa3); pv_one<3>(o[3], vb, pa0, pa1, pa2, pa3);
}
DI void qkt(f32x16& p0, f32x16& p1, const LAS char* Ks, const bf16x8 (&qr)[8], int r32, int hi) {
#pragma unroll
    for (int i = 0; i < 16; ++i) { p0[i] = 0.f; p1[i] = 0.f; }
#pragma unroll
    for (int d0 = 0; d0 < 8; ++d0) { const int cb = (d0 * 16 + hi * 8) * 2;
        const bf16x8 b0 = *(const LAS bf16x8*)(Ks + KSWZ(r32, cb)), b1 = *(const LAS bf16x8*)(Ks + KSWZ(32 + r32, cb));
        p0 = MFMA32(b0, qr[d0], p0); p1 = MFMA32(b1, qr[d0], p1); }
}
#define PK4(P, BASE, OUT) do { unsigned a0_ = pk2(P[BASE + 0], P[BASE + 1]), a1_ = pk2(P[BASE + 2], P[BASE + 3]); \
    unsigned b0_ = pk2(P[BASE + 4], P[BASE + 5]), b1_ = pk2(P[BASE + 6], P[BASE + 7]); \
    auto r0_ = __builtin_amdgcn_permlane32_swap(a0_, b0_, false, false); auto r1_ = __builtin_amdgcn_permlane32_swap(a1_, b1_, false, false); \
    u32x4 w_ = {r0_[0], r1_[0], r0_[1], r1_[1]}; OUT = __builtin_bit_cast(bf16x8, w_); } while (0)
DI float swap_lo(float x, float& hi_out) { auto rr = __builtin_amdgcn_permlane32_swap(__float_as_uint(x), __float_as_uint(x), false, false); hi_out = __uint_as_float(rr[1]); return __uint_as_float(rr[0]); }

struct KVStage { bf16x8 k0, k1, v0, v1; };
DI void kv_load(KVStage& s, const bf16* Kp, const bf16* Vp, size_t ld, int key0, int sr, int sc) {
    s.k0 = *(const GAS bf16x8*)(Kp + (size_t)(key0 + sr) * ld + sc); s.k1 = *(const GAS bf16x8*)(Kp + (size_t)(key0 + 32 + sr) * ld + sc);
    s.v0 = *(const GAS bf16x8*)(Vp + (size_t)(key0 + sr) * ld + sc); s.v1 = *(const GAS bf16x8*)(Vp + (size_t)(key0 + 32 + sr) * ld + sc);
}
DI void kv_write(const KVStage& s, LAS char* Kl, LAS char* Vl, int sr, int sc) {
    *(LAS bf16x8*)(Vl + v_st(sr, sc)) = s.v0; *(LAS bf16x8*)(Vl + v_st(32 + sr, sc)) = s.v1;
    *(LAS bf16x8*)(Kl + KSWZ(sr, sc * 2)) = s.k0; *(LAS bf16x8*)(Kl + KSWZ(32 + sr, sc * 2)) = s.k1;
}

template <bool MASK> DI void sb_half_pre(f32x16& p, float (&l)[16], float C, float bias2, int key0, int tq, int hi) {
#pragma unroll
    for (int r = 0; r < 16; ++r) { const float z = fmaf(p[r], C, bias2); const float e = ex2(z); float ll = lg2(1.f + e); float lb = z - ll;
        if (MASK) { const bool vis = (key0 + crow(r, hi)) < tq; ll = vis ? ll : 0.f; lb = vis ? lb : -1e30f; }
        l[r] = ll; p[r] = lb; }
}
DI void sb_half_fin(f32x16& p, const float (&l)[16], const float (&gbase)[4]) {
#pragma unroll
    for (int g = 0; g < 4; ++g) { float t = gbase[g];
        p[4 * g + 3] = ex2(p[4 * g + 3] - t); t += l[4 * g + 3];
        p[4 * g + 2] = ex2(p[4 * g + 2] - t); t += l[4 * g + 2];
        p[4 * g + 1] = ex2(p[4 * g + 1] - t); t += l[4 * g + 1];
        p[4 * g + 0] = ex2(p[4 * g + 0] - t); }
}
template <bool MASK> DI void sb_half(f32x16& p0, float C, float bias2, float& carry, int key0, int tq, int hi) {
    float l0[16]; sb_half_pre<MASK>(p0, l0, C, bias2, key0, tq, hi);
    float Glo[4], Ghi[4];
#pragma unroll
    for (int g = 0; g < 4; ++g) { const float s0 = (l0[4 * g] + l0[4 * g + 1]) + (l0[4 * g + 2] + l0[4 * g + 3]); Glo[g] = swap_lo(s0, Ghi[g]); }
    float R = carry; float gb[4];
#pragma unroll
    for (int g = 3; g >= 0; --g) { gb[g] = R + (hi == 0 ? Ghi[g] : 0.f); R += Glo[g] + Ghi[g]; }
    carry = R;
    sb_half_fin(p0, l0, gb);
}
template <bool MASK> DI void sb_tile64(f32x16& p0, f32x16& p1, float C, float bias2, float& carry, int key0, int tq, int hi) {
    sb_half<MASK>(p1, C, bias2, carry, key0 + 32, tq, hi); sb_half<MASK>(p0, C, bias2, carry, key0, tq, hi);
}
DI void sb_tile32(f32x16& p0, float C, float bias2, float& carry, int hi) { sb_half<false>(p0, C, bias2, carry, 0, 0, hi); }

DI void sbp_unit(LAS char* lds, const bf16* PROJ, bf16* ATT, float bias, int b, int h, int qb, int tid) {
    const int wid = __builtin_amdgcn_readfirstlane(tid >> 6), lane = tid & 63, r32 = lane & 31, hi = lane >> 5;
    LAS char* Kl[2] = {lds, lds + 16384}; LAS char* Vl[2] = {lds + 32768, lds + 49152};
    const bf16* Qp = PROJ + (size_t)(b * TP) * NIN + h * HD; const bf16* Kp = Qp + SBW; const bf16* Vp = Qp + 2 * SBW;
    const int Q0 = qb * 256, tmin = Q0 + 32 * wid, tq = tmin + r32, tmax = tmin + 31;
    bf16x8 qr[8];
#pragma unroll
    for (int d0 = 0; d0 < 8; ++d0) qr[d0] = *(const GAS bf16x8*)(Qp + (size_t)tq * NIN + d0 * 16 + hi * 8);
    const float C = 0.08838834764831845f * LOG2E, bias2 = bias * LOG2E;
    f32x16 o[4];
#pragma unroll
    for (int d = 0; d < 4; ++d)
#pragma unroll
        for (int i = 0; i < 16; ++i) o[d][i] = 0.f;
    float carry = 0.f;
    const int sr = tid >> 4, sc = (tid & 15) * 8;
    const unsigned vb0 = (unsigned)(uintptr_t)Vl[0] + v_rd_base(lane), vb1 = (unsigned)(uintptr_t)Vl[1] + v_rd_base(lane);
    const int jmax = Q0 / 64 + 3;
    KVStage st; kv_load(st, Kp, Vp, NIN, jmax * 64, sr, sc); kv_write(st, Kl[0], Vl[0], sr, sc); __syncthreads();
    int cur = 0;
    for (int j = jmax; j >= 0; --j) {
        if (j > 0) kv_load(st, Kp, Vp, NIN, (j - 1) * 64, sr, sc);
        if (64 * j < tmax) {
            f32x16 p0, p1; bf16x8 pa0, pa1, pa2, pa3;
            qkt(p0, p1, cur ? Kl[1] : Kl[0], qr, r32, hi);
            if (64 * j + 63 >= tmin) sb_tile64<true>(p0, p1, C, bias2, carry, 64 * j, tq, hi); else sb_tile64<false>(p0, p1, C, bias2, carry, 64 * j, tq, hi);
            PK4(p0, 0, pa0); PK4(p0, 8, pa1); PK4(p1, 0, pa2); PK4(p1, 8, pa3);
            pv_d0(o, cur ? vb1 : vb0, pa0, pa1, pa2, pa3);
        }
        if (j > 0) kv_write(st, cur ? Kl[0] : Kl[1], cur ? Vl[0] : Vl[1], sr, sc);
        __syncthreads();
        cur ^= 1;
    }
    bf16* Ow = ATT + (size_t)(b * TP + tmin) * D + h * HD;
#pragma unroll
    for (int r = 0; r < 16; ++r) { const int orow = crow(r, hi);
#pragma unroll
        for (int d0 = 0; d0 < 4; ++d0) Ow[(size_t)orow * D + d0 * 32 + r32] = (bf16)(pk2(o[d0][r], 0.f) & 0xffffu); }
}

DI void mem_unit(LAS char* lds, LAS float* xch  , const bf16* Qp  , size_t ldq, int nq, const bf16* Kp, const bf16* Vp, size_t ldk, bf16* Op, size_t ldo, int tid) {
    const int wid = __builtin_amdgcn_readfirstlane(tid >> 6), lane = tid & 63, r32 = lane & 31, hi = lane >> 5;
    const int sr = tid >> 4, sc = (tid & 15) * 8;
#pragma unroll
    for (int t = 0; t < 4; ++t) { KVStage st; kv_load(st, Kp, Vp, ldk, t * 64, sr, sc); kv_write(st, lds + t * 16384, lds + 65536 + t * 16384, sr, sc); }
    __syncthreads();
    const int qrow = 32 * wid + r32;
    if (32 * wid < nq) {
        bf16x8 qr[8];
#pragma unroll
        for (int d0 = 0; d0 < 8; ++d0) { bf16x8 z = {0, 0, 0, 0, 0, 0, 0, 0}; qr[d0] = (qrow < nq) ? *(const GAS bf16x8*)(Qp + (size_t)qrow * ldq + d0 * 16 + hi * 8) : z; }
        const float C = 0.08838834764831845f * LOG2E;
        float m = -1e30f;
#pragma unroll
        for (int t = 0; t < 4; ++t) { f32x16 p0, p1; qkt(p0, p1, lds + t * 16384, qr, r32, hi);
#pragma unroll
            for (int r = 0; r < 16; ++r) m = fmaxf(m, fmaxf(p0[r], p1[r])); }
        { float mh; const float ml = swap_lo(m, mh); m = fmaxf(ml, mh); }
        const float mC = -m * C; float l = 0.f;
        f32x16 o[4];
#pragma unroll
        for (int d = 0; d < 4; ++d)
#pragma unroll
            for (int i = 0; i < 16; ++i) o[d][i] = 0.f;
#pragma unroll
        for (int t = 0; t < 4; ++t) { f32x16 p0, p1; bf16x8 pa0, pa1, pa2, pa3; qkt(p0, p1, lds + t * 16384, qr, r32, hi);
#pragma unroll
            for (int r = 0; r < 16; ++r) { p0[r] = ex2(fmaf(p0[r], C, mC)); p1[r] = ex2(fmaf(p1[r], C, mC)); l += p0[r] + p1[r]; }
            PK4(p0, 0, pa0); PK4(p0, 8, pa1); PK4(p1, 0, pa2); PK4(p1, 8, pa3);
            pv_d0(o, (unsigned)(uintptr_t)(lds + 65536 + t * 16384) + v_rd_base(lane), pa0, pa1, pa2, pa3); }
        { float lh; const float ll = swap_lo(l, lh); l = ll + lh; }
        if (hi == 0) xch[r32] = l;
        LDS_WAIT(); asm volatile("" ::: "memory");
#pragma unroll
        for (int r = 0; r < 16; ++r) { const int orow = 32 * wid + crow(r, hi); const float rl = rcpf_(xch[crow(r, hi)]);
            if (orow < nq) {
#pragma unroll
                for (int d0 = 0; d0 < 4; ++d0) Op[(size_t)orow * ldo + d0 * 32 + r32] = (bf16)(pk2(o[d0][r] * rl, 0.f) & 0xffffu); } }
    }
    __syncthreads();
}

DI void sbs_unit(const bf16* PROJ, const float* cK, const float* cV, const int* page_table, float bias, float* PO, float* PL, int db, int pg, int h, int lane) {
    const int r32 = lane & 31, hi = lane >> 5;
    const int phys = page_table[db * NPAGES + pg];
    const float* Kb = cK + (size_t)phys * PAGE * SBW + h * HD; const float* Vb = cV + (size_t)phys * PAGE * SBW + h * HD;
    bf16x8 qr[8];
#pragma unroll
    for (int d0 = 0; d0 < 8; ++d0) { bf16x8 z = {0, 0, 0, 0, 0, 0, 0, 0}; qr[d0] = (r32 < TS) ? *(const GAS bf16x8*)(PROJ + (size_t)(MPR + db * TS + r32) * NIN + h * HD + d0 * 16 + hi * 8) : z; }
    const float C = 0.08838834764831845f * LOG2E, bias2 = bias * LOG2E;
    f32x16 o[4];
#pragma unroll
    for (int d = 0; d < 4; ++d)
#pragma unroll
        for (int i = 0; i < 16; ++i) o[d][i] = 0.f;
    float carry = 0.f;
    for (int blk = 3; blk >= 0; --blk) {
        const int key0 = blk * 32;
        f32x16 p;
#pragma unroll
        for (int i = 0; i < 16; ++i) p[i] = 0.f;
        const GAS float* kr = (const GAS float*)(Kb + (size_t)(key0 + r32) * SBW + 8 * hi);
#pragma unroll
        for (int d0 = 0; d0 < 8; ++d0) { const f32x4 a = *(const GAS f32x4*)(kr + 16 * d0), c = *(const GAS f32x4*)(kr + 16 * d0 + 4);
            u32x4 w = {pk2(a.x, a.y), pk2(a.z, a.w), pk2(c.x, c.y), pk2(c.z, c.w)}; p = MFMA32(__builtin_bit_cast(bf16x8, w), qr[d0], p); }
        sb_tile32(p, C, bias2, carry, hi);
        bf16x8 pa0, pa1; PK4(p, 0, pa0); PK4(p, 8, pa1);
#pragma unroll
        for (int ks = 0; ks < 2; ++ks) {
            const GAS float* vr = (const GAS float*)(Vb + (size_t)(key0 + 16 * ks + 8 * hi) * SBW + r32);
#pragma unroll
            for (int d0 = 0; d0 < 4; ++d0) { float vv[8];
#pragma unroll
                for (int j = 0; j < 8; ++j) vv[j] = vr[(size_t)j * SBW + 32 * d0];
                u32x4 w = {pk2(vv[0], vv[1]), pk2(vv[2], vv[3]), pk2(vv[4], vv[5]), pk2(vv[6], vv[7])};
                o[d0] = MFMA32(ks ? pa1 : pa0, __builtin_bit_cast(bf16x8, w), o[d0]); } }
    }
    const size_t ub = ((size_t)(db * NPAGES + pg) * SBH + h) * TS;
#pragma unroll
    for (int r = 0; r < 4; ++r) { const int q = crow(r, hi);
#pragma unroll
        for (int d0 = 0; d0 < 4; ++d0) PO[(ub + q) * HD + d0 * 32 + r32] = o[d0][r]; }
    if (lane < TS) PL[ub + lane] = carry;
}
DI void sbs_combine(const bf16* PROJ, const float* PO, const float* PL, float bias, bf16* ATT, int db, int h, int q, int lane) {
    const float C = 0.08838834764831845f * LOG2E, bias2 = bias * LOG2E;
    const size_t rowq = (size_t)(MPR + db * TS + q);
    const unsigned qw = *(const GAS unsigned*)(PROJ + rowq * NIN + h * HD + 2 * lane);
    const float q0 = bflo(qw), q1 = bfhi(qw);
    float o0 = 0.f, o1 = 0.f, carry = 0.f;
    for (int s = q - 1; s >= 0; --s) {
        const size_t rows = (size_t)(MPR + db * TS + s);
        const unsigned kw = *(const GAS unsigned*)(PROJ + rows * NIN + SBW + h * HD + 2 * lane), vw = *(const GAS unsigned*)(PROJ + rows * NIN + 2 * SBW + h * HD + 2 * lane);
        const float dot = wave_sum(q0 * bflo(kw) + q1 * bfhi(kw));
        const float z = fmaf(dot, C, bias2), e = ex2(z), ll = lg2(1.f + e), a = ex2(z - ll - carry);
        o0 = fmaf(a, bflo(vw), o0); o1 = fmaf(a, bfhi(vw), o1); carry += ll;
    }
    for (int pg = NPAGES - 1; pg >= 0; --pg) {
        const size_t ub = ((size_t)(db * NPAGES + pg) * SBH + h) * TS + q;
        const f32x2 po = *(const GAS f32x2*)(PO + ub * HD + 2 * lane); const float pl = PL[ub];
        const float sc = ex2(-carry); o0 = fmaf(sc, po.x, o0); o1 = fmaf(sc, po.y, o1); carry += pl;
    }
    *(GAS unsigned*)(ATT + rowq * D + h * HD + 2 * lane) = pk2(o0, o1);
}
DI void gla_decode(int u, int& row0, int& h, int& nvalid) {
    if (u < 512) { const int b = u >> 8, rem = u & 255; h = rem & 3; row0 = b * TP + (rem >> 2) * 64; nvalid = 64; }
    else { const int su = u - 512; h = su & 3; row0 = MPR + (su >> 2) * TS; nvalid = TS; }
}
template <int KS> DI bf16x8 tr_frag_rt(unsigned vb) {
    const s16x4 l = tr_read<v_rd_off(0, KS, 0)>(vb), h = tr_read<v_rd_off(0, KS, 1)>(vb); asm volatile("s_waitcnt lgkmcnt(0)" ::: "memory"); SBAR(); return PKLH(l, h);
}
DI void gla_g1(LAS char* lds, int u, const bf16* PROJ, const float* LOW, const float* w_a2, const float* b_a, float* DST, float* DEC, float* GO, bf16* QDg, int tid) {
    int row0, h, nvalid; gla_decode(u, row0, h, nvalid);
    const int wid = __builtin_amdgcn_readfirstlane(tid >> 6), lane = tid & 63, r32 = lane & 31, hi = lane >> 5;
    LAS float* lowb = (LAS float*)lds; LAS float* gt = (LAS float*)(lds + 4096);
    LAS char* QDt = lds + 8192; LAS char* KDt = lds + 24576; LAS char* KEt = lds + 40960; LAS char* Vt0 = lds + 57344; LAS char* Vt1 = lds + 73728;
    if (tid < 256) { const int t = tid >> 2, j4 = (tid & 3) * 4; f32x4 v = {0.f, 0.f, 0.f, 0.f}; if (t < nvalid) v = *(const GAS f32x4*)(LOW + (size_t)(row0 + t) * 16 + j4); *(LAS f32x4*)(lowb + t * 16 + j4) = v; }
    { const int sr = tid >> 4, sc = (tid & 15) * 8; const bf16x8 z = {0, 0, 0, 0, 0, 0, 0, 0};
#pragma unroll
        for (int rr = 0; rr < 2; ++rr) { const int t = sr + 32 * rr; const bf16* vp = PROJ + (size_t)(row0 + t) * NIN + 4096 + h * GDV + sc;
            const bf16x8 a = (t < nvalid) ? *(const GAS bf16x8*)vp : z, b = (t < nvalid) ? *(const GAS bf16x8*)(vp + 128) : z;
            *(LAS bf16x8*)(Vt0 + v_st(t, sc)) = a; *(LAS bf16x8*)(Vt1 + v_st(t, sc)) = b; } }
    __syncthreads();
    const int c = tid & 127, tg = tid >> 7;
    float cs[16];
    { float wa[16];
#pragma unroll
        for (int j = 0; j < 16; ++j) wa[j] = w_a2[(size_t)j * GKW + h * GDK + c];
        const float ba = b_a[h * GDK + c]; float run = 0.f;
#pragma unroll
        for (int i = 0; i < 16; ++i) { const int t = 16 * tg + i; float pre = ba;
#pragma unroll
            for (int j4 = 0; j4 < 4; ++j4) { const f32x4 lw = *(const LAS f32x4*)(lowb + t * 16 + 4 * j4); pre += lw.x * wa[4 * j4] + lw.y * wa[4 * j4 + 1] + lw.z * wa[4 * j4 + 2] + lw.w * wa[4 * j4 + 3]; }
            const float la = (t < nvalid) ? -softplusf_(-pre) * (1.f / 16.f) : 0.f; run += la; cs[i] = run; }
        gt[tg * 128 + c] = run; }
    __syncthreads();
    { const float g0 = gt[c], g1 = gt[128 + c], g2 = gt[256 + c], g3 = gt[384 + c];
        const float off = (tg > 0 ? g0 : 0.f) + (tg > 1 ? g1 : 0.f) + (tg > 2 ? g2 : 0.f), blast = (g0 + g1) + (g2 + g3);
        if (tg == 0) DEC[(size_t)u * GDK + c] = ex2(blast * LOG2E);
#pragma unroll
        for (int i = 0; i < 16; ++i) { const int t = 16 * tg + i; const float b = cs[i] + off;
            float q = 0.f, k = 0.f;
            if (t < nvalid) { q = bf2f(PROJ[(size_t)(row0 + t) * NIN + 3072 + h * GDK + c]); k = bf2f(PROJ[(size_t)(row0 + t) * NIN + 3584 + h * GDK + c]); }
            const float eb = ex2(b * LOG2E), enb = ex2(-b * LOG2E), ele = ex2((blast - b) * LOG2E);
            const bf16 qd = (bf16)(pk2(q * 0.08838834764831845f * eb, 0.f) & 0xffffu), kd = (bf16)(pk2(k * enb, 0.f) & 0xffffu), ke = (bf16)(pk2(k * ele, 0.f) & 0xffffu);
            *(LAS bf16*)(QDt + KSWZ(t, 2 * c)) = qd; *(LAS bf16*)(KDt + KSWZ(t, 2 * c)) = kd; *(LAS bf16*)(KEt + v_st(t, c)) = ke;
            if (t < nvalid) QDg[(size_t)(row0 + t) * GKW + h * GDK + c] = qd; } }
    __syncthreads();
    if (wid < 4) { const int tblk = wid & 1, vt = wid >> 1;
        bf16x8 qr[8];
#pragma unroll
        for (int d0 = 0; d0 < 8; ++d0) qr[d0] = *(const LAS bf16x8*)(QDt + KSWZ(32 * tblk + r32, (d0 * 16 + hi * 8) * 2));
        f32x16 p0, p1; qkt(p0, p1, KDt, qr, r32, hi);
        const int t = 32 * tblk + r32;
#pragma unroll
        for (int r = 0; r < 16; ++r) { p0[r] = (crow(r, hi) <= t) ? p0[r] : 0.f; p1[r] = (32 + crow(r, hi) <= t) ? p1[r] : 0.f; }
        bf16x8 pa0, pa1, pa2, pa3; PK4(p0, 0, pa0); PK4(p0, 8, pa1); PK4(p1, 0, pa2); PK4(p1, 8, pa3);
        f32x16 o[4];
#pragma unroll
        for (int d = 0; d < 4; ++d)
#pragma unroll
            for (int i = 0; i < 16; ++i) o[d][i] = 0.f;
        pv_d0(o, (unsigned)(uintptr_t)(vt ? Vt1 : Vt0) + v_rd_base(lane), pa0, pa1, pa2, pa3);
#pragma unroll
        for (int r = 0; r < 16; ++r) { const int tt = 32 * tblk + crow(r, hi);
            if (tt < nvalid) {
#pragma unroll
                for (int d0 = 0; d0 < 4; ++d0) GO[(size_t)(row0 + tt) * GVW + h * GDV + 128 * vt + 32 * d0 + r32] = o[d0][r]; } } }
    { const unsigned va = (unsigned)(uintptr_t)((wid >> 2) ? Vt1 : Vt0) + v_rd_base(lane) + 512 * (wid & 3), kb = (unsigned)(uintptr_t)KEt + v_rd_base(lane);
        f32x16 acc[4];
#pragma unroll
        for (int d = 0; d < 4; ++d)
#pragma unroll
            for (int i = 0; i < 16; ++i) acc[d][i] = 0.f;
#define G1_KS(KS) do { const bf16x8 af = tr_frag_rt<KS>(va); \
        { const bf16x8 b0 = tr_frag_rt<KS>(kb), b1 = tr_frag_rt<KS>(kb + 512), b2 = tr_frag_rt<KS>(kb + 1024), b3 = tr_frag_rt<KS>(kb + 1536); \
          acc[0] = MFMA32(af, b0, acc[0]); acc[1] = MFMA32(af, b1, acc[1]); acc[2] = MFMA32(af, b2, acc[2]); acc[3] = MFMA32(af, b3, acc[3]); } } while (0)
        G1_KS(0); G1_KS(1); G1_KS(2); G1_KS(3);
#undef G1_KS
#pragma unroll
        for (int r = 0; r < 16; ++r) { const int dv = 32 * wid + crow(r, hi);
#pragma unroll
            for (int c0 = 0; c0 < 4; ++c0) DST[((size_t)u * GDV + dv) * GDK + 32 * c0 + r32] = acc[c0][r]; } }
    __syncthreads();
}
DI void gla_g2(const float* DST, const float* DEC, bf16* SIN, const float* state_gla, float* gla_p, float* gla_s, int gtid, int nthreads) {
    for (int e = gtid; e < 8 * 16384; e += nthreads) {
        const int chain = e >> 14, pr = e & 16383, idx = pr * 2, b = chain >> 2, h = chain & 3, c = idx & 127, dv = idx >> 7;
        float s0 = 0.f, s1 = 0.f;
        for (int n = 0; n < 64; ++n) { const size_t u = (size_t)b * 256 + n * 4 + h;
            *(GAS unsigned*)(SIN + u * 32768 + idx) = pk2(s0, s1);
            const f32x2 d = *(const GAS f32x2*)(DST + u * 32768 + idx), dc = *(const GAS f32x2*)(DEC + u * GDK + c);
            s0 = fmaf(s0, dc.x, d.x); s1 = fmaf(s1, dc.y, d.y); }
        float* o = gla_p + ((size_t)chain * GDK + c) * GDV + dv; o[0] = s0; o[GDV] = s1;
    }
    for (int e = gtid; e < 32 * 16384; e += nthreads) {
        const int chain = e >> 14, pr = e & 16383, idx = pr * 2, c = idx & 127, dv = idx >> 7; const size_t u = 512 + chain;
        const float* si = state_gla + ((size_t)chain * GDK + c) * GDV + dv;
        float s0 = si[0], s1 = si[GDV];
        *(GAS unsigned*)(SIN + u * 32768 + idx) = pk2(s0, s1);
        const f32x2 d = *(const GAS f32x2*)(DST + u * 32768 + idx), dc = *(const GAS f32x2*)(DEC + u * GDK + c);
        s0 = fmaf(s0, dc.x, d.x); s1 = fmaf(s1, dc.y, d.y);
        float* o = gla_s + ((size_t)chain * GDK + c) * GDV + dv; o[0] = s0; o[GDV] = s1;
    }
}
DI void gla_g3(LAS char* lds, int u, const bf16* PROJ, const bf16* QDg, const bf16* SIN, float* GO, const float* norm_w, bf16* ATT, int tid) {
    int row0, h, nvalid; gla_decode(u, row0, h, nvalid);
    const int wid = __builtin_amdgcn_readfirstlane(tid >> 6), lane = tid & 63, r32 = lane & 31, hi = lane >> 5;
    const int tblk = wid & 1, dq = wid >> 1;
    LAS float* ob = (LAS float*)lds;
    { const int t = 32 * tblk + r32; const bf16x8 z = {0, 0, 0, 0, 0, 0, 0, 0};
        f32x16 acc[2];
#pragma unroll
        for (int d = 0; d < 2; ++d)
#pragma unroll
            for (int i = 0; i < 16; ++i) acc[d][i] = 0.f;
#pragma unroll
        for (int ks = 0; ks < 8; ++ks) {
            const bf16x8 af = (t < nvalid) ? *(const GAS bf16x8*)(QDg + (size_t)(row0 + t) * GKW + h * GDK + 16 * ks + 8 * hi) : z;
#pragma unroll
            for (int nb = 0; nb < 2; ++nb) { const int dv = 64 * dq + 32 * nb + r32;
                const bf16x8 bfr = *(const GAS bf16x8*)(SIN + ((size_t)u * GDV + dv) * GDK + 16 * ks + 8 * hi);
                acc[nb] = MFMA32(af, bfr, acc[nb]); } }
#pragma unroll
        for (int r = 0; r < 16; ++r) { const int tt = 32 * tblk + crow(r, hi);
#pragma unroll
            for (int nb = 0; nb < 2; ++nb) { const int dv = 64 * dq + 32 * nb + r32;
                const float g = (tt < nvalid) ? GO[(size_t)(row0 + tt) * GVW + h * GDV + dv] : 0.f;
                ob[tt * 260 + dv] = acc[nb][r] + g;
#if MK_CHECK
                if (tt < nvalid) GO[(size_t)(row0 + tt) * GVW + h * GDV + dv] = acc[nb][r] + g;
#endif
            } } }
    __syncthreads();
    for (int i = 0; i < 8; ++i) { const int t = 8 * wid + i;
        if (t < nvalid) {
            const f32x4 v = *(const LAS f32x4*)(ob + t * 260 + 4 * lane);
            const float ss = wave_sum((v.x * v.x + v.y * v.y) + (v.z * v.z + v.w * v.w));
            const float rms = 1.f / sqrtf(ss * (1.f / GDV) + GLA_EPS);
            const f32x4 nw = *(const GAS f32x4*)(norm_w + 4 * lane);
            const u32x2 gw = *(const GAS u32x2*)(PROJ + (size_t)(row0 + t) * NIN + 5120 + h * GDV + 4 * lane);
            const float o0 = v.x * rms * nw.x * siluf_(bflo(gw.x)), o1 = v.y * rms * nw.y * siluf_(bfhi(gw.x)), o2 = v.z * rms * nw.z * siluf_(bflo(gw.y)), o3 = v.w * rms * nw.w * siluf_(bfhi(gw.y));
            u32x2 w; w.x = pk2(o0, o1); w.y = pk2(o2, o3);
            *(GAS u32x2*)(ATT + (size_t)(row0 + t) * D + SBW + h * GDV + 4 * lane) = w; } }
    __syncthreads();
}
constexpr int RCH = 16;
DI float dpp_sum16(float x) {
    x += __int_as_float(__builtin_amdgcn_update_dpp(0, __float_as_int(x), 0xB1, 0xF, 0xF, true));
    x += __int_as_float(__builtin_amdgcn_update_dpp(0, __float_as_int(x), 0x4E, 0xF, 0xF, true));
    x += __int_as_float(__builtin_amdgcn_update_dpp(0, __float_as_int(x), 0x141, 0xF, 0xF, true));
    x += __int_as_float(__builtin_amdgcn_update_dpp(0, __float_as_int(x), 0x140, 0xF, 0xF, true));
    return x;
}
struct RwC { const bf16* PROJ; const float* L2; const float *w0, *a0, *k_k, *k_a, *r_k; const float* state_in; float* Y; float* BON; float* rw_p; float* rw_s; };
DI void rwkv_unit(LAS char* lds, int u, const RwC& R, int tid) {
    const int wid = __builtin_amdgcn_readfirstlane(tid >> 6), lane = tid & 63;
    int row0, T, h, qt; const float* s_in = nullptr; float* s_out;
    if (u < 256) { const int b = u >> 7; h = (u >> 2) & 31; qt = u & 3; row0 = b * TP; T = TP; s_out = R.rw_p + (size_t)(b * RWH + h) * 4096; }
    else { const int su = u - 256, db = su >> 7; h = (su >> 2) & 31; qt = su & 3; row0 = MPR + db * TS; T = TS; s_in = R.state_in + (size_t)(db * RWH + h) * 4096; s_out = R.rw_s + (size_t)(db * RWH + h) * 4096; }
    LAS float* inb = (LAS float*)lds;
    LAS float* ybuf = (LAS float*)(lds + 2 * RCH * 6 * 64 * 4);
    const int nch = (T + RCH - 1) / RCH;
    const int hc = h * 64 + lane;
    float c_w0 = 0.f, c_a0 = 0.f, c_kk = 0.f, c_ka = 0.f, c_rk = 0.f;
    if (wid >= 4) { c_w0 = R.w0[hc]; c_a0 = R.a0[hc]; c_kk = R.k_k[hc]; c_ka = R.k_a[hc]; c_rk = R.r_k[hc]; }
    const int vrow = 16 * qt + 4 * wid + (lane >> 4), j4 = (lane & 15) * 4;
    f32x4 S = {0.f, 0.f, 0.f, 0.f};
    if (wid < 4 && s_in) S = *(const GAS f32x4*)(s_in + (size_t)vrow * 64 + j4);
#define RW_STAGE(ci) do { const int t0_ = (ci) * RCH; const int nst_ = (T - t0_) < RCH ? (T - t0_) : RCH; LAS float* ib_ = inb + ((ci) & 1) * (RCH * 6 * 64); \
        for (int tt = wid - 4; tt < nst_; tt += 4) { const size_t row = (size_t)(row0 + t0_ + tt); \
            const float r = bf2f(R.PROJ[row * NIN + hc]), k = bf2f(R.PROJ[row * NIN + 2048 + hc]), v = bf2f(R.PROJ[row * NIN + 4096 + hc]); \
            const float wpre = R.L2[row * 6144 + hc] + c_w0, apre = R.L2[row * 6144 + 2048 + hc] + c_a0; \
            const float wlog = -softplusf_(-wpre) - 0.5f; const float dec = ex2(-ex2(wlog * LOG2E) * LOG2E); \
            const float a = sigmoidf_(apre); float kk = k * c_kk; const float n2 = wave_sum(kk * kk); kk *= 1.f / sqrtf(fmaxf(n2, 1e-24f)); \
            const float k2 = k * (1.f + (a - 1.f) * c_ka); \
            LAS float* o_ = ib_ + tt * 384 + lane; o_[0] = dec; o_[64] = kk; o_[128] = kk * a; o_[192] = k2; o_[256] = r; o_[320] = v; \
            const float bs = wave_sum(r * k2 * c_rk); if (qt == 0) R.BON[row * D + hc] = bs * v; } } while (0)
#define RW_YOUT(ci) do { const int t0_ = (ci) * RCH; const int nst_ = (T - t0_) < RCH ? (T - t0_) : RCH; const LAS float* yb_ = ybuf + ((ci) & 1) * (RCH * 256); \
        for (int idx = (wid - 4) * 64 + lane; idx < nst_ * 16; idx += 256) { const int tt = idx >> 4, rl = idx & 15; const LAS f32x4* p_ = (const LAS f32x4*)(yb_ + idx * 16); \
            const f32x4 a_ = p_[0], b_ = p_[1], c_ = p_[2], d_ = p_[3]; \
            R.Y[(size_t)(row0 + t0_ + tt) * D + h * 64 + 16 * qt + rl] = ((a_.x + a_.y) + (a_.z + a_.w)) + ((b_.x + b_.y) + (b_.z + b_.w)) + ((c_.x + c_.y) + (c_.z + c_.w)) + ((d_.x + d_.y) + (d_.z + d_.w)); } } while (0)
    if (wid >= 4) RW_STAGE(0);
    __syncthreads();
    for (int ci = 0; ci < nch; ++ci) {
        if (wid >= 4) { if (ci + 1 < nch) RW_STAGE(ci + 1); if (ci > 0) RW_YOUT(ci - 1); }
        else { const int t0 = ci * RCH; const int nst = (T - t0) < RCH ? (T - t0) : RCH; const LAS float* ib = inb + (ci & 1) * (RCH * 6 * 64); LAS float* yb = ybuf + (ci & 1) * (RCH * 256);
            for (int tt = 0; tt < nst; ++tt) { const LAS float* p = ib + tt * 384;
                const f32x4 w = *(const LAS f32x4*)(p + j4), kk = *(const LAS f32x4*)(p + 64 + j4), bb = *(const LAS f32x4*)(p + 128 + j4), k2 = *(const LAS f32x4*)(p + 192 + j4), r = *(const LAS f32x4*)(p + 256 + j4);
                const float vv = p[320 + vrow];
                const float sa = -dpp_sum16((S.x * kk.x + S.y * kk.y) + (S.z * kk.z + S.w * kk.w));
                S = S * w + (bb * sa + k2 * vv);
                yb[tt * 256 + wid * 64 + lane] = (S.x * r.x + S.y * r.y) + (S.z * r.z + S.w * r.w); } }
        __syncthreads();
    }
    if (wid >= 4) RW_YOUT(nch - 1);
    else *(GAS f32x4*)(s_out + (size_t)vrow * 64 + j4) = S;
    __syncthreads();
#undef RW_STAGE
#undef RW_YOUT
}
DI void rwkv_post(const float* Y, const float* BON, const float* G  , const float* ln_w, const float* ln_b, bf16* ATT, int gw, int NGW, int lane) {
    for (int it = gw; it < MR * RWH; it += NGW) { const int row = it >> 5, h = it & 31; const size_t o = (size_t)row * D + h * 64 + lane;
        const float y = Y[o]; const float mu = wave_sum(y) * (1.f / 64.f); const float d = y - mu; const float var = wave_sum(d * d) * (1.f / 64.f);
        const float yn = d * (1.f / sqrtf(var + RW_LN_EPS)) * ln_w[h * 64 + lane] + ln_b[h * 64 + lane];
        const float out = (yn + BON[o]) * G[(size_t)row * 6144 + h * 64 + lane];
        ATT[o] = (bf16)(pk2(out, 0.f) & 0xffffu); }
}
DI void rwkv_mix(const float* XF, const float* mix, const float* shift_in, bf16* MIX, float* sh_p, float* sh_s, int gtid, int nthreads) {
    for (int it = gtid; it < MR * (D / 8); it += nthreads) { const int row = it >> 8, c = (it & 255) * 8;
        int t, sq; if (row < MPR) { t = row & (TP - 1); sq = -1; } else { t = (row - MPR) & 7; sq = (row - MPR) >> 3; }
        const f32x4 x0 = *(const GAS f32x4*)(XF + (size_t)row * D + c), x1 = *(const GAS f32x4*)(XF + (size_t)row * D + c + 4);
        f32x4 p0 = {0.f, 0.f, 0.f, 0.f}, p1 = {0.f, 0.f, 0.f, 0.f};
        if (t > 0) { p0 = *(const GAS f32x4*)(XF + (size_t)(row - 1) * D + c); p1 = *(const GAS f32x4*)(XF + (size_t)(row - 1) * D + c + 4); }
        else if (sq >= 0) { p0 = *(const GAS f32x4*)(shift_in + (size_t)sq * D + c); p1 = *(const GAS f32x4*)(shift_in + (size_t)sq * D + c + 4); }
        const f32x4 d0 = p0 - x0, d1 = p1 - x1;
#pragma unroll
        for (int m = 0; m < 6; ++m) { const f32x4 m0 = *(const GAS f32x4*)(mix + (size_t)m * D + c), m1 = *(const GAS f32x4*)(mix + (size_t)m * D + c + 4);
            const f32x4 a = x0 + d0 * m0, b = x1 + d1 * m1; u32x4 w = {pk2(a.x, a.y), pk2(a.z, a.w), pk2(b.x, b.y), pk2(b.z, b.w)};
            *(GAS u32x4*)(MIX + ((size_t)m * M + row) * D + c) = w; }
        if (row < MPR) { if (t == TP - 1) { float* o = sh_p + (size_t)(row >> 12) * D + c; *(GAS f32x4*)o = x0; *(GAS f32x4*)(o + 4) = x1; } }
        else if (t == TS - 1) { float* o = sh_s + (size_t)sq * D + c; *(GAS f32x4*)o = x0; *(GAS f32x4*)(o + 4) = x1; }
    }
}
DI void conv_gate(const bf16* U, const float* cw, const float* cb, const float* conv0_s  , bf16* ACT, int gtid, int nthreads) {
    for (int it = gtid; it < MR * (FF / 8); it += nthreads) { const int row = it / (FF / 8), c = (it % (FF / 8)) * 8;
        int t, sq; if (row < MPR) { t = row & (TP - 1); sq = -1; } else { t = (row - MPR) & 7; sq = (row - MPR) >> 3; }
        float val[8], gat[8];
#pragma unroll
        for (int half = 0; half < 2; ++half) { const int cc = c + half * FF; float acc[8];
            const f32x4 b0 = *(const GAS f32x4*)(cb + cc), b1 = *(const GAS f32x4*)(cb + cc + 4);
            acc[0] = b0.x; acc[1] = b0.y; acc[2] = b0.z; acc[3] = b0.w; acc[4] = b1.x; acc[5] = b1.y; acc[6] = b1.z; acc[7] = b1.w;
#pragma unroll
            for (int tap = 0; tap < 3; ++tap) { const int ts = t - 2 + tap;
                float x[8];
                if (ts >= 0) { const u32x4 w = *(const GAS u32x4*)(U + (size_t)(row - 2 + tap) * F2 + cc);
                    x[0] = bflo(w.x); x[1] = bfhi(w.x); x[2] = bflo(w.y); x[3] = bfhi(w.y); x[4] = bflo(w.z); x[5] = bfhi(w.z); x[6] = bflo(w.w); x[7] = bfhi(w.w); }
                else if (sq >= 0) { const float* s = conv0_s + ((size_t)sq * 2 + (ts + 2)) * F2 + cc; const f32x4 s0 = *(const GAS f32x4*)s, s1 = *(const GAS f32x4*)(s + 4);
                    x[0] = s0.x; x[1] = s0.y; x[2] = s0.z; x[3] = s0.w; x[4] = s1.x; x[5] = s1.y; x[6] = s1.z; x[7] = s1.w; }
                else {
#pragma unroll
                    for (int i = 0; i < 8; ++i) x[i] = 0.f; }
                const f32x4 w0 = *(const GAS f32x4*)(cw + (size_t)tap * F2 + cc), w1 = *(const GAS f32x4*)(cw + (size_t)tap * F2 + cc + 4);
                acc[0] += w0.x * x[0]; acc[1] += w0.y * x[1]; acc[2] += w0.z * x[2]; acc[3] += w0.w * x[3]; acc[4] += w1.x * x[4]; acc[5] += w1.y * x[5]; acc[6] += w1.z * x[6]; acc[7] += w1.w * x[7]; }
#pragma unroll
            for (int i = 0; i < 8; ++i) { if (half == 0) val[i] = acc[i]; else gat[i] = acc[i]; } }
        u32x4 w = {pk2(siluf_(gat[0]) * val[0], siluf_(gat[1]) * val[1]), pk2(siluf_(gat[2]) * val[2], siluf_(gat[3]) * val[3]),
                   pk2(siluf_(gat[4]) * val[4], siluf_(gat[5]) * val[5]), pk2(siluf_(gat[6]) * val[6], siluf_(gat[7]) * val[7])};
        *(GAS u32x4*)(ACT + (size_t)row * FF + c) = w; }
}
#ifndef MK_CHECK
#define MK_CHECK 0
#endif
#if MK_CHECK
DI void chk(unsigned* errs, int id, float got, float ref, float tol) {
    float e = fabsf(got - ref) / tol; if (!(e < 1e30f)) e = 1e30f;
    atomicMax(errs + id, __float_as_uint(e));
}
DI unsigned hsh(unsigned x) { x ^= x >> 16; x *= 0x7feb352dU; x ^= x >> 15; x *= 0x846ca68bU; x ^= x >> 16; return x; }
DI float naive_dot(const bf16* a, const bf16* b, int K) { float s = 0.f; for (int k = 0; k < K; ++k) s += bf2f(a[k]) * bf2f(b[k]); return s; }
DI float bfr(float x) { return bflo(pk2(x, 0.f) & 0xffffu); }
#endif
constexpr int NWAVES = 8, NTHREADS = 512;
constexpr size_t WS_WLOW = WS_END;
constexpr size_t WS_DBG = WS_WLOW + al((size_t)32 * D * 2);
constexpr size_t WS_TOTAL = WS_DBG + 4 * MiB;
struct Args { const float* in[43]; float* out; unsigned char* ws; int ph_lo, ph_hi, fused, pad; };
struct TrRow { int in_idx; long in_off; long ws_off; int ldw, Kr, Nr, ldt, npad; };
__device__ const TrRow TR_TABLE[NTR] = {
    {12, 0, (long)WS_WIN, NIN_FULL, D, NIN, D, NIN},
    {12, NIN, (long)WS_WLOW, NIN_FULL, D, 16, D, 32},
    {17, 0, (long)WS_WOUT, D, D, D, D, D},
    {19, 0, (long)WS_WRKV, D, D, D, D, D}, {19, (long)D * D, (long)(WS_WRKV + (size_t)D * D * 2), D, D, D, D, D}, {19, 2L * D * D, (long)(WS_WRKV + (size_t)2 * D * D * 2), D, D, D, D, D},
    {21, 0, (long)(WS_WRKV + (size_t)6144 * D * 2), 96, D, 96, D, 256}, {24, 0, (long)(WS_WRKV + (size_t)6400 * D * 2), 96, D, 96, D, 256}, {26, 0, (long)(WS_WRKV + (size_t)6656 * D * 2), 256, D, 256, D, 256},
    {22, 0, (long)WS_WL2, D, 96, D, 256, D}, {25, 0, (long)(WS_WL2 + (size_t)2048 * 256 * 2), D, 96, D, 256, D}, {27, 0, (long)(WS_WL2 + (size_t)4096 * 256 * 2), D, 256, D, 256, D},
    {33, 0, (long)WS_WO, D, D, D, D, D},
    {34, 0, (long)WS_WQ, MW, D, MW, D, MW}, {34, (long)D * MW, (long)(WS_WQ + (size_t)MW * D * 2), MW, D, MW, D, MW},
    {35, 0, (long)WS_WKV, 1024, D, 1024, D, 1024}, {35, (long)D * 1024, (long)(WS_WKV + (size_t)1024 * D * 2), 1024, D, 1024, D, 1024},
    {36, 0, (long)WS_WCO, D, MW, D, MW, D}, {36, (long)MW * D, (long)(WS_WCO + (size_t)D * MW * 2), D, MW, D, MW, D},
    {37, 0, (long)WS_WUP, F2, D, F2, D, F2}, {37, (long)D * F2, (long)(WS_WUP + (size_t)F2 * D * 2), F2, D, F2, D, F2},
    {40, 0, (long)WS_WDN, D, FF, D, FF, D}, {40, (long)FF * D, (long)(WS_WDN + (size_t)D * FF * 2), D, FF, D, FF, D},
};
DI int tr_items(int d) { return (TR_TABLE[d].ldt / 64) * (TR_TABLE[d].npad / 32); }
DI TrDesc make_desc(unsigned char* ws, int d) { const TrRow r = TR_TABLE[d]; TrDesc t; t.W = inp(r.in_idx) + r.in_off; t.WT = (bf16*)(ws + r.ws_off); t.ldw = r.ldw; t.Kr = r.Kr; t.Nr = r.Nr; t.ldt = r.ldt; t.nblk = r.npad / 32; t.start = 0; return t; }

struct FInProj { bf16* PROJ; float* out;
    DI void operator()(int row, int col, f32x4 v0, f32x4 v1, int pn) const {
        u32x4 w = {pk2(v0.x, v0.y), pk2(v0.z, v0.w), pk2(v1.x, v1.y), pk2(v1.z, v1.w)};
        *(GAS u32x4*)(PROJ + (size_t)row * NIN + col) = w;
        if (pn >= 4 && pn < 12 && row < MR) { const int kv = col >= 2048; const int cc = col - 1024 - kv * 1024;
            float* o = row < MPR ? out + (kv ? O_SBVP : O_SBKP) + (size_t)row * SBW + cc : out + (kv ? O_SBVS : O_SBKS) + (size_t)(row - MPR) * SBW + cc;
            *(GAS f32x4*)o = v0; *(GAS f32x4*)(o + 4) = v1; } } };
struct FResid { const float* XF; float* HPRE;
    DI void operator()(int row, int col, f32x4 v, int) const { const f32x4 x = *(const GAS f32x4*)(XF + (size_t)row * D + col); *(GAS f32x4*)(HPRE + (size_t)row * D + col) = x * ALPHA + v; } };
struct FBf16 { bf16* O; int ld;
    DI void operator()(int row, int col, f32x4 v0, f32x4 v1, int) const { u32x4 w = {pk2(v0.x, v0.y), pk2(v0.z, v0.w), pk2(v1.x, v1.y), pk2(v1.z, v1.w)}; *(GAS u32x4*)(O + (size_t)row * ld + col) = w; } };
struct FMemKV { bf16* MEMKV; float* out;
    DI void operator()(int row, int col, f32x4 v0, f32x4 v1, int) const { u32x4 w = {pk2(v0.x, v0.y), pk2(v0.z, v0.w), pk2(v1.x, v1.y), pk2(v1.z, v1.w)}; *(GAS u32x4*)(MEMKV + (size_t)row * D + col) = w;
        const int layer = col >> 10, kv = (col >> 9) & 1, cc = col & 511; float* o = out + (kv ? O_MVP : O_MKP) + ((size_t)layer * 512 + row) * MW + cc; *(GAS f32x4*)o = v0; *(GAS f32x4*)(o + 4) = v1; } };
struct FUp { bf16* U; float* out; int layer;
    DI void operator()(int row, int col, f32x4 v0, f32x4 v1, int) const { u32x4 w = {pk2(v0.x, v0.y), pk2(v0.z, v0.w), pk2(v1.x, v1.y), pk2(v1.z, v1.w)}; *(GAS u32x4*)(U + (size_t)row * F2 + col) = w;
        float* o = nullptr;
        if (row < MPR) { const int t = row & (TP - 1); if (t >= TP - 2) o = out + O_CONVP + ((size_t)(layer * BP + (row >> 12)) * 2 + (t - (TP - 2))) * F2 + col; }
        else if (row < MR) { const int t = (row - MPR) & 7; if (t >= TS - 2) o = out + O_CONVS + ((size_t)(layer * DB + ((row - MPR) >> 3)) * 2 + (t - (TS - 2))) * F2 + col; }
        if (o) { *(GAS f32x4*)o = v0; *(GAS f32x4*)(o + 4) = v1; } } };
struct FRkv { bf16* PROJ; bf16* L1;
    DI void operator()(int row, int col, f32x4 v0, f32x4 v1, int pn) const {
        if (pn < 24) { u32x4 w = {pk2(v0.x, v0.y), pk2(v0.z, v0.w), pk2(v1.x, v1.y), pk2(v1.z, v1.w)}; *(GAS u32x4*)(PROJ + (size_t)row * NIN + col) = w; }
        else { float x[8] = {v0.x, v0.y, v0.z, v0.w, v1.x, v1.y, v1.z, v1.w};
#pragma unroll
            for (int i = 0; i < 8; ++i) x[i] = pn == 24 ? tanhf_(x[i]) : (pn == 26 ? sigmoidf_(x[i]) : x[i]);
            u32x4 w = {pk2(x[0], x[1]), pk2(x[2], x[3]), pk2(x[4], x[5]), pk2(x[6], x[7])}; *(GAS u32x4*)(L1 + (size_t)row * 768 + (col - NIN)) = w; } } };
struct FL2 { float* L2;
    DI void operator()(int row, int col, f32x4 v, int) const { *(GAS f32x4*)(L2 + (size_t)row * 6144 + col) = v; } };
struct RkvOrder : pg8::StaticOrder { DI size_t a_off(int pn) const { const int idx = pn < 8 ? 0 : pn < 16 ? 2 : pn < 24 ? 3 : pn == 24 ? 1 : pn == 25 ? 4 : 5; return (size_t)idx * M * D * 2; } };
struct L2Order : pg8::StaticOrder { DI size_t a_off(int pn) const { return (size_t)(pn >> 3) * 256 * 2; } };

DI void low_task(const bf16* XB, const bf16* Wlow_t, float* LOW, int task, int lane) {
    const int fr = lane & 15, fq = lane >> 4; const size_t row = (size_t)task * 16 + fr;
    f32x4 acc = {0.f, 0.f, 0.f, 0.f};
#pragma unroll 8
    for (int ks = 0; ks < 64; ++ks) { const bf16x8 a = *(const GAS bf16x8*)(XB + row * D + 32 * ks + 8 * fq), b = *(const GAS bf16x8*)(Wlow_t + (size_t)fr * D + 32 * ks + 8 * fq);
        acc = __builtin_amdgcn_mfma_f32_16x16x32_bf16(b, a, acc, 0, 0, 0); }
    *(GAS f32x4*)(LOW + row * 16 + 4 * fq) = acc;
}
#if MK_CHECK
struct Ck { unsigned* errs; int gtid, NT, tid, bx, G; LAS char* lds; };
DI void ck_p0(const Ck& k, const Args& a, const bf16* XB, const float* XF, const bf16* MEMB, const bf16* CMK, const bf16* CMV) {
    for (int i = k.gtid; i < NTR * 64; i += k.NT) { const TrDesc d = make_desc(a.ws, i / 64);
        const int n = hsh(i) % (d.nblk * 32), kk = hsh(i + 7777) % d.ldt;
        const float ref = (kk < d.Kr && n < d.Nr) ? bfr(d.W[(size_t)kk * d.ldw + n]) : 0.f;
        chk(k.errs, 10, bf2f(d.WT[(size_t)n * d.ldt + kk]), ref, 1e-6f); }
    for (int i = k.gtid; i < 1024; i += k.NT) { const int row = hsh(i + 11) % MR, col = hsh(i + 13) % D;
        const float src = row < MPR ? inp(0)[(size_t)row * D + col] : inp(1)[(size_t)(row - MPR) * D + col];
        chk(k.errs, 11, bf2f(XB[(size_t)row * D + col]), bfr(src), 1e-6f); chk(k.errs, 11, XF[(size_t)row * D + col], src, 1e-6f);
        const int mr = hsh(i + 17) % 512; chk(k.errs, 11, bf2f(MEMB[(size_t)mr * D + col]), bfr(inp(2)[(size_t)mr * D + col]), 1e-6f);
        const size_t ci = hsh(i + 19) % (2u * DB * NMEM * MW); chk(k.errs, 11, bf2f(CMK[ci]), bfr(inp(10)[ci]), 1e-6f); chk(k.errs, 11, bf2f(CMV[ci]), bfr(inp(11)[ci]), 1e-6f); }
}
DI void ck_p1(const Ck& k, const Args& a, const bf16* XB, const bf16* Win, const bf16* PROJ, const float* LOW) {
    for (int i = k.gtid; i < 2048; i += k.NT) { const int row = (i & 7) ? hsh(i) % MR : MPR + hsh(i) % MSR, col = hsh(i + 5) % NIN;
        const float ref = naive_dot(XB + (size_t)row * D, Win + (size_t)col * D, D);
        chk(k.errs, 12, bf2f(PROJ[(size_t)row * NIN + col]), ref, 0.05f);
        if (col >= 1024 && col < 3072) { const int kv = col >= 2048, cc = col - 1024 - kv * 1024;
            const float o = row < MPR ? a.out[(kv ? O_SBVP : O_SBKP) + (size_t)row * SBW + cc] : a.out[(kv ? O_SBVS : O_SBKS) + (size_t)(row - MPR) * SBW + cc];
            chk(k.errs, 12, o, ref, 0.05f); } }
    for (int i = k.gtid; i < 1024; i += k.NT) { const int row = hsh(i + 3) % MR, j = i & 15; float s = 0.f;
        for (int c = 0; c < D; ++c) s += bf2f(XB[(size_t)row * D + c]) * bfr(inp(12)[(size_t)c * NIN_FULL + NIN + j]);
        chk(k.errs, 13, LOW[(size_t)row * 16 + j], s, 0.05f); }
}
DI void ck_sbp(const Ck& k, const Args& a, const bf16* PROJ, const bf16* ATT) {
    const int tl[12] = {0, 1, 2, 63, 64, 65, 255, 256, 1000, 2047, 3000, 4095};
    LAS float* zb = (LAS float*)k.lds;
    for (int i = k.bx; i < 24; i += k.G) { const int b = i & 1, h = (i * 3) & 7, t = tl[i % 12];
        const bf16* Q = PROJ + (size_t)(b * TP + t) * NIN + h * HD; const float bias = inp(13)[h];
        for (int s = k.tid; s < t; s += NTHREADS) { const float dot = naive_dot(Q, PROJ + (size_t)(b * TP + s) * NIN + SBW + h * HD, HD); zb[s] = (dot * 0.08838834764831845f + bias) * LOG2E; }
        __syncthreads();
        if (k.tid == 0) { float tail = 0.f; for (int s = t - 1; s >= 0; --s) { const float z = zb[s], l = lg2(1.f + ex2(z)); zb[s] = ex2(z - l - tail); tail += l; } }
        __syncthreads();
        if (k.tid < HD) { float o = 0.f; for (int s = 0; s < t; ++s) o += zb[s] * bf2f(PROJ[(size_t)(b * TP + s) * NIN + 2 * SBW + h * HD + k.tid]);
            chk(k.errs, 14, bf2f(ATT[(size_t)(b * TP + t) * D + h * HD + k.tid]), o, 0.02f); }
        __syncthreads(); }
}
DI void ck_sbs(const Ck& k, const Args& a, const bf16* PROJ, const bf16* ATT) {
    LAS float* zb = (LAS float*)k.lds; const int* pt = (const int*)inp(5);
    for (int i = k.bx; i < 16; i += k.G) { const int db = i & 7, h = (i * 5 + 1) & 7, q = (i * 3) & 7;
        const bf16* Q = PROJ + (size_t)(MPR + db * TS + q) * NIN + h * HD; const float bias = inp(13)[h]; const int nk = PAST + q;
        for (int s = k.tid; s < nk; s += NTHREADS) { float dot = 0.f;
            if (s < PAST) { const float* kr = inp(3) + ((size_t)pt[db * NPAGES + (s >> 7)] * PAGE + (s & 127)) * SBW + h * HD; for (int d = 0; d < HD; ++d) dot += bf2f(Q[d]) * bfr(kr[d]); }
            else dot = naive_dot(Q, PROJ + (size_t)(MPR + db * TS + (s - PAST)) * NIN + SBW + h * HD, HD);
            zb[s] = (dot * 0.08838834764831845f + bias) * LOG2E; }
        __syncthreads();
        if (k.tid == 0) { float tail = 0.f; for (int s = nk - 1; s >= 0; --s) { const float z = zb[s], l = lg2(1.f + ex2(z)); zb[s] = ex2(z - l - tail); tail += l; } }
        __syncthreads();
        if (k.tid < HD) { float o = 0.f;
            for (int s = 0; s < nk; ++s) { float v;
                if (s < PAST) v = bfr(inp(4)[((size_t)pt[db * NPAGES + (s >> 7)] * PAGE + (s & 127)) * SBW + h * HD + k.tid]); else v = bf2f(PROJ[(size_t)(MPR + db * TS + (s - PAST)) * NIN + 2 * SBW + h * HD + k.tid]);
                o += zb[s] * v; }
            chk(k.errs, 15, bf2f(ATT[(size_t)(MPR + db * TS + q) * D + h * HD + k.tid]), o, 0.02f); }
        __syncthreads(); }
}
DI void ck_gla(const Ck& k, const Args& a, const bf16* PROJ, const float* LOW, const float* GO) {
    const int wid = k.tid >> 6, lane = k.tid & 63; LAS float* sh = (LAS float*)k.lds + wid * 512;
    for (int i = k.bx * NWAVES + wid; i < 8; i += k.G * NWAVES) {
        int row0, T, h, dvg; float S[128]; const float* s_in = nullptr; const float* s_out;
        if (i < 4) { const int b = i & 1; h = (i * 3) & 3; dvg = (i + 1) & 3; row0 = b * TP; T = TP; s_out = a.out + O_GLAP + (size_t)(b * GH + h) * GDK * GDV; }
        else { const int db = (i * 3) & 7; h = i & 3; dvg = (i + 2) & 3; row0 = MPR + db * TS; T = TS; s_in = inp(6) + (size_t)(db * GH + h) * GDK * GDV; s_out = a.out + O_GLAS + (size_t)(db * GH + h) * GDK * GDV; }
        const int dv = dvg * 64 + lane;
#pragma unroll
        for (int c = 0; c < 128; ++c) S[c] = s_in ? s_in[(size_t)c * GDV + dv] : 0.f;
        for (int t = 0; t < T; ++t) { const size_t row = (size_t)(row0 + t);
#pragma unroll
            for (int cc = 0; cc < 2; ++cc) { const int c = lane + 64 * cc; float pre = inp(15)[h * GDK + c];
                for (int j = 0; j < 16; ++j) pre += LOW[row * 16 + j] * inp(14)[(size_t)j * GKW + h * GDK + c];
                sh[c] = expf(-softplusf_(-pre) * (1.f / 16.f)); sh[128 + c] = bf2f(PROJ[row * NIN + 3072 + h * GDK + c]) * 0.08838834764831845f; sh[256 + c] = bf2f(PROJ[row * NIN + 3584 + h * GDK + c]); }
            LDS_WAIT(); asm volatile("" ::: "memory");
            const float v = bf2f(PROJ[row * NIN + 4096 + h * GDV + dv]); float o = 0.f;
#pragma unroll
            for (int c = 0; c < 128; ++c) { S[c] = S[c] * sh[c] + sh[256 + c] * v; o += sh[128 + c] * S[c]; }
            LDS_WAIT(); asm volatile("" ::: "memory");
            chk(k.errs, 16, GO[row * GVW + h * GDV + dv], o, 1.0f); }
#pragma unroll
        for (int c = 0; c < 128; ++c) chk(k.errs, 17, s_out[(size_t)c * GDV + dv], S[c], 0.3f);
    }
}
DI void ck_gla_norm(const Ck& k, const Args& a, const bf16* PROJ, const float* GO, const bf16* ATT) {
    for (int i = k.gtid; i < 512; i += k.NT) { const int row = (i & 3) ? hsh(i) % MR : MPR + hsh(i) % MSR, h = i & 3, dv = hsh(i + 9) & 255; float ss = 0.f;
        for (int j = 0; j < GDV; ++j) { const float g = GO[(size_t)row * GVW + h * GDV + j]; ss += g * g; }
        const float ref = GO[(size_t)row * GVW + h * GDV + dv] / sqrtf(ss / GDV + GLA_EPS) * inp(16)[dv] * siluf_(bf2f(PROJ[(size_t)row * NIN + 5120 + h * GDV + dv]));
        chk(k.errs, 18, bf2f(ATT[(size_t)row * D + SBW + h * GDV + dv]), ref, 0.03f); }
}
template <class FA, class FG> DI void ck_gemm(const Ck& k, int id, int nrows_lo, int nrows, int N, int K, const bf16* Bt, FA fa, FG fg, float tol, unsigned salt) {
    for (int i = k.gtid; i < 1024; i += k.NT) { const int row = nrows_lo + hsh(i + salt) % nrows, col = hsh(i + salt + 99) % N;
        const float ref = naive_dot(fa(row, col), Bt + (size_t)col * K, K); chk(k.errs, id, fg(row, col, ref), 0.f, tol); }
}
DI void ck_ln(const Ck& k, int id, const float* HPRE, const float* gw, const float* gb, const float* of, size_t ofs_sample_delta_unused) {
    for (int i = k.gtid; i < 512; i += k.NT) { const int row = (i & 3) ? hsh(i + 1) % MR : MPR + hsh(i) % MSR, col = hsh(i + 2) % D; float s = 0.f, s2 = 0.f;
        for (int c = 0; c < D; ++c) s += HPRE[(size_t)row * D + c]; const float mu = s / D;
        for (int c = 0; c < D; ++c) { const float d = HPRE[(size_t)row * D + c] - mu; s2 += d * d; }
        const float ref = (HPRE[(size_t)row * D + col] - mu) / sqrtf(s2 / D + LN_EPS) * gw[col] + gb[col];
        chk(k.errs, id, of[(size_t)row * D + col], ref, 0.01f); }
}
DI void ck_mem(const Ck& k, int id, const bf16* QM, const bf16* MEMKV, const bf16* CMK, const bf16* CMV, const bf16* OM, int L) {
    const int wid = k.tid >> 6, lane = k.tid & 63;
    for (int i = k.bx * NWAVES + wid; i < 64; i += k.G * NWAVES) { const int row = (i & 3) ? hsh(i + 31) % MR : MPR + hsh(i) % MSR, h = i & 3;
        const bf16 *Kp, *Vp; size_t ld;
        if (row < MPR) { Kp = MEMKV + (size_t)((row >> 12) * NMEM) * D + L * 1024 + h * HD; Vp = Kp + 512; ld = D; }
        else { const int db = (row - MPR) >> 3; Kp = CMK + (size_t)((L * DB + db) * NMEM) * MW + h * HD; Vp = CMV + (size_t)((L * DB + db) * NMEM) * MW + h * HD; ld = MW; }
        float s[4], mx = -1e30f;
        for (int j = 0; j < 4; ++j) { s[j] = naive_dot(QM + (size_t)row * MW + h * HD, Kp + (size_t)(lane + 64 * j) * ld, HD) * 0.08838834764831845f; mx = fmaxf(mx, s[j]); }
        for (int o = 1; o < 64; o <<= 1) mx = fmaxf(mx, __shfl_xor(mx, o));
        float den = 0.f; for (int j = 0; j < 4; ++j) { s[j] = expf(s[j] - mx); den += s[j]; } den = wave_sum(den);
        for (int d = 0; d < HD; ++d) { float acc = 0.f; for (int j = 0; j < 4; ++j) acc += bfr(s[j] / den) * bf2f(Vp[(size_t)(lane + 64 * j) * ld + d]); acc = wave_sum(acc);
            if (lane == 0) chk(k.errs, id, bf2f(OM[(size_t)row * MW + h * HD + d]), acc, 0.02f); } }
}
DI void ck_conv(const Ck& k, int id, const Args& a, const bf16* U, const bf16* ACT, int L) {
    for (int i = k.gtid; i < 2048; i += k.NT) { int row = (i & 3) ? hsh(i + 41) % MR : MPR + hsh(i) % MSR; if ((i & 15) == 5) row = (i & 16) ? TP : 1; const int c = hsh(i + 43) % FF;
        int t, sq; if (row < MPR) { t = row & (TP - 1); sq = -1; } else { t = (row - MPR) & 7; sq = (row - MPR) >> 3; }
        float cv[2];
        for (int half = 0; half < 2; ++half) { const int cc = c + half * FF; float acc = inp(39)[(size_t)L * F2 + cc];
            for (int tap = 0; tap < 3; ++tap) { const int ts = t - 2 + tap; float x = 0.f;
                if (ts >= 0) x = bf2f(U[(size_t)(row - 2 + tap) * F2 + cc]); else if (sq >= 0) x = inp(9)[((size_t)(L * DB + sq) * 2 + (ts + 2)) * F2 + cc];
                acc += inp(38)[((size_t)L * 3 + tap) * F2 + cc] * x; }
            cv[half] = acc; }
        chk(k.errs, id, bf2f(ACT[(size_t)row * FF + c]), siluf_(cv[1]) * cv[0], 0.03f); }
}
DI void ck_mix(const Ck& k, const Args& a, const float* XF, const bf16* MIX) {
    for (int i = k.gtid; i < 2048; i += k.NT) { int row = (i & 3) ? hsh(i + 51) % MR : MPR + hsh(i) % MSR; if ((i & 15) == 5) row = (i & 16) ? TP : 0; const int c = hsh(i + 53) % D, m = i % 6;
        int t, sq; if (row < MPR) { t = row & (TP - 1); sq = -1; } else { t = (row - MPR) & 7; sq = (row - MPR) >> 3; }
        const float x = XF[(size_t)row * D + c]; const float xp = t > 0 ? XF[(size_t)(row - 1) * D + c] : (sq >= 0 ? inp(8)[(size_t)sq * D + c] : 0.f);
        chk(k.errs, 28, bf2f(MIX[((size_t)m * M + row) * D + c]), x + (xp - x) * inp(18)[(size_t)m * D + c], 0.02f); }
}
DI void ck_rwkv(const Ck& k, const Args& a, const bf16* PROJ, const float* L2, const float* Y, const float* BON) {
    const int wid = k.tid >> 6, lane = k.tid & 63; LAS float* sh = (LAS float*)k.lds + wid * 512;
    for (int i = k.bx * NWAVES + wid; i < 8; i += k.G * NWAVES) {
        int row0, T, h; const float* s_in = nullptr; const float* s_out;
        if (i < 3) { const int b = i & 1; h = (i * 11 + 5) & 31; row0 = b * TP; T = TP; s_out = a.out + O_RWP + (size_t)(b * RWH + h) * 4096; }
        else { const int db = (i * 3) & 7; h = (i * 7 + 2) & 31; row0 = MPR + db * TS; T = TS; s_in = inp(7) + (size_t)(db * RWH + h) * 4096; s_out = a.out + O_RWS + (size_t)(db * RWH + h) * 4096; }
        const int hc = h * 64 + lane; float S[64];
#pragma unroll
        for (int c = 0; c < 64; ++c) S[c] = s_in ? s_in[(size_t)lane * 64 + c] : 0.f;
        for (int t = 0; t < T; ++t) { const size_t row = (size_t)(row0 + t);
            const float r = bf2f(PROJ[row * NIN + hc]), kx = bf2f(PROJ[row * NIN + 2048 + hc]), v = bf2f(PROJ[row * NIN + 4096 + hc]);
            const float wpre = L2[row * 6144 + hc] + inp(20)[hc], apre = L2[row * 6144 + 2048 + hc] + inp(23)[hc];
            const float wlog = -logf(1.f + expf(-wpre)) - 0.5f, dec = expf(-expf(wlog)), aa = 1.f / (1.f + expf(-apre));
            float kk = kx * inp(28)[hc]; const float n2 = wave_sum(kk * kk); kk = kk / sqrtf(fmaxf(n2, 1e-24f));
            const float k2 = kx * (1.f + (aa - 1.f) * inp(29)[hc]);
            sh[lane] = dec; sh[64 + lane] = kk; sh[128 + lane] = kk * aa; sh[192 + lane] = k2; sh[256 + lane] = r;
            const float bon = wave_sum(r * k2 * inp(30)[hc]) * v;
            LDS_WAIT(); asm volatile("" ::: "memory");
            float sa = 0.f;
#pragma unroll
            for (int c = 0; c < 64; ++c) sa -= S[c] * sh[64 + c];
            float y = 0.f;
#pragma unroll
            for (int c = 0; c < 64; ++c) { S[c] = S[c] * sh[c] + sa * sh[128 + c] + v * sh[192 + c]; y += S[c] * sh[256 + c]; }
            LDS_WAIT(); asm volatile("" ::: "memory");
            chk(k.errs, 31, Y[row * D + hc], y, 0.05f); chk(k.errs, 33, BON[row * D + hc], bon, 0.02f); }
#pragma unroll
        for (int c = 0; c < 64; ++c) chk(k.errs, 32, s_out[(size_t)lane * 64 + c], S[c], 0.05f);
    }
}
DI void ck_post(const Ck& k, const Args& a, const float* Y, const float* BON, const float* G, const bf16* ATT) {
    for (int i = k.gtid; i < 1024; i += k.NT) { const int row = (i & 3) ? hsh(i + 61) % MR : MPR + hsh(i) % MSR, h = hsh(i + 63) & 31, c = hsh(i + 67) & 63; float s = 0.f, s2 = 0.f;
        for (int j = 0; j < 64; ++j) s += Y[(size_t)row * D + h * 64 + j]; const float mu = s / 64.f;
        for (int j = 0; j < 64; ++j) { const float d = Y[(size_t)row * D + h * 64 + j] - mu; s2 += d * d; }
        const size_t o = (size_t)row * D + h * 64 + c;
        const float ref = ((Y[o] - mu) / sqrtf(s2 / 64.f + RW_LN_EPS) * inp(31)[h * 64 + c] + inp(32)[h * 64 + c] + BON[o]) * G[(size_t)row * 6144 + h * 64 + c];
        chk(k.errs, 34, bf2f(ATT[o]), ref, 0.03f); }
}
#endif
#define PG8_SP2 true
#define PG8_ALIGN true
__global__ void __launch_bounds__(NTHREADS, 2) fwd(Args a) {
    LAS unsigned char* ldsu = (LAS unsigned char*)lds_raw; LAS char* lds = (LAS char*)lds_raw;
    const int wave0 = __builtin_amdgcn_readfirstlane((int)threadIdx.x >> 6);
    const int G = gridDim.x, bx = blockIdx.x, NGW = G * NWAVES, NT = G * NTHREADS;
#define PHV unsigned char* ws = ws_top; float* out = out_top; asm volatile("" : "+s"(ws), "+s"(out)); int tid = wave0 * 64 + lane_id(); const int lane = tid & 63, wave = __builtin_amdgcn_readfirstlane(tid >> 6), gw = bx * NWAVES + wave, gtid = bx * NTHREADS + tid; (void)lane; (void)gw; (void)gtid; (void)ws; (void)out
    volatile LAS unsigned* MISC = (volatile LAS unsigned*)(ldsu + MISC_OFF);
    if (threadIdx.x < 64) MISC[threadIdx.x] = 0u;
    if (threadIdx.x == 0) { volatile LAS unsigned long long* P = (volatile LAS unsigned long long*)(ldsu + PTRS_OFF);
#pragma unroll
        for (int i = 0; i < 43; ++i) P[i] = (unsigned long long)a.in[i]; }
    __syncthreads();
    unsigned char* const ws_top = a.ws; unsigned* ctl = (unsigned*)(ws_top + WS_CTL);
    XcdBarrier bar; bar.bar = ctl + CW_BAR; bar.x = 0; bar.st = nullptr;
    if (a.fused) bar = xcd_barrier_post(ctl + CW_BAR, MISC + 8);
    const int lo = a.ph_lo, hi = a.ph_hi;
#ifndef MK_ONLY
#define MK_ONLY -1
#endif
#define IN(k) ((MK_ONLY < 0 || (k) == MK_ONLY) && lo <= (k) && (k) < hi)
#define INL(kb) ((MK_ONLY < 0 || (kb) == MK_ONLY) && lo <= (kb) + pb && (kb) + pb < hi)
#define SEAM(k) do { if (lo <= (k) && (k) + 1 < hi) xcd_barrier(bar); } while (0)
#define W_in ((bf16*)(ws + WS_WIN))
#define W_out ((bf16*)(ws + WS_WOUT))
#define W_rkv ((bf16*)(ws + WS_WRKV))
#define W_l2 ((bf16*)(ws + WS_WL2))
#define W_o ((bf16*)(ws + WS_WO))
#define W_q ((bf16*)(ws + WS_WQ))
#define W_kv ((bf16*)(ws + WS_WKV))
#define W_co ((bf16*)(ws + WS_WCO))
#define W_up ((bf16*)(ws + WS_WUP))
#define W_dn ((bf16*)(ws + WS_WDN))
#define W_low ((bf16*)(ws + WS_WLOW))
#define XB ((bf16*)(ws + WS_XB))
#define XF ((float*)(ws + WS_XF))
#define HPRE ((float*)(ws + WS_HPRE))
#define PROJ ((bf16*)(ws + WS_PROJ))
#define ATT ((bf16*)(ws + WS_ATT))
#define QM ((bf16*)(ws + WS_QM))
#define OM ((bf16*)(ws + WS_OM))
#define MEMB ((bf16*)(ws + WS_MEMB))
#define MEMKV ((bf16*)(ws + WS_MEMKV))
#define CMK ((bf16*)(ws + WS_CMK))
#define CMV ((bf16*)(ws + WS_CMV))
#define U ((bf16*)(ws + WS_U))
#define ACT ((bf16*)(ws + WS_ACT))
#define MIX ((bf16*)(ws + WS_MIX))
#define L1 ((bf16*)(ws + WS_L1))
#define L2 ((float*)(ws + WS_L2))
#define Y ((float*)(ws + WS_Y))
#define BON ((float*)(ws + WS_BON))
#define LOW ((float*)(ws + WS_LOW))
#define DST ((float*)(ws + WS_DST))
#define DEC ((float*)(ws + WS_DEC))
#define GO ((float*)(ws + WS_GO))
#define SIN ((bf16*)(ws + WS_SIN))
#define QDg ((bf16*)(ws + WS_QD))
#define PO ((float*)(ws + WS_PO))
#define PL ((float*)(ws + WS_PL))
    float* const out_top = a.out;
#if MK_CHECK
#define CK(k, stmt) do { if (IN(100 + (k))) { PHV; Ck ck{ctl + CW_ERR, gtid, NT, tid, bx, G, lds}; stmt; } } while (0)
#else
#define CK(k, stmt) do { } while (0)
#endif

    if (IN(0)) { PHV;
        LAS float* scr = (LAS float*)(lds + wave * 16384);
        { int base = 0;
            for (int d = 0; d < NTR; ++d) { const int ni = tr_items(d); const TrDesc td = make_desc(ws, d);
                for (int it = gw; it < ni; it += NGW) tr_item(td, scr, it, lane);
                base += ni; } }
        for (int row = gw; row < MR; row += NGW) row_to_bf16(row < MPR ? inp(0) + (size_t)row * D : inp(1) + (size_t)(row - MPR) * D, XB + (size_t)row * D, XF + (size_t)row * D, lane);
        for (int row = gw; row < 512; row += NGW) row_to_bf16(inp(2) + (size_t)row * D, MEMB + (size_t)row * D, nullptr, lane);
        for (int i = gtid; i < 2 * DB * NMEM * MW / 8; i += NT) { const f32x4 k0 = *(const GAS f32x4*)(inp(10) + (size_t)i * 8), k1 = *(const GAS f32x4*)(inp(10) + (size_t)i * 8 + 4);
            const f32x4 v0 = *(const GAS f32x4*)(inp(11) + (size_t)i * 8), v1 = *(const GAS f32x4*)(inp(11) + (size_t)i * 8 + 4);
            u32x4 wk = {pk2(k0.x, k0.y), pk2(k0.z, k0.w), pk2(k1.x, k1.y), pk2(k1.z, k1.w)}, wv = {pk2(v0.x, v0.y), pk2(v0.z, v0.w), pk2(v1.x, v1.y), pk2(v1.z, v1.w)};
            *(GAS u32x4*)(CMK + (size_t)i * 8) = wk; *(GAS u32x4*)(CMV + (size_t)i * 8) = wv; }
    }
    SEAM(0);
    CK(0, ck_p0(ck, a, XB, XF, MEMB, CMK, CMV));

    for (int L = 0; L < 2; ++L) {
        const int pb = 15 * L;
        if (L == 0) {
            if (IN(1)) { PHV;
                pg8::Gemm g{XB, W_in, M, NIN, D, D}; pg8::StaticOrder S; S.init(M, NIN, G, bx);
                pg8::Epi8<FInProj> E{FInProj{PROJ, out}};
                pg8::gemm_phase<pg8::Epi8<FInProj>, pg8::StaticOrder, PG8_ALIGN, PG8_SP2>(ldsu, g, S, E, tid);
                for (int t = gw; t < MR / 16; t += NGW) low_task(XB, W_low, LOW, t, lane);
            }
            SEAM(1);
            CK(1, ck_p1(ck, a, XB, W_in, PROJ, LOW));
            if (IN(2)) { PHV;
#ifndef NO_SBS
                for (int i = bx; i < DB * NPAGES; i += G) sbs_unit(PROJ, inp(3), inp(4), (const int*)inp(5), inp(13)[wave], PO, PL, i >> 7, i & 127, wave, lane);
#endif
                const int half = G / 2;
#ifndef NO_SBP
                if (bx < half) { for (int p = bx; p < 128; p += half) { const int bh = p >> 3, s = p & 7;
                        sbp_unit(lds, PROJ, ATT, inp(13)[bh & 7], bh >> 3, bh & 7, s, tid); sbp_unit(lds, PROJ, ATT, inp(13)[bh & 7], bh >> 3, bh & 7, 15 - s, tid); } }
#endif
#ifndef NO_G1
                if (bx >= half) { for (int u = bx - half; u < NUNITS_G; u += G - half) gla_g1(lds, u, PROJ, LOW, inp(14), inp(15), DST, DEC, GO, QDg, tid); }
#endif
            }
            SEAM(2);
            if (IN(3)) { PHV;
                gla_g2(DST, DEC, SIN, inp(6), out + O_GLAP, out + O_GLAS, gtid, NT);
                for (int i = gw; i < DB * SBH * TS; i += NGW) sbs_combine(PROJ, PO, PL, inp(13)[(i >> 3) & 7], ATT, i >> 6, (i >> 3) & 7, i & 7, lane);
            }
            SEAM(3);
            CK(3, ck_sbp(ck, a, PROJ, ATT)); CK(3, ck_sbs(ck, a, PROJ, ATT));
            if (IN(4)) { PHV; for (int u = bx; u < NUNITS_G; u += G) gla_g3(lds, u, PROJ, QDg, SIN, GO, inp(16), ATT, tid); }
            SEAM(4);
            CK(4, ck_gla(ck, a, PROJ, LOW, GO)); CK(4, ck_gla_norm(ck, a, PROJ, GO, ATT));
        } else {
            if (IN(15)) { PHV; rwkv_mix(XF, inp(18), inp(8), MIX, out + O_SHP, out + O_SHS, gtid, NT); }
            SEAM(15);
            CK(15, ck_mix(ck, a, XF, MIX));
            if (IN(16)) { PHV;
                pg8::Gemm g{MIX, W_rkv, M, 6912, D, D}; RkvOrder S; S.init(M, 6912, G, bx);
                pg8::Epi8<FRkv> E{FRkv{PROJ, L1}};
                pg8::gemm_phase<pg8::Epi8<FRkv>, RkvOrder, PG8_ALIGN, PG8_SP2>(ldsu, g, S, E, tid);
            }
            SEAM(16);
            CK(16, ck_gemm(ck, 29, 0, MR, 6912, D, W_rkv, [&](int r, int c) { const int pn = c >> 8; const int idx = pn < 8 ? 0 : pn < 16 ? 2 : pn < 24 ? 3 : pn == 24 ? 1 : pn == 25 ? 4 : 5; return (const bf16*)(MIX + ((size_t)idx * M + r) * D); },
                [&](int r, int c, float ref) { const int pn = c >> 8; if (pn < 24) return bf2f(PROJ[(size_t)r * NIN + c]) - ref; const float x = pn == 24 ? tanhf(ref) : pn == 26 ? 1.f / (1.f + expf(-ref)) : ref; return bf2f(L1[(size_t)r * 768 + c - NIN]) - x; }, 0.05f, 160));
            if (IN(17)) { PHV;
                pg8::Gemm g{L1, W_l2, M, 6144, 256, 768}; L2Order S; S.init(M, 6144, G, bx);
                pg8::Epi4<FL2> E{FL2{L2}};
                pg8::gemm_phase<pg8::Epi4<FL2>, L2Order, PG8_ALIGN, PG8_SP2>(ldsu, g, S, E, tid);
            }
            SEAM(17);
            CK(17, ck_gemm(ck, 30, 0, MR, 6144, 256, W_l2, [&](int r, int c) { return (const bf16*)(L1 + (size_t)r * 768 + (c >> 11) * 256); },
                [&](int r, int c, float ref) { return L2[(size_t)r * 6144 + c] - ref; }, 0.05f, 170));
            if (IN(18)) { PHV; const RwC R{PROJ, L2, inp(20), inp(23), inp(28), inp(29), inp(30), inp(7), Y, BON, out + O_RWP, out + O_RWS};
                for (int u = bx; u < 256 + DB * RWH * 4; u += G) rwkv_unit(lds, u, R, tid); }
            SEAM(18);
            CK(18, ck_rwkv(ck, a, PROJ, L2, Y, BON));
            if (IN(19)) { PHV; rwkv_post(Y, BON, L2 + 4096, inp(31), inp(32), ATT, gw, NGW, lane); }
            SEAM(19);
            CK(19, ck_post(ck, a, Y, BON, L2 + 4096, ATT));
        }
        if (INL(5)) { PHV;
            pg8::Gemm g{ATT, L == 0 ? W_out : W_o, M, D, D, D}; pg8::StaticOrder S; S.init(M, D, G, bx);
            pg8::Epi4<FResid> E{FResid{XF, HPRE}};
            pg8::gemm_phase<pg8::Epi4<FResid>, pg8::StaticOrder, PG8_ALIGN, PG8_SP2>(ldsu, g, S, E, tid);
        }
        SEAM(5 + pb);
        CK(5 + pb, ck_gemm(ck, 19, 0, MR, D, D, L == 0 ? W_out : W_o, [&](int r, int) { return (const bf16*)(ATT + (size_t)r * D); },
            [&](int r, int c, float ref) { return HPRE[(size_t)r * D + c] - (ALPHA * XF[(size_t)r * D + c] + ref); }, 0.05f, 50));
        const float* lnw = inp(41) + (size_t)L * 3 * D; const float* lnb = inp(42) + (size_t)L * 3 * D;
        if (INL(6)) { PHV; for (int row = gw; row < MR; row += NGW) ln_row(HPRE + (size_t)row * D, lnw, lnb, XF + (size_t)row * D, XB + (size_t)row * D, lane); }
        SEAM(6 + pb);
        CK(6 + pb, ck_ln(ck, 20, HPRE, lnw, lnb, XF, 0));
        if (INL(7)) { PHV;
            { pg8::Gemm g{XB, W_q + (size_t)L * MW * D, M, MW, D, D}; pg8::StaticOrder S; S.init(M, MW, G, bx);
              pg8::Epi8<FBf16> E{FBf16{QM, MW}};
              pg8::gemm_phase<pg8::Epi8<FBf16>, pg8::StaticOrder, PG8_ALIGN, PG8_SP2>(ldsu, g, S, E, tid); }
            if (L == 0) { pg8::Gemm g{MEMB, W_kv, 512, D, D, D}; pg8::StaticOrder S; S.init(512, D, G, (bx + G - 80) % G);
              pg8::Epi8<FMemKV> E{FMemKV{MEMKV, out}};
              pg8::gemm_phase<pg8::Epi8<FMemKV>, pg8::StaticOrder, PG8_ALIGN, PG8_SP2>(ldsu, g, S, E, tid); }
        }
        SEAM(7 + pb);
        CK(7 + pb, ck_gemm(ck, 21, 0, MR, MW, D, W_q + (size_t)L * MW * D, [&](int r, int) { return (const bf16*)(XB + (size_t)r * D); }, [&](int r, int c, float ref) { return bf2f(QM[(size_t)r * MW + c]) - ref; }, 0.05f, 70));
        CK(7 + pb, ck_gemm(ck, 22, 0, 512, D, D, W_kv, [&](int r, int) { return (const bf16*)(MEMB + (size_t)r * D); },
            [&](int r, int c, float ref) { const float e1 = fabsf(bf2f(MEMKV[(size_t)r * D + c]) - ref); const int layer = c >> 10, kv = (c >> 9) & 1, cc = c & 511; const float e2 = fabsf(out[(kv ? O_MVP : O_MKP) + ((size_t)layer * 512 + r) * MW + cc] - ref); return e1 + e2; }, 0.05f, 75));
        if (INL(8)) { PHV;
            LAS float* xch = (LAS float*)(lds + XCH_OFF + wave * 256);
            for (int i = bx; i < 128 + DB * MH; i += G) {
                if (i < 128) { const int rt = i >> 2, h = i & 3, b = rt >> 4;
                    mem_unit(lds, xch, QM + (size_t)rt * 256 * MW + h * HD, MW, 256, MEMKV + (size_t)b * NMEM * D + L * 1024 + h * HD, MEMKV + (size_t)b * NMEM * D + L * 1024 + 512 + h * HD, D, OM + (size_t)rt * 256 * MW + h * HD, MW, tid); }
                else { const int su = i - 128, db = su >> 2, h = su & 3; const size_t kb = (size_t)((L * DB + db) * NMEM) * MW + h * HD;
                    mem_unit(lds, xch, QM + (size_t)(MPR + db * TS) * MW + h * HD, MW, TS, CMK + kb, CMV + kb, MW, OM + (size_t)(MPR + db * TS) * MW + h * HD, MW, tid); } }
        }
        SEAM(8 + pb);
        CK(8 + pb, ck_mem(ck, 23, QM, MEMKV, CMK, CMV, OM, L));
        if (INL(9)) { PHV;
            pg8::Gemm g{OM, W_co + (size_t)L * D * MW, M, D, MW, MW}; pg8::StaticOrder S; S.init(M, D, G, bx);
            pg8::Epi4<FResid> E{FResid{XF, HPRE}};
            pg8::gemm_phase<pg8::Epi4<FResid>, pg8::StaticOrder, PG8_ALIGN, PG8_SP2>(ldsu, g, S, E, tid);
        }
        SEAM(9 + pb);
        CK(9 + pb, ck_gemm(ck, 24, 0, MR, D, MW, W_co + (size_t)L * D * MW, [&](int r, int) { return (const bf16*)(OM + (size_t)r * MW); },
            [&](int r, int c, float ref) { return HPRE[(size_t)r * D + c] - (ALPHA * XF[(size_t)r * D + c] + ref); }, 0.05f, 90));
        if (INL(10)) { PHV; for (int row = gw; row < MR; row += NGW) ln_row(HPRE + (size_t)row * D, lnw + D, lnb + D, XF + (size_t)row * D, XB + (size_t)row * D, lane); }
        SEAM(10 + pb);
        CK(10 + pb, ck_ln(ck, 20, HPRE, lnw + D, lnb + D, XF, 0));
        if (INL(11)) { PHV;
            pg8::Gemm g{XB, W_up + (size_t)L * F2 * D, M, F2, D, D}; pg8::StaticOrder S; S.init(M, F2, G, bx);
            pg8::Epi8<FUp> E{FUp{U, out, L}};
            pg8::gemm_phase<pg8::Epi8<FUp>, pg8::StaticOrder, PG8_ALIGN, PG8_SP2>(ldsu, g, S, E, tid);
        }
        SEAM(11 + pb);
        CK(11 + pb, ck_gemm(ck, 25, 0, MR, F2, D, W_up + (size_t)L * F2 * D, [&](int r, int) { return (const bf16*)(XB + (size_t)r * D); }, [&](int r, int c, float ref) { return bf2f(U[(size_t)r * F2 + c]) - ref; }, 0.05f, 110));
        if (INL(12)) { PHV; conv_gate(U, inp(38) + (size_t)L * 3 * F2, inp(39) + (size_t)L * F2, inp(9) + (size_t)L * DB * 2 * F2, ACT, gtid, NT); }
        SEAM(12 + pb);
        CK(12 + pb, ck_conv(ck, 26, a, U, ACT, L));
        if (INL(13)) { PHV;
            pg8::Gemm g{ACT, W_dn + (size_t)L * D * FF, M, D, FF, FF}; pg8::StaticOrder S; S.init(M, D, G, bx);
            pg8::Epi4<FResid> E{FResid{XF, HPRE}};
            pg8::gemm_phase<pg8::Epi4<FResid>, pg8::StaticOrder, PG8_ALIGN, PG8_SP2>(ldsu, g, S, E, tid);
        }
        SEAM(13 + pb);
        CK(13 + pb, ck_gemm(ck, 27, 0, MR, D, FF, W_dn + (size_t)L * D * FF, [&](int r, int) { return (const bf16*)(ACT + (size_t)r * FF); },
            [&](int r, int c, float ref) { return HPRE[(size_t)r * D + c] - (ALPHA * XF[(size_t)r * D + c] + ref); }, 0.05f, 130));
        if (INL(14)) { PHV;
            for (int row = gw; row < MR; row += NGW) {
                if (L == 0) ln_row(HPRE + (size_t)row * D, lnw + 2 * D, lnb + 2 * D, XF + (size_t)row * D, XB + (size_t)row * D, lane);
                else ln_row(HPRE + (size_t)row * D, lnw + 2 * D, lnb + 2 * D, row < MPR ? out + O_YP + (size_t)row * D : out + O_YS + (size_t)(row - MPR) * D, nullptr, lane); }
        }
        SEAM(14 + pb);
    }
#if MK_CHECK
    if (IN(200)) { PHV; if (gtid == 0) { unsigned code = 0; float mag = 0.f;
            for (int id = 10; id < 64; ++id) { const float e = __uint_as_float(ctl[CW_ERR + id]); if (e > 1.f && code == 0) { code = id; mag = e; } }
#ifdef MK_REPORT
            code = 1000; mag = __uint_as_float(ctl[CW_ERR + MK_REPORT]);
#endif
            ctl[CW_ERR + 100] = code; ctl[CW_ERR + 101] = __float_as_uint(mag); } }
    if (IN(201)) { PHV; const unsigned code = ctl[CW_ERR + 100]; const float mag = __uint_as_float(ctl[CW_ERR + 101]);
        if (code) { int ex = 4; float m = mag; while (m >= 10.f && ex < 30) { m *= 0.1f; ++ex; }
            float c2 = (float)code; for (int i = 0; i < ex; ++i) c2 *= 10.f; if (code == 1000) c2 = fmaxf(mag, 1e-5f) * 1e6f; const float c = sqrtf(c2);
            for (size_t i = gtid; i < (size_t)MPR * D; i += NT) out[O_YP + i] = c; } }
#endif
#undef IN
#undef W_in
#undef W_out
#undef W_rkv
#undef W_l2
#undef W_o
#undef W_q
#undef W_kv
#undef W_co
#undef W_up
#undef W_dn
#undef W_low
#undef XB
#undef XF
#undef HPRE
#undef PROJ
#undef ATT
#undef QM
#undef OM
#undef MEMB
#undef MEMKV
#undef CMK
#undef CMV
#undef U
#undef ACT
#undef MIX
#undef L1
#undef L2
#undef Y
#undef BON
#undef LOW
#undef DST
#undef DEC
#undef GO
#undef SIN
#undef QDg
#undef PO
#undef PL
#undef PHV
#undef INL
#undef SEAM
#undef CK
}
#ifndef MK_FUSED
#define MK_FUSED 0
#endif
extern "C" void kernel_launch(void* const* d_in, const int* in_sizes, int n_in, void* d_out, int out_size, void* d_ws, size_t ws_size, hipStream_t stream) {
    static int grid = 0;
    if (grid == 0) {
        if (n_in != 43 || (size_t)out_size != O_END || ws_size < WS_TOTAL) { fprintf(stderr, "kernel_launch: unexpected problem shape (n_in %d, out %d, ws %zu); nothing launched\n", n_in, out_size, ws_size); grid = -1; return; }
        int dev = 0, cus = 0;
        if (hipGetDevice(&dev) != hipSuccess || hipDeviceGetAttribute(&cus, hipDeviceAttributeMultiprocessorCount, dev) != hipSuccess) { grid = -1; return; }
        if (hipFuncSetAttribute((const void*)fwd, hipFuncAttributeMaxDynamicSharedMemorySize, LDS_BYTES) != hipSuccess) { fprintf(stderr, "kernel_launch: hipFuncSetAttribute failed\n"); grid = -1; return; }
        int per_cu = 0;
        if (hipOccupancyMaxActiveBlocksPerMultiprocessor(&per_cu, (const void*)fwd, NTHREADS, LDS_BYTES) != hipSuccess || per_cu < 1) fprintf(stderr, "kernel_launch: occupancy query reports %d blocks per CU\n", per_cu);
        (void)hipGetLastError();
        grid = cus;
    }
    if (grid < 0) return;
    (void)hipMemsetAsync((char*)d_ws + WS_CTL, 0, CTL_ZERO_BYTES, stream);
    Args a{};
    for (int i = 0; i < 43; ++i) a.in[i] = (const float*)d_in[i];
    a.out = (float*)d_out; a.ws = (unsigned char*)d_ws;
#if MK_FUSED
    a.ph_lo = 0; a.ph_hi = 30; a.fused = 1;
    hipLaunchKernelGGL(fwd, dim3(grid), dim3(NTHREADS), LDS_BYTES, stream, a);
#else
    a.fused = 0;
    for (int k = 0; k < 30; ++k) {
        a.ph_lo = k; a.ph_hi = k + 1; hipLaunchKernelGGL(fwd, dim3(grid), dim3(NTHREADS), LDS_BYTES, stream, a);
#if MK_CHECK
        a.ph_lo = 100 + k; a.ph_hi = 101 + k; hipLaunchKernelGGL(fwd, dim3(grid), dim3(NTHREADS), LDS_BYTES, stream, a);
#endif
    }
#if MK_CHECK
    a.ph_lo = 200; a.ph_hi = 201; hipLaunchKernelGGL(fwd, dim3(grid), dim3(NTHREADS), LDS_BYTES, stream, a);
    a.ph_lo = 201; a.ph_hi = 202; hipLaunchKernelGGL(fwd, dim3(grid), dim3(NTHREADS), LDS_BYTES, stream, a);
#endif
#endif
    const hipError_t le = hipPeekAtLastError();
    if (le != hipSuccess) fprintf(stderr, "kernel_launch: launch failed: %s\n", hipGetErrorName(le));
}
```

```cpp
#define MK_CHECK 0
#define MK_FUSED 1

#include <hip/hip_runtime.h>
#include <cstdio>
#include <cstdint>

#define GAS __attribute__((address_space(1)))
#define LAS __attribute__((address_space(3)))
#define DI __device__ __forceinline__
typedef unsigned short bf16;
typedef short bf16x8 __attribute__((ext_vector_type(8)));
typedef short s16x4 __attribute__((ext_vector_type(4)));
typedef float f32x2 __attribute__((ext_vector_type(2)));
typedef float f32x4 __attribute__((ext_vector_type(4)));
typedef float f32x16 __attribute__((ext_vector_type(16)));
typedef unsigned u32x2 __attribute__((ext_vector_type(2)));
typedef unsigned u32x4 __attribute__((ext_vector_type(4)));

constexpr int D = 2048, TP = 4096, BP = 2, MPR = BP * TP;
constexpr int DB = 8, TS = 8, MSR = DB * TS;
constexpr int MR = MPR + MSR;
constexpr int M = MPR + 256;
constexpr int NPAGES = 128, PAGE = 128, PAST = 16384;
constexpr int SBH = 8, HD = 128, SBW = 1024;
constexpr int GH = 4, GDK = 128, GDV = 256, GKW = 512, GVW = 1024, GRANK = 16;
constexpr int NIN = 6144, NIN_FULL = 6160;
constexpr int RWH = 32, RWN = 64;
constexpr int NMEM = 256, MH = 4, MW = 512;
constexpr int FF = 5504, F2 = 11008;
constexpr float LN_EPS = 1e-5f, GLA_EPS = 1e-5f, RW_LN_EPS = 64e-5f;
constexpr float ALPHA = 1.4142135623730951f;
constexpr float LOG2E = 1.4426950408889634f;
constexpr int NUNITS_G = BP * 64 * GH + DB * GH;

constexpr size_t O_YP = 0, O_YS = O_YP + (size_t)MPR * D, O_SBKP = O_YS + (size_t)MSR * D, O_SBVP = O_SBKP + (size_t)MPR * SBW,
    O_GLAP = O_SBVP + (size_t)MPR * SBW, O_RWP = O_GLAP + (size_t)BP * GH * GDK * GDV, O_SHP = O_RWP + (size_t)BP * RWH * 64 * 64, O_CONVP = O_SHP + (size_t)BP * D,
    O_MKP = O_CONVP + (size_t)2 * BP * 2 * F2, O_MVP = O_MKP + (size_t)2 * BP * NMEM * MW, O_SBKS = O_MVP + (size_t)2 * BP * NMEM * MW, O_SBVS = O_SBKS + (size_t)MSR * SBW,
    O_GLAS = O_SBVS + (size_t)MSR * SBW, O_RWS = O_GLAS + (size_t)DB * GH * GDK * GDV, O_SHS = O_RWS + (size_t)DB * RWH * 64 * 64, O_CONVS = O_SHS + (size_t)DB * D,
    O_END = O_CONVS + (size_t)2 * DB * 2 * F2;

constexpr size_t MiB = 1u << 20;
constexpr size_t al(size_t x) { return (x + 255) & ~(size_t)255; }
constexpr size_t WS_CTL = 0, CTL_ZERO_BYTES = 1 * MiB;
constexpr size_t WS_WIN = 2 * MiB;
constexpr size_t WS_WOUT = WS_WIN + al((size_t)NIN * D * 2);
constexpr size_t WS_WRKV = WS_WOUT + al((size_t)D * D * 2);
constexpr size_t WS_WL2 = WS_WRKV + al((size_t)6912 * D * 2);
constexpr size_t WS_WO = WS_WL2 + al((size_t)6144 * 256 * 2);
constexpr size_t WS_WQ = WS_WO + al((size_t)D * D * 2);
constexpr size_t WS_WKV = WS_WQ + al((size_t)2 * MW * D * 2);
constexpr size_t WS_WCO = WS_WKV + al((size_t)2048 * D * 2);
constexpr size_t WS_WUP = WS_WCO + al((size_t)2 * D * MW * 2);
constexpr size_t WS_WDN = WS_WUP + al((size_t)2 * F2 * D * 2);
constexpr size_t WS_XB = WS_WDN + al((size_t)2 * D * FF * 2);
constexpr size_t WS_XF = WS_XB + al((size_t)M * D * 2);
constexpr size_t WS_HPRE = WS_XF + al((size_t)M * D * 4);
constexpr size_t WS_PROJ = WS_HPRE + al((size_t)M * D * 4);
constexpr size_t WS_ATT = WS_PROJ + al((size_t)M * NIN * 2);
constexpr size_t WS_QM = WS_ATT + al((size_t)M * D * 2);
constexpr size_t WS_OM = WS_QM + al((size_t)M * MW * 2);
constexpr size_t WS_MEMB = WS_OM + al((size_t)M * MW * 2);
constexpr size_t WS_MEMKV = WS_MEMB + al((size_t)512 * D * 2);
constexpr size_t WS_CMK = WS_MEMKV + al((size_t)512 * D * 2);
constexpr size_t WS_CMV = WS_CMK + al((size_t)2 * DB * NMEM * MW * 2);
constexpr size_t WS_U = WS_CMV + al((size_t)2 * DB * NMEM * MW * 2);
constexpr size_t WS_ACT = WS_U + al((size_t)M * F2 * 2);
constexpr size_t WS_MIX = WS_ACT + al((size_t)M * FF * 2);
constexpr size_t WS_L1 = WS_MIX + al((size_t)6 * M * D * 2);
constexpr size_t WS_L2 = WS_L1 + al((size_t)M * 768 * 2);
constexpr size_t WS_Y = WS_L2 + al((size_t)3 * M * D * 4);
constexpr size_t WS_BON = WS_Y + al((size_t)M * D * 4);
constexpr size_t WS_LOW = WS_BON + al((size_t)M * D * 4);
constexpr size_t WS_DST = WS_LOW + al((size_t)M * 16 * 4);
constexpr size_t WS_DEC = WS_DST + al((size_t)NUNITS_G * GDV * GDK * 4);
constexpr size_t WS_GO = WS_DEC + al((size_t)NUNITS_G * GDK * 4);
constexpr size_t WS_SIN = WS_GO + al((size_t)M * GVW * 4);
constexpr size_t WS_QD = WS_SIN + al((size_t)NUNITS_G * GDV * GDK * 2);
constexpr size_t WS_PO = WS_QD + al((size_t)M * GKW * 2);
constexpr size_t WS_PL = WS_PO + al((size_t)DB * NPAGES * SBH * TS * HD * 4);
constexpr size_t WS_END = WS_PL + al((size_t)DB * NPAGES * SBH * TS * 4);
constexpr int CW_BAR = 4096;
constexpr int CW_ERR = 16384;
constexpr int CW_Q = 8192;
namespace pg8 {
#define PG8_LAS __attribute__((address_space(3)))
typedef unsigned short bf16_t;
typedef short bf16x8 __attribute__((ext_vector_type(8)));
typedef float f32x4 __attribute__((ext_vector_type(4)));
typedef unsigned u32x4 __attribute__((ext_vector_type(4)));
constexpr int BM = 256, BK = 64, HALF = 128, HTB = HALF * BK * 2, STAGE_BYTES = 8 * HTB, NXCD = 8, WGM = 8;
__host__ __device__ __forceinline__ int lds_byte(int r, int c) { const int st = (r >> 4) * 2 + (c >> 5), rr = r & 15, cc = c & 31, ob = rr * 64 + cc * 2; return st * 1024 + (ob ^ (((ob >> 9) & 1) << 5)); }
__host__ __device__ __forceinline__ void stage_rc(int b, int& R, int& C) { const int st = b / 1024, sb = b % 1024, swz = sb ^ (((sb >> 9) & 1) << 5); R = (st >> 1) * 16 + swz / 64; C = (st & 1) * 32 + (swz % 64) / 2; }
__host__ __device__ __forceinline__ int perm32(int rho) { const int n = rho >> 4, i = rho & 15; return 8 * (i >> 2) + 4 * n + (i & 3); }
struct Unit { int pm, pn; };
struct Gemm { const bf16_t* A; const bf16_t* Bt; int M, N, K, lda; };
struct StaticOrder {
    int nM, nN, nwg, G, c;
    __host__ __device__ void init(int M, int N, int G_, int c_) { nM = M / BM; nN = N / BM; nwg = nM * nN; G = G_; c = c_; }
    __host__ __device__ bool next(int i, Unit& u) const {
        const long L = (long)i * G + c; if (L >= nwg) return false;
        int wgid = (int)L; { const int q = nwg / NXCD, r = nwg % NXCD, xcd = wgid % NXCD, off = wgid / NXCD; wgid = (xcd < r ? xcd * (q + 1) : r * (q + 1) + (xcd - r) * q) + off; }
        const int nig = WGM * nN, gid = wgid / nig, fm = gid * WGM, gsz = (nM - fm) < WGM ? (nM - fm) : WGM;
        u.pm = fm + ((wgid % nig) % gsz); u.pn = (wgid % nig) / gsz; return true;
    }
    __device__ __forceinline__ void a_ready(const Unit&) const {}
    __device__ __forceinline__ void done(const Unit&) const {}
    __device__ __forceinline__ size_t a_off(int) const { return 0; }
};
__device__ __forceinline__ unsigned cvt_pk_bf16(float lo, float hi) { unsigned r; asm volatile("v_cvt_pk_bf16_f32 %0, %1, %2" : "=v"(r) : "v"(lo), "v"(hi)); return r; }

template <class F> struct Epi8 {
    static constexpr bool PERM = true, AFTER_DRAIN = false; F f;
    __device__ __forceinline__ void operator()(const f32x4 (&acc)[2][2][4][2], const Unit& u, int wr, int wc, int fr, int fq) const {
        const int row0 = u.pm * BM + wr * 64 + fr, col0 = u.pn * BM + wc * 32 + 8 * fq;
#pragma unroll
        for (int ai = 0; ai < 2; ++ai)
#pragma unroll
            for (int m = 0; m < 4; ++m)
#pragma unroll
                for (int bj = 0; bj < 2; ++bj) f(row0 + ai * HALF + m * 16, col0 + bj * HALF, acc[ai][bj][m][0], acc[ai][bj][m][1], u.pn);
    }
};
template <class F> struct Epi4 {
    static constexpr bool PERM = false, AFTER_DRAIN = false; F f;
    __device__ __forceinline__ void operator()(const f32x4 (&acc)[2][2][4][2], const Unit& u, int wr, int wc, int fr, int fq) const {
        const int row0 = u.pm * BM + wr * 64 + fr, col0 = u.pn * BM + wc * 32 + 4 * fq;
#pragma unroll
        for (int ai = 0; ai < 2; ++ai)
#pragma unroll
            for (int m = 0; m < 4; ++m)
#pragma unroll
                for (int bj = 0; bj < 2; ++bj)
#pragma unroll
                    for (int n = 0; n < 2; ++n) f(row0 + ai * HALF + m * 16, col0 + bj * HALF + n * 16, acc[ai][bj][m][n], u.pn);
    }
};
template <class Epi, class Sched, bool ALIGN_EPI = false, bool SP2 = false>
__device__ __forceinline__ void gemm_phase(PG8_LAS unsigned char* lds, const Gemm g, const Sched& S, const Epi& E, const int tid) {
    const int wid = __builtin_amdgcn_readfirstlane(tid >> 6), lane = tid & 63, wr = wid >> 2, wc = wid & 3, fr = lane & 15, fq = lane >> 4;
    const int K = g.K, nt = K / BK;
    unsigned voffA[2], voffB[2];
#pragma unroll
    for (int i = 0; i < 2; ++i) { int R, C; stage_rc(tid * 16 + i * 8192, R, C); const int Rb = Epi::PERM ? ((R & ~31) + perm32(R & 31)) : R;
        voffA[i] = (unsigned)(R * g.lda + C) * 2u; voffB[i] = (unsigned)(Rb * K + C) * 2u; }
    const size_t kstep = (size_t)(BK * 2);
    const size_t hstepB = (size_t)HALF * K * 2, hstepA = (size_t)HALF * g.lda * 2;
    const size_t tstepB = 2 * hstepB, tstepA = 2 * hstepA;
    const unsigned ldsw = (unsigned)wid * 1024u;
    const int aoff = lds_byte(wr * 64 + fr, fq * 8), boff = lds_byte(wc * 32 + fr, fq * 8);
#define PG8_SA(b, h) (((b) * 2 + (h)) * HTB)
#define PG8_SB(b, h) ((4 + (b) * 2 + (h)) * HTB)
#define PG8_STAGE(bufoff, gbase, voff) do { _Pragma("unroll") for (int _i = 0; _i < 2; ++_i) \
        __builtin_amdgcn_global_load_lds((const unsigned*)((const char*)(gbase) + (voff)[_i]), (PG8_LAS unsigned*)(lds + (bufoff) + ldsw + _i * 8192), 16, 0, 0); } while (0)
#define PG8_LDA(dst, b, h) do { _Pragma("unroll") for (int m = 0; m < 4; ++m) _Pragma("unroll") for (int k = 0; k < 2; ++k) dst[m][k] = *(const PG8_LAS bf16x8*)(lds + PG8_SA(b, h) + aoff + m * 2048 + k * 1024); } while (0)
#define PG8_LDB(dst, b, h) do { _Pragma("unroll") for (int n = 0; n < 2; ++n) _Pragma("unroll") for (int k = 0; k < 2; ++k) dst[n][k] = *(const PG8_LAS bf16x8*)(lds + PG8_SB(b, h) + boff + n * 2048 + k * 1024); } while (0)
#define PG8_MMA(ai, bj, At, Bt) do { __builtin_amdgcn_s_setprio(1); _Pragma("unroll") for (int m = 0; m < 4; ++m) _Pragma("unroll") for (int n = 0; n < 2; ++n) _Pragma("unroll") for (int k = 0; k < 2; ++k) \
        acc[ai][bj][m][n] = __builtin_amdgcn_mfma_f32_16x16x32_bf16(Bt[n][k], At[m][k], acc[ai][bj][m][n], 0, 0, 0); __builtin_amdgcn_s_setprio(0); } while (0)
#define PG8_WAIT_V(n) asm volatile("s_waitcnt vmcnt(" #n ")" ::: "memory")
#define PG8_WAIT_L(n) asm volatile("s_waitcnt lgkmcnt(" #n ")" ::: "memory")
#define PG8_BAR __builtin_amdgcn_s_barrier()
#define PG8_SCHED __builtin_amdgcn_sched_barrier(0)
    Unit cur, nxt; int ui = 0;
    if (!S.next(0, cur)) return;
    f32x4 acc[2][2][4][2];
#pragma unroll
    for (int a = 0; a < 2; ++a)
#pragma unroll
        for (int b = 0; b < 2; ++b)
#pragma unroll
            for (int m = 0; m < 4; ++m)
#pragma unroll
                for (int n = 0; n < 2; ++n) acc[a][b][m][n] = (f32x4){0.f, 0.f, 0.f, 0.f};
    bf16x8 At[4][2], B0[2][2], B1[2][2];
    const char* cA = (const char*)g.A + S.a_off(cur.pn) + (size_t)cur.pm * tstepA; const char* cB = (const char*)g.Bt + (size_t)cur.pn * tstepB;
    S.a_ready(cur);
    if constexpr (SP2) {
        PG8_STAGE(PG8_SB(0, 0), cB, voffB); PG8_STAGE(PG8_SB(0, 1), cB + hstepB, voffB); PG8_STAGE(PG8_SA(0, 0), cA, voffA); PG8_STAGE(PG8_SA(0, 1), cA + hstepA, voffA);
        if (wr == 1) PG8_BAR;
        PG8_WAIT_V(2); PG8_BAR;
        PG8_STAGE(PG8_SB(1, 0), cB + kstep, voffB); PG8_STAGE(PG8_SA(1, 0), cA + kstep, voffA); PG8_STAGE(PG8_SB(1, 1), cB + hstepB + kstep, voffB);
        PG8_WAIT_V(6); PG8_BAR;
    } else {
        PG8_STAGE(PG8_SB(0, 0), cB, voffB); PG8_STAGE(PG8_SA(0, 0), cA, voffA); PG8_STAGE(PG8_SB(0, 1), cB + hstepB, voffB); PG8_STAGE(PG8_SA(0, 1), cA + hstepA, voffA);
        if (wr == 1) PG8_BAR;
        PG8_WAIT_V(4); PG8_BAR;
        PG8_STAGE(PG8_SB(1, 0), cB + kstep, voffB); PG8_STAGE(PG8_SA(1, 0), cA + kstep, voffA); PG8_STAGE(PG8_SB(1, 1), cB + hstepB + kstep, voffB);
        PG8_WAIT_V(6); PG8_BAR;
    }
    for (;;) {
        const bool has_next = S.next(ui + 1, nxt);
        const char* nA = has_next ? (const char*)g.A + S.a_off(nxt.pn) + (size_t)nxt.pm * tstepA : cA; const char* nB = has_next ? (const char*)g.Bt + (size_t)nxt.pn * tstepB : cB;
#pragma nounroll
        for (int t = 0; t < nt; t += 2) {
            const bool last = (t == nt - 2);
            const char* a1 = cA + (size_t)(t + 1) * kstep;
            const char* a2 = last ? nA : cA + (size_t)(t + 2) * kstep; const char* b2 = last ? nB : cB + (size_t)(t + 2) * kstep;
            const char* a3 = a2 + kstep; const char* b3 = b2 + kstep;
            if (last && has_next) S.a_ready(nxt);
            if constexpr (SP2) {
            PG8_LDB(B0, 0, 0); PG8_LDB(B1, 0, 1); PG8_SCHED; PG8_LDA(At, 0, 0); PG8_STAGE(PG8_SA(1, 1), a1 + hstepA, voffA);
            PG8_WAIT_V(8); PG8_WAIT_L(0); PG8_BAR; PG8_MMA(0, 0, At, B0); PG8_MMA(0, 1, At, B1); PG8_BAR; PG8_SCHED;
            PG8_LDA(At, 0, 1); PG8_STAGE(PG8_SB(0, 0), b2, voffB); PG8_STAGE(PG8_SB(0, 1), b2 + hstepB, voffB); PG8_STAGE(PG8_SA(0, 0), a2, voffA);
            PG8_WAIT_V(8); PG8_WAIT_L(0); PG8_BAR; PG8_MMA(1, 0, At, B0); PG8_MMA(1, 1, At, B1); PG8_BAR; PG8_SCHED;
            PG8_LDB(B0, 1, 0); PG8_LDB(B1, 1, 1); PG8_SCHED; PG8_LDA(At, 1, 0); PG8_STAGE(PG8_SA(0, 1), a2 + hstepA, voffA);
            PG8_WAIT_V(8); PG8_WAIT_L(0); PG8_BAR; PG8_MMA(0, 0, At, B0); PG8_MMA(0, 1, At, B1); PG8_BAR; PG8_SCHED;
            PG8_LDA(At, 1, 1); PG8_STAGE(PG8_SB(1, 0), b3, voffB); PG8_STAGE(PG8_SB(1, 1), b3 + hstepB, voffB); PG8_STAGE(PG8_SA(1, 0), a3, voffA);
            PG8_WAIT_V(8); PG8_WAIT_L(0); PG8_BAR; PG8_MMA(1, 0, At, B0); PG8_MMA(1, 1, At, B1); PG8_BAR; PG8_SCHED;
            } else {
            PG8_LDB(B0, 0, 0); PG8_SCHED; PG8_LDA(At, 0, 0); PG8_STAGE(PG8_SA(1, 1), a1 + hstepA, voffA);
            PG8_WAIT_L(8); PG8_BAR; PG8_WAIT_L(0); PG8_MMA(0, 0, At, B0); PG8_BAR; PG8_SCHED;
            PG8_LDB(B1, 0, 1); PG8_STAGE(PG8_SB(0, 0), b2, voffB);
            PG8_BAR; PG8_WAIT_L(0); PG8_MMA(0, 1, At, B1); PG8_BAR;
            PG8_LDA(At, 0, 1); PG8_STAGE(PG8_SA(0, 0), a2, voffA);
            PG8_BAR; PG8_WAIT_L(0); PG8_MMA(1, 0, At, B0); PG8_BAR; PG8_SCHED;
            PG8_STAGE(PG8_SB(0, 1), b2 + hstepB, voffB);
            PG8_WAIT_V(6); PG8_BAR; PG8_MMA(1, 1, At, B1); PG8_BAR;
            PG8_LDB(B0, 1, 0); PG8_SCHED; PG8_LDA(At, 1, 0); PG8_STAGE(PG8_SA(0, 1), a2 + hstepA, voffA);
            PG8_WAIT_L(8); PG8_BAR; PG8_WAIT_L(0); PG8_MMA(0, 0, At, B0); PG8_BAR; PG8_SCHED;
            PG8_LDB(B1, 1, 1); PG8_STAGE(PG8_SB(1, 0), b3, voffB);
            PG8_BAR; PG8_WAIT_L(0); PG8_MMA(0, 1, At, B1); PG8_BAR;
            PG8_LDA(At, 1, 1); PG8_STAGE(PG8_SA(1, 0), a3, voffA);
            PG8_BAR; PG8_WAIT_L(0); PG8_MMA(1, 0, At, B0); PG8_BAR; PG8_SCHED;
            PG8_STAGE(PG8_SB(1, 1), b3 + hstepB, voffB);
            PG8_WAIT_V(6); PG8_BAR; PG8_MMA(1, 1, At, B1); PG8_BAR;
            }
        }
        if constexpr (ALIGN_EPI) { if (wr == 0) PG8_BAR; }
        if constexpr (!Epi::AFTER_DRAIN) { E(acc, cur, wr, wc, fr, fq); S.done(cur); }
        if (!has_next) break;
#pragma unroll
        for (int a = 0; a < 2; ++a)
#pragma unroll
            for (int b = 0; b < 2; ++b)
#pragma unroll
                for (int m = 0; m < 4; ++m)
#pragma unroll
                    for (int n = 0; n < 2; ++n) acc[a][b][m][n] = (f32x4){0.f, 0.f, 0.f, 0.f};
        cur = nxt; cA = nA; cB = nB; ++ui;
        if constexpr (ALIGN_EPI) { if (wr == 1) PG8_BAR; }
    }
    PG8_WAIT_V(0);
    if constexpr (!ALIGN_EPI) { if (wr == 0) PG8_BAR; }
    PG8_BAR;
    if constexpr (Epi::AFTER_DRAIN) { E.fused(acc, cur, wr, wc, fr, fq, lds, wid, lane); S.done(cur); }
#undef PG8_SA
#undef PG8_SB
#undef PG8_STAGE
#undef PG8_LDA
#undef PG8_LDB
#undef PG8_MMA
#undef PG8_WAIT_V
#undef PG8_WAIT_L
#undef PG8_BAR
#undef PG8_SCHED
}}
#define XB_TMO      128
#define XB_XCNT(j)  (256  + 64 * (j))
#define XB_XSUB(j)  (1280 + 64 * (j))
#define XB_XGEN(j)  (2304 + 64 * (j))
#define XB_TOP      3328
#define XB_TOPGEN   3392
#define XCD_BAR_WORDS 3456
#define XB_SPIN_CAP (1u << 18)

__device__ __forceinline__ unsigned xb_ld(unsigned* p)              { return __hip_atomic_load(p, __ATOMIC_RELAXED, __HIP_MEMORY_SCOPE_AGENT); }
__device__ __forceinline__ unsigned xb_add(unsigned* p, unsigned v) { return __hip_atomic_fetch_add(p, v, __ATOMIC_RELAXED, __HIP_MEMORY_SCOPE_AGENT); }
__device__ __forceinline__ unsigned xb_xcc_id() { return (unsigned)__builtin_amdgcn_s_getreg((3 << 11) | 20) & 0xFu; }
#define XB_SPIN(cond, bar) do { unsigned _sp = 0; while (cond) { __builtin_amdgcn_s_sleep(1); \
    if ((++_sp & 255u) == 0u) { if (xb_ld(&(bar)[XB_TMO])) break; if (_sp > XB_SPIN_CAP) { atomicAdd(&(bar)[XB_TMO], 1u); break; } } } } while (0)

struct XcdBarrier {
    unsigned* bar; unsigned x;
    volatile LAS unsigned* st;
};

__device__ __forceinline__ XcdBarrier xcd_barrier_post(unsigned* bar, volatile LAS unsigned* st) {
    XcdBarrier b; b.bar = bar; b.x = xb_xcc_id(); b.st = st;
    if (threadIdx.x == 0) (void)xb_add(&bar[XB_XCNT(b.x)], 1u);
    return b;
}
__device__ __forceinline__ void xcd_barrier_complete(unsigned* bar, unsigned x, unsigned& nloc, unsigned& nx) {
    const unsigned G = gridDim.x * gridDim.y * gridDim.z;
    unsigned sum, cnt, mine, sp = 0u;
    for (;;) {
        sum = 0u; cnt = 0u; mine = 0u;
#pragma unroll
        for (unsigned j = 0; j < 16; ++j) { const unsigned c = xb_ld(&bar[XB_XCNT(j)]); sum += c; cnt += (c > 0u) ? 1u : 0u; mine = (j == x) ? c : mine; }
        if (sum == G) break;
        __builtin_amdgcn_s_sleep(1);
        if ((++sp & 255u) == 0u) { if (xb_ld(&bar[XB_TMO])) break; if (sp > XB_SPIN_CAP) { atomicAdd(&bar[XB_TMO], 1u); break; } }
    }
    nloc = mine > 0u ? mine : 1u; nx = cnt > 0u ? cnt : 1u;
}

__device__ __forceinline__ void xcd_barrier(const XcdBarrier& b) {
    asm volatile("s_waitcnt vmcnt(0)" ::: "memory");
    __syncthreads();
    if (threadIdx.x == 0) {
        unsigned* bar = b.bar;
        __builtin_amdgcn_s_waitcnt(0);
        unsigned nloc = b.st[0], nx = b.st[1];
        if (nloc == 0u) { xcd_barrier_complete(bar, b.x, nloc, nx); b.st[0] = nloc; b.st[1] = nx; }
        const unsigned old = xb_add(&bar[XB_XSUB(b.x)], 1u);
        const unsigned gen = old / nloc;
        if (old + 1u == (gen + 1u) * nloc) {
            __builtin_amdgcn_fence(__ATOMIC_RELEASE, "agent");
            asm volatile("s_waitcnt vmcnt(0)" ::: "memory");
            const unsigned og = xb_add(&bar[XB_TOP], 1u);
            const unsigned tg = og / nx;
            if (og + 1u == (tg + 1u) * nx) xb_add(&bar[XB_TOPGEN], 1u);
            else XB_SPIN(xb_ld(&bar[XB_TOPGEN]) == tg, bar);
            __builtin_amdgcn_fence(__ATOMIC_ACQUIRE, "agent");
            xb_add(&bar[XB_XGEN(b.x)], 1u);
            asm volatile("s_waitcnt vmcnt(0)" ::: "memory");
        } else {
            XB_SPIN(xb_ld(&bar[XB_XGEN(b.x)]) == gen, bar);
            __builtin_amdgcn_fence(__ATOMIC_ACQUIRE, "agent");
            asm volatile("s_waitcnt vmcnt(0)" ::: "memory");
        }
    }
    __syncthreads();
}

extern __shared__ __attribute__((aligned(16))) unsigned char lds_raw[];
constexpr int MISC_OFF = 131072, PTRS_OFF = MISC_OFF + 256, XCH_OFF = MISC_OFF + 1024, LDS_BYTES = 147456;
DI const float* inp(int k) {
    volatile LAS unsigned* P = (volatile LAS unsigned*)((LAS unsigned char*)lds_raw + PTRS_OFF);
    const unsigned lo = __builtin_amdgcn_readfirstlane(P[2 * k]), hi = __builtin_amdgcn_readfirstlane(P[2 * k + 1]);
    return (const float*)(((unsigned long long)hi << 32) | lo);
}
DI int lane_id() { int l; asm volatile("v_mbcnt_lo_u32_b32 %0, -1, 0\n\tv_mbcnt_hi_u32_b32 %0, -1, %0" : "=v"(l)); return l; }
#define LDS_WAIT() asm volatile("s_waitcnt lgkmcnt(0)" ::: "memory")
#define VM_WAIT() asm volatile("s_waitcnt vmcnt(0)" ::: "memory")
typedef __bf16 bf16x2_t __attribute__((ext_vector_type(2)));
DI unsigned pk2(float lo, float hi) { const f32x2 v = {lo, hi}; const bf16x2_t b = __builtin_convertvector(v, bf16x2_t); return __builtin_bit_cast(unsigned, b); }
DI float bf2f(unsigned short h) { return __uint_as_float(((unsigned)h) << 16); }
DI float bflo(unsigned w) { return __uint_as_float(w << 16); }
DI float bfhi(unsigned w) { return __uint_as_float(w & 0xffff0000u); }
DI float dpp_sum16(float x) {
    x += __int_as_float(__builtin_amdgcn_update_dpp(0, __float_as_int(x), 0xB1, 0xF, 0xF, true));
    x += __int_as_float(__builtin_amdgcn_update_dpp(0, __float_as_int(x), 0x4E, 0xF, 0xF, true));
    x += __int_as_float(__builtin_amdgcn_update_dpp(0, __float_as_int(x), 0x141, 0xF, 0xF, true));
    x += __int_as_float(__builtin_amdgcn_update_dpp(0, __float_as_int(x), 0x140, 0xF, 0xF, true));
    return x;
}
DI float wave_sum(float v) {
    v = dpp_sum16(v);
    const float a = __int_as_float(__builtin_amdgcn_readlane(__float_as_int(v), 0)), b = __int_as_float(__builtin_amdgcn_readlane(__float_as_int(v), 16));
    const float c = __int_as_float(__builtin_amdgcn_readlane(__float_as_int(v), 32)), d = __int_as_float(__builtin_amdgcn_readlane(__float_as_int(v), 48));
    return (a + b) + (c + d);
}
DI float ex2(float x) { return __builtin_amdgcn_exp2f(x); }
DI float lg2(float x) { return __builtin_amdgcn_logf(x); }
DI float rcpf_(float x) { return __builtin_amdgcn_rcpf(x); }
DI float sigmoidf_(float x) { return rcpf_(1.f + ex2(-x * LOG2E)); }
DI float siluf_(float x) { return x * sigmoidf_(x); }
DI float softplusf_(float x) { return fmaxf(x, 0.f) + lg2(1.f + ex2(-fabsf(x) * LOG2E)) * 0.6931471805599453f; }
DI float tanhf_(float x) { const float e = ex2(-2.f * fabsf(x) * LOG2E); const float t = (1.f - e) * rcpf_(1.f + e); return x < 0.f ? -t : t; }

struct TrDesc { const float* W; bf16* WT; int ldw, Kr, Nr, ldt, nblk, start; };
constexpr int NTR = 23;
DI void tr_load(const TrDesc& d, int item, int lane, float (&v)[32]) {
    const int kb = item / d.nblk, nb = item % d.nblk, k0 = 64 * kb, n = 32 * nb + (lane & 31);
#pragma unroll
    for (int i = 0; i < 32; ++i) { const int k = k0 + 2 * i + (lane >> 5); v[i] = (k < d.Kr && n < d.Nr) ? d.W[(size_t)k * d.ldw + n] : 0.f; }
}
DI void tr_finish(const TrDesc& d, LAS float* scr, int item, int lane, const float (&v)[32]) {
    const int kb = item / d.nblk, nb = item % d.nblk, k0 = 64 * kb, n0 = 32 * nb;
#pragma unroll
    for (int i = 0; i < 32; ++i) scr[(2 * i + (lane >> 5)) * 33 + (lane & 31)] = v[i];
    LDS_WAIT(); asm volatile("" ::: "memory");
    const int c = lane & 7;
#pragma unroll
    for (int j = 0; j < 4; ++j) { const int nn = (lane >> 3) + 8 * j; const LAS float* s = scr + (8 * c) * 33 + nn;
        u32x4 o; o.x = pk2(s[0 * 33], s[1 * 33]); o.y = pk2(s[2 * 33], s[3 * 33]); o.z = pk2(s[4 * 33], s[5 * 33]); o.w = pk2(s[6 * 33], s[7 * 33]);
        *(GAS u32x4*)(d.WT + (size_t)(n0 + nn) * d.ldt + k0 + 8 * c) = o; }
    LDS_WAIT(); asm volatile("" ::: "memory");
}
DI void tr_item(const TrDesc& d, LAS float* scr, int item, int lane) { float v[32]; tr_load(d, item, lane, v); tr_finish(d, scr, item, lane, v); }
DI void row_to_bf16(const float* src, bf16* ob, float* of, int lane) {
    const GAS f32x4* xr = (const GAS f32x4*)src + lane;
    GAS u32x2* o8 = (GAS u32x2*)ob + lane;
#pragma unroll
    for (int j = 0; j < 8; ++j) { const f32x4 v = xr[64 * j]; u32x2 w; w.x = pk2(v.x, v.y); w.y = pk2(v.z, v.w); o8[64 * j] = w;
        if (of) ((GAS f32x4*)of)[lane + 64 * j] = v; }
}
DI void ln_rows(const bf16* HB, const float* gwv, const float* gbv, float* of_p, float* of_s, bf16* ob, int gw, int NGW, int lane) {
    f32x4 g[8], b[8];
#pragma unroll
    for (int j = 0; j < 4; ++j) { const int c = 8 * (lane + 64 * j); g[2 * j] = *(const GAS f32x4*)(gwv + c); g[2 * j + 1] = *(const GAS f32x4*)(gwv + c + 4); b[2 * j] = *(const GAS f32x4*)(gbv + c); b[2 * j + 1] = *(const GAS f32x4*)(gbv + c + 4); }
    for (int rowa = gw; rowa < MR; rowa += 2 * NGW) {
        const int rowb = rowa + NGW; const bool hb = rowb < MR;
        u32x4 wa[4], wb[4];
#pragma unroll
        for (int j = 0; j < 4; ++j) { wa[j] = ((const GAS u32x4*)(HB + (size_t)rowa * D) + lane)[64 * j]; wb[j] = hb ? ((const GAS u32x4*)(HB + (size_t)rowb * D) + lane)[64 * j] : wa[j]; }
#pragma unroll
        for (int rr = 0; rr < 2; ++rr) { if (rr == 1 && !hb) break; const int row = rr ? rowb : rowa;
            f32x4 v[8]; float s = 0.f;
#pragma unroll
            for (int j = 0; j < 4; ++j) { const u32x4 w = rr ? wb[j] : wa[j]; v[2 * j] = (f32x4){bflo(w.x), bfhi(w.x), bflo(w.y), bfhi(w.y)}; v[2 * j + 1] = (f32x4){bflo(w.z), bfhi(w.z), bflo(w.w), bfhi(w.w)}; }
#pragma unroll
            for (int j = 0; j < 8; ++j) s += (v[j].x + v[j].y) + (v[j].z + v[j].w);
            const float mean = wave_sum(s) * (1.f / D); float s2 = 0.f;
#pragma unroll
            for (int j = 0; j < 8; ++j) { v[j] = v[j] - mean; s2 += (v[j].x * v[j].x + v[j].y * v[j].y) + (v[j].z * v[j].z + v[j].w * v[j].w); }
            const float rstd = 1.f / sqrtf(wave_sum(s2) * (1.f / D) + LN_EPS);
#pragma unroll
            for (int j = 0; j < 4; ++j) { const f32x4 o0 = v[2 * j] * rstd * g[2 * j] + b[2 * j], o1 = v[2 * j + 1] * rstd * g[2 * j + 1] + b[2 * j + 1]; const int c = 8 * (lane + 64 * j);
                if (ob) { u32x4 w = {pk2(o0.x, o0.y), pk2(o0.z, o0.w), pk2(o1.x, o1.y), pk2(o1.z, o1.w)}; *(GAS u32x4*)(ob + (size_t)row * D + c) = w; }
                if (of_p) { float* of = row < MPR ? of_p + (size_t)row * D : of_s + (size_t)(row - MPR) * D; *(GAS f32x4*)(of + c) = o0; *(GAS f32x4*)(of + c + 4) = o1; } } } }
}
#define KSWZ(row, colB) ((row) * 256 + ((colB) ^ (((row) & 7) << 4)))
#define SBAR() __builtin_amdgcn_sched_barrier(0)
#define MFMA32(a, b, c) __builtin_amdgcn_mfma_f32_32x32x16_bf16((a), (b), (c), 0, 0, 0)
DI int crow(int r, int hi) { return (r & 3) + 8 * (r >> 2) + 4 * hi; }
DI int v_st(int k, int c) { const int kk = (k & ~0xC) | ((k & 4) << 1) | ((k & 8) >> 1); return ((kk >> 3) * 4 + (c >> 5)) * 512 + ((kk & 7) * 32 + (c & 31)) * 2; }
DI int v_rd_base(int lane) { return ((lane & 3) << 3) | (((lane >> 2) & 3) << 6) | (((lane >> 4) & 1) << 5) | (((lane >> 5) & 1) << 8); }
constexpr int v_rd_off(int d0, int ks, int half) { return d0 * 512 + ks * 4096 + half * 2048; }
template <int OFF> DI s16x4 tr_read(unsigned vb) { s16x4 r; asm volatile("ds_read_b64_tr_b16 %0, %1 offset:%2" : "=&v"(r) : "v"(vb), "i"(OFF) : "memory"); return r; }
#define PKLH(L, H) (bf16x8){L[0], L[1], L[2], L[3], H[0], H[1], H[2], H[3]}
template <int D0, int KS> DI bf16x8 tr_frag(unsigned vb) { const s16x4 l = tr_read<v_rd_off(D0, KS, 0)>(vb), h = tr_read<v_rd_off(D0, KS, 1)>(vb); asm volatile("s_waitcnt lgkmcnt(0)" ::: "memory"); SBAR(); return PKLH(l, h); }
template <int D0> DI void pv_one(f32x16& od, unsigned vb, bf16x8 pa0, bf16x8 pa1, bf16x8 pa2, bf16x8 pa3) {
    const s16x4 l0 = tr_read<v_rd_off(D0, 0, 0)>(vb), h0 = tr_read<v_rd_off(D0, 0, 1)>(vb), l1 = tr_read<v_rd_off(D0, 1, 0)>(vb), h1 = tr_read<v_rd_off(D0, 1, 1)>(vb);
    const s16x4 l2 = tr_read<v_rd_off(D0, 2, 0)>(vb), h2 = tr_read<v_rd_off(D0, 2, 1)>(vb), l3 = tr_read<v_rd_off(D0, 3, 0)>(vb), h3 = tr_read<v_rd_off(D0, 3, 1)>(vb);
    asm volatile("s_waitcnt lgkmcnt(0)" ::: "memory"); SBAR();
    od = MFMA32(pa0, PKLH(l0, h0), od); od = MFMA32(pa1, PKLH(l1, h1), od); od = MFMA32(pa2, PKLH(l2, h2), od); od = MFMA32(pa3, PKLH(l3, h3), od);
}
DI void pv_d0(f32x16 (&o)[4], unsigned vb, bf16x8 pa0, bf16x8 pa1, bf16x8 pa2, bf16x8 pa3) {
    pv_one<0>(o[0], vb, pa0, pa1, pa2, pa3); pv_one<1>(o[1], vb, pa0, pa1, pa2, pa3); pv_one<2>(o[2], vb, pa0, pa1, pa2, pa3); pv_one<3>(o[3], vb, pa0, pa1, pa2, pa3);
}
DI void qkt(f32x16& p0, f32x16& p1, const LAS char* Ks, const bf16x8 (&qr)[8], int r32, int hi) {
#pragma unroll
    for (int i = 0; i < 16; ++i) { p0[i] = 0.f; p1[i] = 0.f; }
#pragma unroll
    for (int d0 = 0; d0 < 8; ++d0) { const int cb = (d0 * 16 + hi * 8) * 2;
        const bf16x8 b0 = *(const LAS bf16x8*)(Ks + KSWZ(r32, cb)), b1 = *(const LAS bf16x8*)(Ks + KSWZ(32 + r32, cb));
        p0 = MFMA32(b0, qr[d0], p0); p1 = MFMA32(b1, qr[d0], p1); }
}
#define PK4(P, BASE, OUT) do { unsigned a0_ = pk2(P[BASE + 0], P[BASE + 1]), a1_ = pk2(P[BASE + 2], P[BASE + 3]); \
    unsigned b0_ = pk2(P[BASE + 4], P[BASE + 5]), b1_ = pk2(P[BASE + 6], P[BASE + 7]); \
    auto r0_ = __builtin_amdgcn_permlane32_swap(a0_, b0_, false, false); auto r1_ = __builtin_amdgcn_permlane32_swap(a1_, b1_, false, false); \
    u32x4 w_ = {r0_[0], r1_[0], r0_[1], r1_[1]}; OUT = __builtin_bit_cast(bf16x8, w_); } while (0)
DI float swap_lo(float x, float& hi_out) { auto rr = __builtin_amdgcn_permlane32_swap(__float_as_uint(x), __float_as_uint(x), false, false); hi_out = __uint_as_float(rr[1]); return __uint_as_float(rr[0]); }

struct KVStage { bf16x8 k0, k1, v0, v1; };
DI void kv_load(KVStage& s, const bf16* Kp, const bf16* Vp, size_t ld, int key0, int sr, int sc) {
    s.k0 = *(const GAS bf16x8*)(Kp + (size_t)(key0 + sr) * ld + sc); s.k1 = *(const GAS bf16x8*)(Kp + (size_t)(key0 + 32 + sr) * ld + sc);
    s.v0 = *(const GAS bf16x8*)(Vp + (size_t)(key0 + sr) * ld + sc); s.v1 = *(const GAS bf16x8*)(Vp + (size_t)(key0 + 32 + sr) * ld + sc);
}
DI void kv_write(const KVStage& s, LAS char* Kl, LAS char* Vl, int sr, int sc) {
    *(LAS bf16x8*)(Vl + v_st(sr, sc)) = s.v0; *(LAS bf16x8*)(Vl + v_st(32 + sr, sc)) = s.v1;
    *(LAS bf16x8*)(Kl + KSWZ(sr, sc * 2)) = s.k0; *(LAS bf16x8*)(Kl + KSWZ(32 + sr, sc * 2)) = s.k1;
}

template <bool MASK> DI void sb_half_pre(f32x16& p, float (&l)[16], float C, float bias2, int key0, int tq, int hi) {
#pragma unroll
    for (int r = 0; r < 16; ++r) { const float z = fmaf(p[r], C, bias2); const float e = ex2(z); float ll = lg2(1.f + e); float lb = z - ll;
        if (MASK) { const bool vis = (key0 + crow(r, hi)) < tq; ll = vis ? ll : 0.f; lb = vis ? lb : -1e30f; }
        l[r] = ll; p[r] = lb; }
}
DI void sb_half_fin(f32x16& p, const float (&l)[16], const float (&gbase)[4]) {
#pragma unroll
    for (int g = 0; g < 4; ++g) { float t = gbase[g];
        p[4 * g + 3] = ex2(p[4 * g + 3] - t); t += l[4 * g + 3];
        p[4 * g + 2] = ex2(p[4 * g + 2] - t); t += l[4 * g + 2];
        p[4 * g + 1] = ex2(p[4 * g + 1] - t); t += l[4 * g + 1];
        p[4 * g + 0] = ex2(p[4 * g + 0] - t); }
}
template <bool MASK> DI void sb_half(f32x16& p0, float C, float bias2, float& carry, int key0, int tq, int hi) {
    float l0[16]; sb_half_pre<MASK>(p0, l0, C, bias2, key0, tq, hi);
    float Glo[4], Ghi[4];
#pragma unroll
    for (int g = 0; g < 4; ++g) { const float s0 = (l0[4 * g] + l0[4 * g + 1]) + (l0[4 * g + 2] + l0[4 * g + 3]); Glo[g] = swap_lo(s0, Ghi[g]); }
    float R = carry; float gb[4];
#pragma unroll
    for (int g = 3; g >= 0; --g) { gb[g] = R + (hi == 0 ? Ghi[g] : 0.f); R += Glo[g] + Ghi[g]; }
    carry = R;
    sb_half_fin(p0, l0, gb);
}
template <bool MASK> DI void sb_tile64(f32x16& p0, f32x16& p1, float C, float bias2, float& carry, int key0, int tq, int hi) {
    sb_half<MASK>(p1, C, bias2, carry, key0 + 32, tq, hi); sb_half<MASK>(p0, C, bias2, carry, key0, tq, hi);
}
DI void sb_tile32(f32x16& p0, float C, float bias2, float& carry, int hi) { sb_half<false>(p0, C, bias2, carry, 0, 0, hi); }

DI void sbp_unit(LAS char* lds, const bf16* PROJ, bf16* ATT, float bias, int b, int h, int qb, int tid) {
    const int wid = __builtin_amdgcn_readfirstlane(tid >> 6), lane = tid & 63, r32 = lane & 31, hi = lane >> 5;
    LAS char* Kl[2] = {lds, lds + 16384}; LAS char* Vl[2] = {lds + 32768, lds + 49152};
    const bf16* Qp = PROJ + (size_t)(b * TP) * NIN + h * HD; const bf16* Kp = Qp + SBW; const bf16* Vp = Qp + 2 * SBW;
    const int Q0 = qb * 256, tmin = Q0 + 32 * wid, tq = tmin + r32, tmax = tmin + 31;
    bf16x8 qr[8];
#pragma unroll
    for (int d0 = 0; d0 < 8; ++d0) qr[d0] = *(const GAS bf16x8*)(Qp + (size_t)tq * NIN + d0 * 16 + hi * 8);
    const float C = 0.08838834764831845f * LOG2E, bias2 = bias * LOG2E;
    f32x16 o[4];
#pragma unroll
    for (int d = 0; d < 4; ++d)
#pragma unroll
        for (int i = 0; i < 16; ++i) o[d][i] = 0.f;
    float carry = 0.f;
    const int sr = tid >> 4, sc = (tid & 15) * 8;
    const unsigned vb0 = (unsigned)(uintptr_t)Vl[0] + v_rd_base(lane), vb1 = (unsigned)(uintptr_t)Vl[1] + v_rd_base(lane);
    const int jmax = Q0 / 64 + 3;
    KVStage st; kv_load(st, Kp, Vp, NIN, jmax * 64, sr, sc); kv_write(st, Kl[0], Vl[0], sr, sc); __syncthreads();
    int cur = 0;
    for (int j = jmax; j >= 0; --j) {
        if (j > 0) kv_load(st, Kp, Vp, NIN, (j - 1) * 64, sr, sc);
        if (64 * j < tmax) {
            f32x16 p0, p1; bf16x8 pa0, pa1, pa2, pa3;
            qkt(p0, p1, cur ? Kl[1] : Kl[0], qr, r32, hi);
            if (64 * j + 63 >= tmin) sb_tile64<true>(p0, p1, C, bias2, carry, 64 * j, tq, hi); else sb_tile64<false>(p0, p1, C, bias2, carry, 64 * j, tq, hi);
            PK4(p0, 0, pa0); PK4(p0, 8, pa1); PK4(p1, 0, pa2); PK4(p1, 8, pa3);
            pv_d0(o, cur ? vb1 : vb0, pa0, pa1, pa2, pa3);
        }
        if (j > 0) kv_write(st, cur ? Kl[0] : Kl[1], cur ? Vl[0] : Vl[1], sr, sc);
        __syncthreads();
        cur ^= 1;
    }
    bf16* Ow = ATT + (size_t)(b * TP + tmin) * D + h * HD;
#pragma unroll
    for (int r = 0; r < 16; ++r) { const int orow = crow(r, hi);
#pragma unroll
        for (int d0 = 0; d0 < 4; ++d0) Ow[(size_t)orow * D + d0 * 32 + r32] = (bf16)(pk2(o[d0][r], 0.f) & 0xffffu); }
}

DI void mem_unit(LAS char* lds, LAS float* xch  , const bf16* Qp  , size_t ldq, int nq, const bf16* Kp, const bf16* Vp, size_t ldk, bf16* Op, size_t ldo, int tid) {
    const int wid = __builtin_amdgcn_readfirstlane(tid >> 6), lane = tid & 63, r32 = lane & 31, hi = lane >> 5;
    const int sr = tid >> 4, sc = (tid & 15) * 8;
#pragma unroll
    for (int t = 0; t < 4; ++t) { KVStage st; kv_load(st, Kp, Vp, ldk, t * 64, sr, sc); kv_write(st, lds + t * 16384, lds + 65536 + t * 16384, sr, sc); }
    __syncthreads();
    const int qrow = 32 * wid + r32;
    if (32 * wid < nq) {
        bf16x8 qr[8];
#pragma unroll
        for (int d0 = 0; d0 < 8; ++d0) { bf16x8 z = {0, 0, 0, 0, 0, 0, 0, 0}; qr[d0] = (qrow < nq) ? *(const GAS bf16x8*)(Qp + (size_t)qrow * ldq + d0 * 16 + hi * 8) : z; }
        const float C = 0.08838834764831845f * LOG2E;
        float m = -1e30f;
#pragma unroll
        for (int t = 0; t < 4; ++t) { f32x16 p0, p1; qkt(p0, p1, lds + t * 16384, qr, r32, hi);
#pragma unroll
            for (int r = 0; r < 16; ++r) m = fmaxf(m, fmaxf(p0[r], p1[r])); }
        { float mh; const float ml = swap_lo(m, mh); m = fmaxf(ml, mh); }
        const float mC = -m * C; float l = 0.f;
        f32x16 o[4];
#pragma unroll
        for (int d = 0; d < 4; ++d)
#pragma unroll
            for (int i = 0; i < 16; ++i) o[d][i] = 0.f;
#pragma unroll
        for (int t = 0; t < 4; ++t) { f32x16 p0, p1; bf16x8 pa0, pa1, pa2, pa3; qkt(p0, p1, lds + t * 16384, qr, r32, hi);
#pragma unroll
            for (int r = 0; r < 16; ++r) { p0[r] = ex2(fmaf(p0[r], C, mC)); p1[r] = ex2(fmaf(p1[r], C, mC)); l += p0[r] + p1[r]; }
            PK4(p0, 0, pa0); PK4(p0, 8, pa1); PK4(p1, 0, pa2); PK4(p1, 8, pa3);
            pv_d0(o, (unsigned)(uintptr_t)(lds + 65536 + t * 16384) + v_rd_base(lane), pa0, pa1, pa2, pa3); }
        { float lh; const float ll = swap_lo(l, lh); l = ll + lh; }
        if (hi == 0) xch[r32] = l;
        LDS_WAIT(); asm volatile("" ::: "memory");
#pragma unroll
        for (int r = 0; r < 16; ++r) { const int orow = 32 * wid + crow(r, hi); const float rl = rcpf_(xch[crow(r, hi)]);
            if (orow < nq) {
#pragma unroll
                for (int d0 = 0; d0 < 4; ++d0) Op[(size_t)orow * ldo + d0 * 32 + r32] = (bf16)(pk2(o[d0][r] * rl, 0.f) & 0xffffu); } }
    }
    __syncthreads();
}

DI void sbs_unit(LAS char* qlds  , const bf16* PROJ, const float* cK, const float* cV, const int* page_table, float bias, float* PO, float* PL, int db, int pg, int h, int lane) {
    const int r32 = lane & 31, hi = lane >> 5;
    const int phys = page_table[db * NPAGES + pg];
    const float* Kb = cK + (size_t)phys * PAGE * SBW + h * HD; const float* Vb = cV + (size_t)phys * PAGE * SBW + h * HD;
#pragma unroll
    for (int d0 = 0; d0 < 8; ++d0) { bf16x8 z = {0, 0, 0, 0, 0, 0, 0, 0}; const bf16x8 q = (r32 < TS) ? *(const GAS bf16x8*)(PROJ + (size_t)(MPR + db * TS + r32) * NIN + h * HD + d0 * 16 + hi * 8) : z;
        *(LAS bf16x8*)(qlds + d0 * 1024 + lane * 16) = q; }
    const float C = 0.08838834764831845f * LOG2E, bias2 = bias * LOG2E;
    f32x16 o[4];
#pragma unroll
    for (int d = 0; d < 4; ++d)
#pragma unroll
        for (int i = 0; i < 16; ++i) o[d][i] = 0.f;
    float carry = 0.f;
    f32x4 kraw[16];
#define SBS_LOADK(blk_) do { const GAS float* kr_ = (const GAS float*)(Kb + (size_t)((blk_) * 32 + r32) * SBW + 8 * hi); \
        _Pragma("unroll") for (int d0 = 0; d0 < 8; ++d0) { kraw[2 * d0] = *(const GAS f32x4*)(kr_ + 16 * d0); kraw[2 * d0 + 1] = *(const GAS f32x4*)(kr_ + 16 * d0 + 4); } } while (0)
#define SBS_LOADV(dst, ks_) do { const GAS float* vr_ = (const GAS float*)(Vb + (size_t)(key0 + 16 * (ks_) + 8 * hi) * SBW + r32); \
        _Pragma("unroll") for (int d0 = 0; d0 < 4; ++d0) _Pragma("unroll") for (int j = 0; j < 8; ++j) dst[d0][j] = vr_[(size_t)j * SBW + 32 * d0]; } while (0)
#define SBS_PV(src, pa_) do { _Pragma("unroll") for (int d0 = 0; d0 < 4; ++d0) { u32x4 w_ = {pk2(src[d0][0], src[d0][1]), pk2(src[d0][2], src[d0][3]), pk2(src[d0][4], src[d0][5]), pk2(src[d0][6], src[d0][7])}; \
        o[d0] = MFMA32(pa_, __builtin_bit_cast(bf16x8, w_), o[d0]); } } while (0)
#define SBS_BLOCK(blk_, NEXT) do { const int key0 = (blk_) * 32; float vA[4][8], vB[4][8]; \
        SBAR(); SBS_LOADV(vA, 0); SBAR(); \
        f32x16 p; _Pragma("unroll") for (int i = 0; i < 16; ++i) p[i] = 0.f; \
        _Pragma("unroll") for (int d0 = 0; d0 < 8; ++d0) { const f32x4 ka = kraw[2 * d0], kc = kraw[2 * d0 + 1]; \
            u32x4 w = {pk2(ka.x, ka.y), pk2(ka.z, ka.w), pk2(kc.x, kc.y), pk2(kc.z, kc.w)}; \
            const bf16x8 q = *(const LAS bf16x8*)(qlds + d0 * 1024 + lane * 16); \
            p = MFMA32(__builtin_bit_cast(bf16x8, w), q, p); } \
        SBAR(); SBS_LOADV(vB, 1); SBAR(); \
        sb_tile32(p, C, bias2, carry, hi); \
        bf16x8 pa0, pa1; PK4(p, 0, pa0); PK4(p, 8, pa1); \
        SBAR(); SBS_PV(vA, pa0); SBAR(); \
        if (NEXT) SBS_LOADK((blk_) - 1); \
        SBAR(); SBS_PV(vB, pa1); SBAR(); } while (0)
    SBS_LOADK(3);
#pragma nounroll
    for (int blk = 3; blk >= 1; --blk) SBS_BLOCK(blk, true);
    SBS_BLOCK(0, false);
#undef SBS_BLOCK
#undef SBS_LOADV
#undef SBS_PV
#undef SBS_LOADK
    const size_t ub = ((size_t)(db * NPAGES + pg) * SBH + h) * TS;
#pragma unroll
    for (int r = 0; r < 4; ++r) { const int q = crow(r, hi);
#pragma unroll
        for (int d0 = 0; d0 < 4; ++d0) PO[(ub + q) * HD + d0 * 32 + r32] = o[d0][r]; }
    if (lane < TS) PL[ub + lane] = carry;
}
DI void sbs_combine(const bf16* PROJ, const float* PO, const float* PL, float bias, bf16* ATT, int db, int h, int q, int lane) {
    const float C = 0.08838834764831845f * LOG2E, bias2 = bias * LOG2E;
    const size_t rowq = (size_t)(MPR + db * TS + q);
    const unsigned qw = *(const GAS unsigned*)(PROJ + rowq * NIN + h * HD + 2 * lane);
    const float q0 = bflo(qw), q1 = bfhi(qw);
    float o0 = 0.f, o1 = 0.f, carry = 0.f;
    for (int s = q - 1; s >= 0; --s) {
        const size_t rows = (size_t)(MPR + db * TS + s);
        const unsigned kw = *(const GAS unsigned*)(PROJ + rows * NIN + SBW + h * HD + 2 * lane), vw = *(const GAS unsigned*)(PROJ + rows * NIN + 2 * SBW + h * HD + 2 * lane);
        const float dot = wave_sum(q0 * bflo(kw) + q1 * bfhi(kw));
        const float z = fmaf(dot, C, bias2), e = ex2(z), ll = lg2(1.f + e), a = ex2(z - ll - carry);
        o0 = fmaf(a, bflo(vw), o0); o1 = fmaf(a, bfhi(vw), o1); carry += ll;
    }
    for (int pg0 = NPAGES - 16; pg0 >= 0; pg0 -= 16) {
        f32x2 po[16]; float pl[16];
#pragma unroll
        for (int i = 0; i < 16; ++i) { const size_t ub = ((size_t)(db * NPAGES + pg0 + 15 - i) * SBH + h) * TS + q; po[i] = *(const GAS f32x2*)(PO + ub * HD + 2 * lane); pl[i] = PL[ub]; }
#pragma unroll
        for (int i = 0; i < 16; ++i) { const float sc = ex2(-carry); o0 = fmaf(sc, po[i].x, o0); o1 = fmaf(sc, po[i].y, o1); carry += pl[i]; }
    }
    *(GAS unsigned*)(ATT + rowq * D + h * HD + 2 * lane) = pk2(o0, o1);
}
DI void gla_decode(int u, int& row0, int& h, int& nvalid) {
    if (u < 512) { const int b = u >> 8, rem = u & 255; h = rem & 3; row0 = b * TP + (rem >> 2) * 64; nvalid = 64; }
    else { const int su = u - 512; h = su & 3; row0 = MPR + (su >> 2) * TS; nvalid = TS; }
}
template <int KS> DI bf16x8 tr_frag_rt(unsigned vb) {
    const s16x4 l = tr_read<v_rd_off(0, KS, 0)>(vb), h = tr_read<v_rd_off(0, KS, 1)>(vb); asm volatile("s_waitcnt lgkmcnt(0)" ::: "memory"); SBAR(); return PKLH(l, h);
}
DI void gla_g1(LAS char* lds, int u, const bf16* PROJ, const float* LOW, const float* w_a2, const float* b_a, float* DST, float* DEC, float* GO, bf16* QDg, int tid) {
    int row0, h, nvalid; gla_decode(u, row0, h, nvalid);
    const int wid = __builtin_amdgcn_readfirstlane(tid >> 6), lane = tid & 63, r32 = lane & 31, hi = lane >> 5;
    LAS float* lowb = (LAS float*)lds; LAS float* gt = (LAS float*)(lds + 4096);
    LAS char* QDt = lds + 8192; LAS char* KDt = lds + 24576; LAS char* KEt = lds + 40960; LAS char* Vt0 = lds + 57344; LAS char* Vt1 = lds + 73728;
    if (tid < 256) { const int t = tid >> 2, j4 = (tid & 3) * 4; f32x4 v = {0.f, 0.f, 0.f, 0.f}; if (t < nvalid) v = *(const GAS f32x4*)(LOW + (size_t)(row0 + t) * 16 + j4); *(LAS f32x4*)(lowb + t * 16 + j4) = v; }
    { const int sr = tid >> 4, sc = (tid & 15) * 8; const bf16x8 z = {0, 0, 0, 0, 0, 0, 0, 0};
#pragma unroll
        for (int rr = 0; rr < 2; ++rr) { const int t = sr + 32 * rr; const bf16* vp = PROJ + (size_t)(row0 + t) * NIN + 4096 + h * GDV + sc;
            const bf16x8 a = (t < nvalid) ? *(const GAS bf16x8*)vp : z, b = (t < nvalid) ? *(const GAS bf16x8*)(vp + 128) : z;
            *(LAS bf16x8*)(Vt0 + v_st(t, sc)) = a; *(LAS bf16x8*)(Vt1 + v_st(t, sc)) = b; } }
    __syncthreads();
    const int c = tid & 127, tg = tid >> 7;
    float cs[16];
    { float wa[16];
#pragma unroll
        for (int j = 0; j < 16; ++j) wa[j] = w_a2[(size_t)j * GKW + h * GDK + c];
        const float ba = b_a[h * GDK + c]; float run = 0.f;
#pragma unroll
        for (int i = 0; i < 16; ++i) { const int t = 16 * tg + i; float pre = ba;
#pragma unroll
            for (int j4 = 0; j4 < 4; ++j4) { const f32x4 lw = *(const LAS f32x4*)(lowb + t * 16 + 4 * j4); pre += lw.x * wa[4 * j4] + lw.y * wa[4 * j4 + 1] + lw.z * wa[4 * j4 + 2] + lw.w * wa[4 * j4 + 3]; }
            const float la = (t < nvalid) ? -softplusf_(-pre) * (1.f / 16.f) : 0.f; run += la; cs[i] = run; }
        gt[tg * 128 + c] = run; }
    __syncthreads();
    { const float g0 = gt[c], g1 = gt[128 + c], g2 = gt[256 + c], g3 = gt[384 + c];
        const float off = (tg > 0 ? g0 : 0.f) + (tg > 1 ? g1 : 0.f) + (tg > 2 ? g2 : 0.f), blast = (g0 + g1) + (g2 + g3);
        if (tg == 0) DEC[(size_t)u * GDK + c] = ex2(blast * LOG2E);
#pragma unroll
        for (int i = 0; i < 16; ++i) { const int t = 16 * tg + i; const float b = cs[i] + off;
            float q = 0.f, k = 0.f;
            if (t < nvalid) { q = bf2f(PROJ[(size_t)(row0 + t) * NIN + 3072 + h * GDK + c]); k = bf2f(PROJ[(size_t)(row0 + t) * NIN + 3584 + h * GDK + c]); }
            const float eb = ex2(b * LOG2E), enb = ex2(-b * LOG2E), ele = ex2((blast - b) * LOG2E);
            const bf16 qd = (bf16)(pk2(q * 0.08838834764831845f * eb, 0.f) & 0xffffu), kd = (bf16)(pk2(k * enb, 0.f) & 0xffffu), ke = (bf16)(pk2(k * ele, 0.f) & 0xffffu);
            *(LAS bf16*)(QDt + KSWZ(t, 2 * c)) = qd; *(LAS bf16*)(KDt + KSWZ(t, 2 * c)) = kd; *(LAS bf16*)(KEt + v_st(t, c)) = ke;
            if (t < nvalid) QDg[(size_t)(row0 + t) * GKW + h * GDK + c] = qd; } }
    __syncthreads();
    if (wid < 4) { const int tblk = wid & 1, vt = wid >> 1;
        bf16x8 qr[8];
#pragma unroll
        for (int d0 = 0; d0 < 8; ++d0) qr[d0] = *(const LAS bf16x8*)(QDt + KSWZ(32 * tblk + r32, (d0 * 16 + hi * 8) * 2));
        f32x16 p0, p1; qkt(p0, p1, KDt, qr, r32, hi);
        const int t = 32 * tblk + r32;
#pragma unroll
        for (int r = 0; r < 16; ++r) { p0[r] = (crow(r, hi) <= t) ? p0[r] : 0.f; p1[r] = (32 + crow(r, hi) <= t) ? p1[r] : 0.f; }
        bf16x8 pa0, pa1, pa2, pa3; PK4(p0, 0, pa0); PK4(p0, 8, pa1); PK4(p1, 0, pa2); PK4(p1, 8, pa3);
        f32x16 o[4];
#pragma unroll
        for (int d = 0; d < 4; ++d)
#pragma unroll
            for (int i = 0; i < 16; ++i) o[d][i] = 0.f;
        pv_d0(o, (unsigned)(uintptr_t)(vt ? Vt1 : Vt0) + v_rd_base(lane), pa0, pa1, pa2, pa3);
#pragma unroll
        for (int r = 0; r < 16; ++r) { const int tt = 32 * tblk + crow(r, hi);
            if (tt < nvalid) {
#pragma unroll
                for (int d0 = 0; d0 < 4; ++d0) GO[(size_t)(row0 + tt) * GVW + h * GDV + 128 * vt + 32 * d0 + r32] = o[d0][r]; } } }
    { const unsigned va = (unsigned)(uintptr_t)((wid >> 2) ? Vt1 : Vt0) + v_rd_base(lane) + 512 * (wid & 3), kb = (unsigned)(uintptr_t)KEt + v_rd_base(lane);
        f32x16 acc[4];
#pragma unroll
        for (int d = 0; d < 4; ++d)
#pragma unroll
            for (int i = 0; i < 16; ++i) acc[d][i] = 0.f;
#define G1_KS(KS) do { const bf16x8 af = tr_frag_rt<KS>(va); \
        { const bf16x8 b0 = tr_frag_rt<KS>(kb), b1 = tr_frag_rt<KS>(kb + 512), b2 = tr_frag_rt<KS>(kb + 1024), b3 = tr_frag_rt<KS>(kb + 1536); \
          acc[0] = MFMA32(af, b0, acc[0]); acc[1] = MFMA32(af, b1, acc[1]); acc[2] = MFMA32(af, b2, acc[2]); acc[3] = MFMA32(af, b3, acc[3]); } } while (0)
        G1_KS(0); G1_KS(1); G1_KS(2); G1_KS(3);
#undef G1_KS
#pragma unroll
        for (int r = 0; r < 16; ++r) { const int dv = 32 * wid + crow(r, hi);
#pragma unroll
            for (int c0 = 0; c0 < 4; ++c0) DST[((size_t)u * GDV + dv) * GDK + 32 * c0 + r32] = acc[c0][r]; } }
    __syncthreads();
}
DI void gla_g2(const float* DST, const float* DEC, bf16* SIN, const float* state_gla, float* gla_p, float* gla_s, int gtid, int nthreads) {
    for (int e = gtid; e < 8 * 16384; e += nthreads) {
        const int chain = e >> 14, pr = e & 16383, idx = pr * 2, b = chain >> 2, h = chain & 3, c = idx & 127, dv = idx >> 7;
        float s0 = 0.f, s1 = 0.f;
        for (int n = 0; n < 64; ++n) { const size_t u = (size_t)b * 256 + n * 4 + h;
            *(GAS unsigned*)(SIN + u * 32768 + idx) = pk2(s0, s1);
            const f32x2 d = *(const GAS f32x2*)(DST + u * 32768 + idx), dc = *(const GAS f32x2*)(DEC + u * GDK + c);
            s0 = fmaf(s0, dc.x, d.x); s1 = fmaf(s1, dc.y, d.y); }
        float* o = gla_p + ((size_t)chain * GDK + c) * GDV + dv; o[0] = s0; o[GDV] = s1;
    }
    for (int e = gtid; e < 32 * 16384; e += nthreads) {
        const int chain = e >> 14, pr = e & 16383, idx = pr * 2, c = idx & 127, dv = idx >> 7; const size_t u = 512 + chain;
        const float* si = state_gla + ((size_t)chain * GDK + c) * GDV + dv;
        float s0 = si[0], s1 = si[GDV];
        *(GAS unsigned*)(SIN + u * 32768 + idx) = pk2(s0, s1);
        const f32x2 d = *(const GAS f32x2*)(DST + u * 32768 + idx), dc = *(const GAS f32x2*)(DEC + u * GDK + c);
        s0 = fmaf(s0, dc.x, d.x); s1 = fmaf(s1, dc.y, d.y);
        float* o = gla_s + ((size_t)chain * GDK + c) * GDV + dv; o[0] = s0; o[GDV] = s1;
    }
}
DI void gla_g3(LAS char* lds, int u, const bf16* PROJ, const bf16* QDg, const bf16* SIN, float* GO, const float* norm_w, bf16* ATT, int tid) {
    int row0, h, nvalid; gla_decode(u, row0, h, nvalid);
    const int wid = __builtin_amdgcn_readfirstlane(tid >> 6), lane = tid & 63, r32 = lane & 31, hi = lane >> 5;
    const int tblk = wid & 1, dq = wid >> 1;
    LAS float* ob = (LAS float*)lds;
    { const int t = 32 * tblk + r32; const bf16x8 z = {0, 0, 0, 0, 0, 0, 0, 0};
        f32x16 acc[2];
#pragma unroll
        for (int d = 0; d < 2; ++d)
#pragma unroll
            for (int i = 0; i < 16; ++i) acc[d][i] = 0.f;
#pragma unroll
        for (int ks = 0; ks < 8; ++ks) {
            const bf16x8 af = (t < nvalid) ? *(const GAS bf16x8*)(QDg + (size_t)(row0 + t) * GKW + h * GDK + 16 * ks + 8 * hi) : z;
#pragma unroll
            for (int nb = 0; nb < 2; ++nb) { const int dv = 64 * dq + 32 * nb + r32;
                const bf16x8 bfr = *(const GAS bf16x8*)(SIN + ((size_t)u * GDV + dv) * GDK + 16 * ks + 8 * hi);
                acc[nb] = MFMA32(af, bfr, acc[nb]); } }
#pragma unroll
        for (int r = 0; r < 16; ++r) { const int tt = 32 * tblk + crow(r, hi);
#pragma unroll
            for (int nb = 0; nb < 2; ++nb) { const int dv = 64 * dq + 32 * nb + r32;
                const float g = (tt < nvalid) ? GO[(size_t)(row0 + tt) * GVW + h * GDV + dv] : 0.f;
                ob[tt * 260 + dv] = acc[nb][r] + g;
#if MK_CHECK
                if (tt < nvalid) GO[(size_t)(row0 + tt) * GVW + h * GDV + dv] = acc[nb][r] + g;
#endif
            } } }
    __syncthreads();
    for (int i = 0; i < 8; ++i) { const int t = 8 * wid + i;
        if (t < nvalid) {
            const f32x4 v = *(const LAS f32x4*)(ob + t * 260 + 4 * lane);
            const float ss = wave_sum((v.x * v.x + v.y * v.y) + (v.z * v.z + v.w * v.w));
            const float rms = 1.f / sqrtf(ss * (1.f / GDV) + GLA_EPS);
            const f32x4 nw = *(const GAS f32x4*)(norm_w + 4 * lane);
            const u32x2 gw = *(const GAS u32x2*)(PROJ + (size_t)(row0 + t) * NIN + 5120 + h * GDV + 4 * lane);
            const float o0 = v.x * rms * nw.x * siluf_(bflo(gw.x)), o1 = v.y * rms * nw.y * siluf_(bfhi(gw.x)), o2 = v.z * rms * nw.z * siluf_(bflo(gw.y)), o3 = v.w * rms * nw.w * siluf_(bfhi(gw.y));
            u32x2 w; w.x = pk2(o0, o1); w.y = pk2(o2, o3);
            *(GAS u32x2*)(ATT + (size_t)(row0 + t) * D + SBW + h * GDV + 4 * lane) = w; } }
    __syncthreads();
}
constexpr int RCH = 16;
struct RwC { const float* PREP; const float* state_in; float* Y; float* rw_p; float* rw_s; };
DI void rwkv_prep(const bf16* PROJ, const float* L2, const float* w0, const float* a0, const float* k_k, const float* k_a, const float* r_k, float* PREP, float* BON, int gw, int NGW, int lane) {
    const int hg = gw & 7, hc = hg * 256 + lane * 4, h = hg * 4 + (lane >> 4), c4 = (lane & 15) * 4;
    const f32x4 cw0 = *(const GAS f32x4*)(w0 + hc), ca0 = *(const GAS f32x4*)(a0 + hc), ckk = *(const GAS f32x4*)(k_k + hc), cka = *(const GAS f32x4*)(k_a + hc), crk = *(const GAS f32x4*)(r_k + hc);
    constexpr int NB = 4;
    for (size_t row0 = (size_t)(gw >> 3); row0 < (size_t)MR; row0 += (size_t)NB * (NGW >> 3)) {
        u32x2 rwq[NB], kwq[NB], vwq[NB]; f32x4 wpq[NB], apq[NB]; bool ok[NB];
#pragma unroll
        for (int i = 0; i < NB; ++i) { const size_t row = row0 + (size_t)i * (NGW >> 3); ok[i] = row < (size_t)MR; const size_t rr = ok[i] ? row : row0;
            rwq[i] = *(const GAS u32x2*)(PROJ + rr * NIN + hc); kwq[i] = *(const GAS u32x2*)(PROJ + rr * NIN + 2048 + hc); vwq[i] = *(const GAS u32x2*)(PROJ + rr * NIN + 4096 + hc);
            wpq[i] = *(const GAS f32x4*)(L2 + rr * 6144 + hc); apq[i] = *(const GAS f32x4*)(L2 + rr * 6144 + 2048 + hc); }
#pragma unroll
        for (int i = 0; i < NB; ++i) { if (!ok[i]) break; const size_t row = row0 + (size_t)i * (NGW >> 3);
            const u32x2 rw_ = rwq[i], kw_ = kwq[i], vw_ = vwq[i]; const f32x4 wp = wpq[i], ap = apq[i];
            const f32x4 r = {bflo(rw_.x), bfhi(rw_.x), bflo(rw_.y), bfhi(rw_.y)}, k = {bflo(kw_.x), bfhi(kw_.x), bflo(kw_.y), bfhi(kw_.y)}, v = {bflo(vw_.x), bfhi(vw_.x), bflo(vw_.y), bfhi(vw_.y)};
            f32x4 dec, a, kk, k2;
#pragma unroll
            for (int j = 0; j < 4; ++j) { const float wlog = -softplusf_(-(wp[j] + cw0[j])) - 0.5f; dec[j] = ex2(-ex2(wlog * LOG2E) * LOG2E); a[j] = sigmoidf_(ap[j] + ca0[j]); kk[j] = k[j] * ckk[j]; k2[j] = k[j] * (1.f + (a[j] - 1.f) * cka[j]); }
            const float n2 = dpp_sum16((kk.x * kk.x + kk.y * kk.y) + (kk.z * kk.z + kk.w * kk.w)); const float rn = 1.f / sqrtf(fmaxf(n2, 1e-24f)); kk = kk * rn;
            const float bs = dpp_sum16((r.x * k2.x * crk.x + r.y * k2.y * crk.y) + (r.z * k2.z * crk.z + r.w * k2.w * crk.w));
            float* o = PREP + (row * RWH + h) * 384 + c4;
            *(GAS f32x4*)o = dec; *(GAS f32x4*)(o + 64) = kk; *(GAS f32x4*)(o + 128) = kk * a; *(GAS f32x4*)(o + 192) = k2; *(GAS f32x4*)(o + 256) = r; *(GAS f32x4*)(o + 320) = v;
            *(GAS f32x4*)(BON + row * D + hc) = v * bs; } }
}
DI void rwkv_unit(LAS char* lds, int u, const RwC& R, int tid) {
    const int wid = __builtin_amdgcn_readfirstlane(tid >> 6), lane = tid & 63;
    int row0, T, h, qt; const float* s_in = nullptr; float* s_out;
    if (u < 256) { const int hd = (u & 7) + 8 * (u >> 5), b = hd >> 5; h = hd & 31; qt = (u >> 3) & 3; row0 = b * TP; T = TP; s_out = R.rw_p + (size_t)(b * RWH + h) * 4096; }
    else { const int su = u - 256, db = su >> 7; h = (su >> 2) & 31; qt = su & 3; row0 = MPR + db * TS; T = TS; s_in = R.state_in + (size_t)(db * RWH + h) * 4096; s_out = R.rw_s + (size_t)(db * RWH + h) * 4096; }
    LAS float* inb = (LAS float*)lds;
    LAS float* ybuf = (LAS float*)(lds + 2 * RCH * 6 * 64 * 4);
    const int nch = (T + RCH - 1) / RCH;
    const int vrow = 16 * qt + 4 * wid + (lane >> 4), j4 = (lane & 15) * 4;
    f32x2 Sa = {0.f, 0.f}, Sb = {0.f, 0.f};
    if (wid < 4 && s_in) { const f32x4 S0 = *(const GAS f32x4*)(s_in + (size_t)vrow * 64 + j4); Sa = (f32x2){S0.x, S0.y}; Sb = (f32x2){S0.z, S0.w}; }
    f32x4 sg0[6], sg1[6], sg2[6];
    const int sl = (wid - 4) * 64 + lane;
#define RW_LOAD(ci, SG) do { const int t0_ = (ci) * RCH; \
        _Pragma("unroll") for (int i_ = 0; i_ < 6; ++i_) { const int pc = sl + 256 * i_, tk = pc / 96, wi = pc - tk * 96; SG[i_] = (f32x4){0.f, 0.f, 0.f, 0.f}; \
            if (t0_ + tk < T) SG[i_] = *(const GAS f32x4*)(R.PREP + ((size_t)(row0 + t0_ + tk) * RWH + h) * 384 + wi * 4); } } while (0)
#define RW_PROC(ci, SG) do { LAS float* ib_ = inb + ((ci) & 1) * (RCH * 6 * 64); \
        _Pragma("unroll") for (int i_ = 0; i_ < 6; ++i_) { const int pc = sl + 256 * i_; *(LAS f32x4*)(ib_ + pc * 4) = SG[i_]; } } while (0)
#define RW_YOUT(ci) do { const int t0_ = (ci) * RCH; const int nst_ = (T - t0_) < RCH ? (T - t0_) : RCH; const LAS float* yb_ = ybuf + ((ci) & 1) * (RCH * 256); \
        for (int idx = (wid - 4) * 64 + lane; idx < nst_ * 16; idx += 256) { const int tt = idx >> 4, rl = idx & 15; const LAS f32x4* p_ = (const LAS f32x4*)(yb_ + idx * 16); \
            const f32x4 a_ = p_[0], b_ = p_[1], c_ = p_[2], d_ = p_[3]; \
            R.Y[(size_t)(row0 + t0_ + tt) * D + h * 64 + 16 * qt + rl] = ((a_.x + a_.y) + (a_.z + a_.w)) + ((b_.x + b_.y) + (b_.z + b_.w)) + ((c_.x + c_.y) + (c_.z + c_.w)) + ((d_.x + d_.y) + (d_.z + d_.w)); } } while (0)
#define RW_LD(X, tt) do { const LAS float* p_ = ib + (tt) * 384; X##w = *(const LAS f32x4*)(p_ + j4); X##k = *(const LAS f32x4*)(p_ + 64 + j4); X##b = *(const LAS f32x4*)(p_ + 128 + j4); \
                X##q = *(const LAS f32x4*)(p_ + 192 + j4); X##r = *(const LAS f32x4*)(p_ + 256 + j4); X##v = p_[320 + vrow]; } while (0)
#define RW_STEP(X, tt) do { f32x2 d_ = Sa * (f32x2){X##k.x, X##k.y}; d_ = Sb * (f32x2){X##k.z, X##k.w} + d_; \
                const float sa = -dpp_sum16(d_.x + d_.y); \
                const f32x2 ta_ = (f32x2){X##b.x, X##b.y} * sa + (f32x2){X##q.x, X##q.y} * X##v, tb_ = (f32x2){X##b.z, X##b.w} * sa + (f32x2){X##q.z, X##q.w} * X##v; \
                Sa = Sa * (f32x2){X##w.x, X##w.y} + ta_; Sb = Sb * (f32x2){X##w.z, X##w.w} + tb_; \
                f32x2 y_ = Sa * (f32x2){X##r.x, X##r.y}; y_ = Sb * (f32x2){X##r.z, X##r.w} + y_; \
                yb[(tt) * 256 + wid * 64 + lane] = y_.x + y_.y; } while (0)
#define RW_SCAN(ci_) do { const int t0 = (ci_) * RCH; const int nst = (T - t0) < RCH ? (T - t0) : RCH; const LAS float* ib = inb + ((ci_) & 1) * (RCH * 6 * 64); LAS float* yb = ybuf + ((ci_) & 1) * (RCH * 256); \
        f32x4 Aw, Ak, Ab, Aq, Ar, Bw, Bk, Bb, Bq, Br, Cw, Ck, Cb, Cq, Cr; float Av, Bv, Cv; \
        if (nst == RCH) { RW_LD(A, 0); RW_LD(B, 1);        \
            _Pragma("unroll") for (int tt = 0; tt < RCH; tt += 3) { if (tt + 2 < RCH) RW_LD(C, tt + 2); RW_STEP(A, tt); if (tt + 3 < RCH) RW_LD(A, tt + 3); if (tt + 1 < RCH) RW_STEP(B, tt + 1); \
                if (tt + 4 < RCH) RW_LD(B, tt + 4); if (tt + 2 < RCH) RW_STEP(C, tt + 2); } } \
        else { for (int tt = 0; tt < nst; ++tt) { RW_LD(A, tt); RW_STEP(A, tt); } } } while (0)
    if (wid >= 4) { RW_LOAD(0, sg0); RW_PROC(0, sg0); if (nch > 1) RW_LOAD(1, sg1); if (nch > 2) RW_LOAD(2, sg2); if (nch > 3) RW_LOAD(3, sg0); }
    __syncthreads();
#define RW_ITER(ci, SG) do { if (wid >= 4) { if ((ci) + 1 < nch) RW_PROC((ci) + 1, SG); if ((ci) + 4 < nch) RW_LOAD((ci) + 4, SG); if ((ci) > 0) RW_YOUT((ci) - 1); } else { RW_SCAN(ci); } \
        asm volatile("s_waitcnt lgkmcnt(0)" ::: "memory"); __builtin_amdgcn_s_barrier(); asm volatile("" ::: "memory"); } while (0)
    for (int c3 = 0; c3 < nch; c3 += 3) {
        RW_ITER(c3, sg1);
        if (c3 + 1 < nch) RW_ITER(c3 + 1, sg2);
        if (c3 + 2 < nch) RW_ITER(c3 + 2, sg0);
    }
    if (wid >= 4) RW_YOUT(nch - 1);
    else *(GAS f32x4*)(s_out + (size_t)vrow * 64 + j4) = (f32x4){Sa.x, Sa.y, Sb.x, Sb.y};
    __syncthreads();
#undef RW_LOAD
#undef RW_ITER
#undef RW_SCAN
#undef RW_PROC
#undef RW_STEP
#undef RW_LD
#undef RW_YOUT
}
DI void rwkv_post(const float* Y, const float* BON, const float* G  , const float* ln_w, const float* ln_b, bf16* ATT, int gw, int NGW, int lane) {
    const int hc = (gw & 7) * 256 + lane * 4;
    const f32x4 lw = *(const GAS f32x4*)(ln_w + hc), lb = *(const GAS f32x4*)(ln_b + hc);
    for (size_t row0 = (size_t)(gw >> 3); row0 < (size_t)MR; row0 += (size_t)(NGW >> 1)) {
        f32x4 ya[4], ba[4], ga[4]; bool ok[4];
#pragma unroll
        for (int i = 0; i < 4; ++i) { const size_t row = row0 + (size_t)i * (NGW >> 3); ok[i] = row < (size_t)MR; const size_t rr = ok[i] ? row : row0;
            ya[i] = *(const GAS f32x4*)(Y + rr * D + hc); ba[i] = *(const GAS f32x4*)(BON + rr * D + hc); ga[i] = *(const GAS f32x4*)(G + rr * 6144 + hc); }
#pragma unroll
        for (int i = 0; i < 4; ++i) { if (!ok[i]) break; const size_t row = row0 + (size_t)i * (NGW >> 3); const f32x4 y = ya[i];
            const float mu = dpp_sum16((y.x + y.y) + (y.z + y.w)) * (1.f / 64.f); const f32x4 d = y - mu;
            const float var = dpp_sum16((d.x * d.x + d.y * d.y) + (d.z * d.z + d.w * d.w)) * (1.f / 64.f); const float rs = 1.f / sqrtf(var + RW_LN_EPS);
            const f32x4 out = (d * rs * lw + lb + ba[i]) * ga[i];
            u32x2 w; w.x = pk2(out.x, out.y); w.y = pk2(out.z, out.w); *(GAS u32x2*)(ATT + row * D + hc) = w; } }
}
DI void rwkv_mix(const bf16* XB, const float* mix, const float* shift_in, bf16* MIX, float* sh_p, float* sh_s, int gtid, int nthreads) {
    constexpr int RUN = 16, NRUN = MPR / RUN + DB;
    for (int it = gtid; it < NRUN * (D / 8); it += nthreads) { const int run = it >> 8, c = (it & 255) * 8;
        int row0, nrow, sq; if (run < MPR / RUN) { row0 = run * RUN; nrow = RUN; sq = -1; } else { sq = run - MPR / RUN; row0 = MPR + sq * TS; nrow = TS; }
        const int t0 = row0 < MPR ? (row0 & (TP - 1)) : 0;
        f32x4 mw[6][2];
#pragma unroll
        for (int m = 0; m < 6; ++m) { mw[m][0] = *(const GAS f32x4*)(mix + (size_t)m * D + c); mw[m][1] = *(const GAS f32x4*)(mix + (size_t)m * D + c + 4); }
        f32x4 p0 = {0.f, 0.f, 0.f, 0.f}, p1 = {0.f, 0.f, 0.f, 0.f};
        if (t0 > 0) { const u32x4 w = *(const GAS u32x4*)(XB + (size_t)(row0 - 1) * D + c); p0 = (f32x4){bflo(w.x), bfhi(w.x), bflo(w.y), bfhi(w.y)}; p1 = (f32x4){bflo(w.z), bfhi(w.z), bflo(w.w), bfhi(w.w)}; }
        else if (sq >= 0) { p0 = *(const GAS f32x4*)(shift_in + (size_t)sq * D + c); p1 = *(const GAS f32x4*)(shift_in + (size_t)sq * D + c + 4); }
        for (int i0 = 0; i0 < nrow; i0 += 8) {
            u32x4 xq[8];
#pragma unroll
            for (int i = 0; i < 8; ++i) xq[i] = *(const GAS u32x4*)(XB + (size_t)(row0 + i0 + i) * D + c);
#pragma unroll
            for (int i = 0; i < 8; ++i) { const int row = row0 + i0 + i; const u32x4 xw = xq[i];
                const f32x4 x0 = {bflo(xw.x), bfhi(xw.x), bflo(xw.y), bfhi(xw.y)}, x1 = {bflo(xw.z), bfhi(xw.z), bflo(xw.w), bfhi(xw.w)};
                const f32x4 d0 = p0 - x0, d1 = p1 - x1;
#pragma unroll
                for (int m = 0; m < 6; ++m) { const f32x4 a = x0 + d0 * mw[m][0], b = x1 + d1 * mw[m][1]; u32x4 w = {pk2(a.x, a.y), pk2(a.z, a.w), pk2(b.x, b.y), pk2(b.z, b.w)};
                    *(GAS u32x4*)(MIX + ((size_t)m * M + row) * D + c) = w; }
                p0 = x0; p1 = x1; } }
        const int last = row0 + nrow - 1;
        if (sq >= 0) { float* o = sh_s + (size_t)sq * D + c; *(GAS f32x4*)o = p0; *(GAS f32x4*)(o + 4) = p1; }
        else if ((last & (TP - 1)) == TP - 1) { float* o = sh_p + (size_t)(last >> 12) * D + c; *(GAS f32x4*)o = p0; *(GAS f32x4*)(o + 4) = p1; }
    }
}
DI void conv_rowload(const bf16* p, float (&x)[8]) { const u32x4 w = *(const GAS u32x4*)p; x[0] = bflo(w.x); x[1] = bfhi(w.x); x[2] = bflo(w.y); x[3] = bfhi(w.y); x[4] = bflo(w.z); x[5] = bfhi(w.z); x[6] = bflo(w.w); x[7] = bfhi(w.w); }
DI void conv_gate(const bf16* U, const float* cw, const float* cb, const float* conv0_s  , bf16* ACT, int gtid, int nthreads) {
    constexpr int RUN = 32, NRUN = MPR / RUN + DB, NCH = FF / 8;
    for (int it = gtid; it < NRUN * NCH; it += nthreads) { const int run = it / NCH, c = (it - run * NCH) * 8;
        int row0, nrow, sq; if (run < MPR / RUN) { row0 = run * RUN; nrow = RUN; sq = -1; } else { sq = run - MPR / RUN; row0 = MPR + sq * TS; nrow = TS; }
        const int t0 = row0 < MPR ? (row0 & (TP - 1)) : 0;
        float w[2][3][8], bsv[2][8], h1[2][8], h2[2][8];
#pragma unroll
        for (int hf = 0; hf < 2; ++hf) { const int cc = c + hf * FF;
#pragma unroll
            for (int tap = 0; tap < 3; ++tap) { const f32x4 a = *(const GAS f32x4*)(cw + (size_t)tap * F2 + cc), b = *(const GAS f32x4*)(cw + (size_t)tap * F2 + cc + 4);
                w[hf][tap][0] = a.x; w[hf][tap][1] = a.y; w[hf][tap][2] = a.z; w[hf][tap][3] = a.w; w[hf][tap][4] = b.x; w[hf][tap][5] = b.y; w[hf][tap][6] = b.z; w[hf][tap][7] = b.w; }
            { const f32x4 a = *(const GAS f32x4*)(cb + cc), b = *(const GAS f32x4*)(cb + cc + 4); bsv[hf][0] = a.x; bsv[hf][1] = a.y; bsv[hf][2] = a.z; bsv[hf][3] = a.w; bsv[hf][4] = b.x; bsv[hf][5] = b.y; bsv[hf][6] = b.z; bsv[hf][7] = b.w; }
            if (t0 > 0) { conv_rowload(U + (size_t)(row0 - 1) * F2 + cc, h1[hf]); conv_rowload(U + (size_t)(row0 - 2) * F2 + cc, h2[hf]); }
            else if (sq >= 0) { const float* s = conv0_s + (size_t)sq * 2 * F2 + cc;
#pragma unroll
                for (int i = 0; i < 8; ++i) { h2[hf][i] = s[i]; h1[hf][i] = s[F2 + i]; } }
            else {
#pragma unroll
                for (int i = 0; i < 8; ++i) { h1[hf][i] = 0.f; h2[hf][i] = 0.f; } } }
        for (int i0 = 0; i0 < nrow; i0 += 8) {
            u32x4 xv[8], xg[8];
#pragma unroll
            for (int i = 0; i < 8; ++i) { xv[i] = *(const GAS u32x4*)(U + (size_t)(row0 + i0 + i) * F2 + c); xg[i] = *(const GAS u32x4*)(U + (size_t)(row0 + i0 + i) * F2 + c + FF); }
#pragma unroll
            for (int i = 0; i < 8; ++i) { const int row = row0 + i0 + i; float x[2][8], o[8];
                { const u32x4 w_ = xv[i]; x[0][0] = bflo(w_.x); x[0][1] = bfhi(w_.x); x[0][2] = bflo(w_.y); x[0][3] = bfhi(w_.y); x[0][4] = bflo(w_.z); x[0][5] = bfhi(w_.z); x[0][6] = bflo(w_.w); x[0][7] = bfhi(w_.w); }
                { const u32x4 w_ = xg[i]; x[1][0] = bflo(w_.x); x[1][1] = bfhi(w_.x); x[1][2] = bflo(w_.y); x[1][3] = bfhi(w_.y); x[1][4] = bflo(w_.z); x[1][5] = bfhi(w_.z); x[1][6] = bflo(w_.w); x[1][7] = bfhi(w_.w); }
#pragma unroll
                for (int j = 0; j < 8; ++j) { const float val = bsv[0][j] + w[0][0][j] * h2[0][j] + w[0][1][j] * h1[0][j] + w[0][2][j] * x[0][j];
                    const float gat = bsv[1][j] + w[1][0][j] * h2[1][j] + w[1][1][j] * h1[1][j] + w[1][2][j] * x[1][j];
                    o[j] = siluf_(gat) * val; h2[0][j] = h1[0][j]; h1[0][j] = x[0][j]; h2[1][j] = h1[1][j]; h1[1][j] = x[1][j]; }
                u32x4 wv = {pk2(o[0], o[1]), pk2(o[2], o[3]), pk2(o[4], o[5]), pk2(o[6], o[7])};
                *(GAS u32x4*)(ACT + (size_t)row * FF + c) = wv; } }
    }
}
#ifndef MK_CHECK
#define MK_CHECK 0
#endif
#if MK_CHECK
DI void chk(unsigned* errs, int id, float got, float ref, float tol) {
    float e = fabsf(got - ref) / tol; if (!(e < 1e30f)) e = 1e30f;
    atomicMax(errs + id, __float_as_uint(e));
}
DI unsigned hsh(unsigned x) { x ^= x >> 16; x *= 0x7feb352dU; x ^= x >> 15; x *= 0x846ca68bU; x ^= x >> 16; return x; }
DI float naive_dot(const bf16* a, const bf16* b, int K) { float s = 0.f; for (int k = 0; k < K; ++k) s += bf2f(a[k]) * bf2f(b[k]); return s; }
DI float bfr(float x) { return bflo(pk2(x, 0.f) & 0xffffu); }
#endif
constexpr int NWAVES = 8, NTHREADS = 512;
constexpr size_t WS_WLOW = WS_END;
constexpr size_t WS_DBG = WS_WLOW + al((size_t)32 * D * 2);
constexpr size_t WS_PREP = WS_DBG + 4 * MiB;
constexpr size_t WS_TOTAL = WS_PREP + al((size_t)M * RWH * 384 * 4);
constexpr int NPH = 31;
struct Args { const float* in[43]; float* out; unsigned char* ws; int ph_lo, ph_hi, fused, pad; };
struct TrRow { int in_idx; long in_off; long ws_off; int ldw, Kr, Nr, ldt, npad; };
__device__ const TrRow TR_TABLE[NTR] = {
    {12, 0, (long)WS_WIN, NIN_FULL, D, NIN, D, NIN},
    {12, NIN, (long)WS_WLOW, NIN_FULL, D, 16, D, 32},
    {17, 0, (long)WS_WOUT, D, D, D, D, D},
    {19, 0, (long)WS_WRKV, D, D, D, D, D}, {19, (long)D * D, (long)(WS_WRKV + (size_t)D * D * 2), D, D, D, D, D}, {19, 2L * D * D, (long)(WS_WRKV + (size_t)2 * D * D * 2), D, D, D, D, D},
    {21, 0, (long)(WS_WRKV + (size_t)6144 * D * 2), 96, D, 96, D, 256}, {24, 0, (long)(WS_WRKV + (size_t)6400 * D * 2), 96, D, 96, D, 256}, {26, 0, (long)(WS_WRKV + (size_t)6656 * D * 2), 256, D, 256, D, 256},
    {22, 0, (long)WS_WL2, D, 96, D, 256, D}, {25, 0, (long)(WS_WL2 + (size_t)2048 * 256 * 2), D, 96, D, 256, D}, {27, 0, (long)(WS_WL2 + (size_t)4096 * 256 * 2), D, 256, D, 256, D},
    {33, 0, (long)WS_WO, D, D, D, D, D},
    {34, 0, (long)WS_WQ, MW, D, MW, D, MW}, {34, (long)D * MW, (long)(WS_WQ + (size_t)MW * D * 2), MW, D, MW, D, MW},
    {35, 0, (long)WS_WKV, 1024, D, 1024, D, 1024}, {35, (long)D * 1024, (long)(WS_WKV + (size_t)1024 * D * 2), 1024, D, 1024, D, 1024},
    {36, 0, (long)WS_WCO, D, MW, D, MW, D}, {36, (long)MW * D, (long)(WS_WCO + (size_t)D * MW * 2), D, MW, D, MW, D},
    {37, 0, (long)WS_WUP, F2, D, F2, D, F2}, {37, (long)D * F2, (long)(WS_WUP + (size_t)F2 * D * 2), F2, D, F2, D, F2},
    {40, 0, (long)WS_WDN, D, FF, D, FF, D}, {40, (long)FF * D, (long)(WS_WDN + (size_t)D * FF * 2), D, FF, D, FF, D},
};
DI int tr_items(int d) { return (TR_TABLE[d].ldt / 64) * (TR_TABLE[d].npad / 32); }
DI TrDesc make_desc(unsigned char* ws, int d) { const TrRow r = TR_TABLE[d]; TrDesc t; t.W = inp(r.in_idx) + r.in_off; t.WT = (bf16*)(ws + r.ws_off); t.ldw = r.ldw; t.Kr = r.Kr; t.Nr = r.Nr; t.ldt = r.ldt; t.nblk = r.npad / 32; t.start = 0; return t; }

struct FInProj { bf16* PROJ; float* out;
    DI void operator()(int row, int col, f32x4 v0, f32x4 v1, int pn) const {
        u32x4 w = {pk2(v0.x, v0.y), pk2(v0.z, v0.w), pk2(v1.x, v1.y), pk2(v1.z, v1.w)};
        *(GAS u32x4*)(PROJ + (size_t)row * NIN + col) = w;
        if (pn >= 4 && pn < 12 && row < MR) { const int kv = col >= 2048; const int cc = col - 1024 - kv * 1024;
            float* o = row < MPR ? out + (kv ? O_SBVP : O_SBKP) + (size_t)row * SBW + cc : out + (kv ? O_SBVS : O_SBKS) + (size_t)(row - MPR) * SBW + cc;
            *(GAS f32x4*)o = v0; *(GAS f32x4*)(o + 4) = v1; } }
    DI void sk(int row, int col, f32x4 v, int pn) const {
        u32x2 w = {pk2(v.x, v.y), pk2(v.z, v.w)}; *(GAS u32x2*)(PROJ + (size_t)row * NIN + col) = w;
        if (pn >= 4 && pn < 12) { const int kv = col >= 2048; const int cc = col - 1024 - kv * 1024; *(GAS f32x4*)(out + (kv ? O_SBVS : O_SBKS) + (size_t)(row - MPR) * SBW + cc) = v; } } };
struct FResid { const bf16* XB; bf16* HB;
    DI void operator()(int row, int col, f32x4 v0, f32x4 v1, int) const { const u32x4 x = *(const GAS u32x4*)(XB + (size_t)row * D + col);
        u32x4 w = {pk2(bflo(x.x) * ALPHA + v0.x, bfhi(x.x) * ALPHA + v0.y), pk2(bflo(x.y) * ALPHA + v0.z, bfhi(x.y) * ALPHA + v0.w), pk2(bflo(x.z) * ALPHA + v1.x, bfhi(x.z) * ALPHA + v1.y), pk2(bflo(x.w) * ALPHA + v1.z, bfhi(x.w) * ALPHA + v1.w)};
        *(GAS u32x4*)(HB + (size_t)row * D + col) = w; }
    DI void sk(int row, int col, f32x4 v, int) const { const u32x2 x = *(const GAS u32x2*)(XB + (size_t)row * D + col);
        u32x2 w = {pk2(bflo(x.x) * ALPHA + v.x, bfhi(x.x) * ALPHA + v.y), pk2(bflo(x.y) * ALPHA + v.z, bfhi(x.y) * ALPHA + v.w)}; *(GAS u32x2*)(HB + (size_t)row * D + col) = w; } };
struct FBf16 { bf16* O; int ld;
    DI void operator()(int row, int col, f32x4 v0, f32x4 v1, int) const { u32x4 w = {pk2(v0.x, v0.y), pk2(v0.z, v0.w), pk2(v1.x, v1.y), pk2(v1.z, v1.w)}; *(GAS u32x4*)(O + (size_t)row * ld + col) = w; }
    DI void sk(int row, int col, f32x4 v, int) const { u32x2 w = {pk2(v.x, v.y), pk2(v.z, v.w)}; *(GAS u32x2*)(O + (size_t)row * ld + col) = w; } };
struct FMemKV { bf16* MEMKV; float* out;
    DI void operator()(int row, int col, f32x4 v0, f32x4 v1, int) const { u32x4 w = {pk2(v0.x, v0.y), pk2(v0.z, v0.w), pk2(v1.x, v1.y), pk2(v1.z, v1.w)}; *(GAS u32x4*)(MEMKV + (size_t)row * D + col) = w;
        const int layer = col >> 10, kv = (col >> 9) & 1, cc = col & 511; float* o = out + (kv ? O_MVP : O_MKP) + ((size_t)layer * 512 + row) * MW + cc; *(GAS f32x4*)o = v0; *(GAS f32x4*)(o + 4) = v1; } };
struct FUp { bf16* U; float* out; int layer;
    DI void operator()(int row, int col, f32x4 v0, f32x4 v1, int) const { u32x4 w = {pk2(v0.x, v0.y), pk2(v0.z, v0.w), pk2(v1.x, v1.y), pk2(v1.z, v1.w)}; *(GAS u32x4*)(U + (size_t)row * F2 + col) = w;
        float* o = nullptr;
        if (row < MPR) { const int t = row & (TP - 1); if (t >= TP - 2) o = out + O_CONVP + ((size_t)(layer * BP + (row >> 12)) * 2 + (t - (TP - 2))) * F2 + col; }
        else if (row < MR) { const int t = (row - MPR) & 7; if (t >= TS - 2) o = out + O_CONVS + ((size_t)(layer * DB + ((row - MPR) >> 3)) * 2 + (t - (TS - 2))) * F2 + col; }
        if (o) { *(GAS f32x4*)o = v0; *(GAS f32x4*)(o + 4) = v1; } }
    DI void sk(int row, int col, f32x4 v, int) const { u32x2 w = {pk2(v.x, v.y), pk2(v.z, v.w)}; *(GAS u32x2*)(U + (size_t)row * F2 + col) = w;
        const int t = (row - MPR) & 7; if (t >= TS - 2) *(GAS f32x4*)(out + O_CONVS + ((size_t)(layer * DB + ((row - MPR) >> 3)) * 2 + (t - (TS - 2))) * F2 + col) = v; } };
struct FRkv { bf16* PROJ; bf16* L1;
    DI void operator()(int row, int col, f32x4 v0, f32x4 v1, int pn) const {
        if (pn < 24) { u32x4 w = {pk2(v0.x, v0.y), pk2(v0.z, v0.w), pk2(v1.x, v1.y), pk2(v1.z, v1.w)}; *(GAS u32x4*)(PROJ + (size_t)row * NIN + col) = w; }
        else { float x[8] = {v0.x, v0.y, v0.z, v0.w, v1.x, v1.y, v1.z, v1.w};
#pragma unroll
            for (int i = 0; i < 8; ++i) x[i] = pn == 24 ? tanhf_(x[i]) : (pn == 26 ? sigmoidf_(x[i]) : x[i]);
            u32x4 w = {pk2(x[0], x[1]), pk2(x[2], x[3]), pk2(x[4], x[5]), pk2(x[6], x[7])}; *(GAS u32x4*)(L1 + (size_t)row * 768 + (col - NIN)) = w; } }
    DI void sk(int row, int col, f32x4 v, int pn) const {
        if (pn < 24) { u32x2 w = {pk2(v.x, v.y), pk2(v.z, v.w)}; *(GAS u32x2*)(PROJ + (size_t)row * NIN + col) = w; }
        else { float x[4] = {v.x, v.y, v.z, v.w};
#pragma unroll
            for (int i = 0; i < 4; ++i) x[i] = pn == 24 ? tanhf_(x[i]) : (pn == 26 ? sigmoidf_(x[i]) : x[i]);
            u32x2 w = {pk2(x[0], x[1]), pk2(x[2], x[3])}; *(GAS u32x2*)(L1 + (size_t)row * 768 + (col - NIN)) = w; } } };
struct FL2 { float* L2;
    DI void operator()(int row, int col, f32x4 v, int) const { *(GAS f32x4*)(L2 + (size_t)row * 6144 + col) = v; }
    DI void sk(int row, int col, f32x4 v, int pn) const { (*this)(row, col, v, pn); } };
struct RkvOrder : pg8::StaticOrder { DI size_t a_off(int pn) const { const int idx = pn < 8 ? 0 : pn < 16 ? 2 : pn < 24 ? 3 : pn == 24 ? 1 : pn == 25 ? 4 : 5; return (size_t)idx * M * D * 2; } };
struct L2Order : pg8::StaticOrder { DI size_t a_off(int pn) const { return (size_t)(pn >> 3) * 256 * 2; } };

DI void low_task(const bf16* XB, const bf16* Wlow_t, float* LOW, int task, int lane) {
    const int fr = lane & 15, fq = lane >> 4; const size_t row = (size_t)task * 16 + fr;
    f32x4 acc = {0.f, 0.f, 0.f, 0.f};
#pragma unroll 8
    for (int ks = 0; ks < 64; ++ks) { const bf16x8 a = *(const GAS bf16x8*)(XB + row * D + 32 * ks + 8 * fq), b = *(const GAS bf16x8*)(Wlow_t + (size_t)fr * D + 32 * ks + 8 * fq);
        acc = __builtin_amdgcn_mfma_f32_16x16x32_bf16(b, a, acc, 0, 0, 0); }
    *(GAS f32x4*)(LOW + row * 16 + 4 * fq) = acc;
}

template <class F, class Sched> DI void skinny_gemm(LAS char* lds, const bf16* A, int lda, const bf16* Bt, int N, int K, const Sched& S, const F& f, int G, int bx, int tid) {
    const int wid = __builtin_amdgcn_readfirstlane(tid >> 6), lane = tid & 63, fr = lane & 15, fq = lane >> 4;
    LAS f32x4* red = (LAS f32x4*)lds;
    const int nstrips = N / 16, nks = K / 32;
    for (int s = G - 1 - bx; s < nstrips; s += G) {
        const int n0 = s * 16, pn = n0 >> 8;
        const bf16* Ab = (const bf16*)((const char*)A + S.a_off(pn)) + (size_t)(MPR + fr) * lda + 8 * fq;
        const bf16* Bb = Bt + (size_t)(n0 + fr) * K + 8 * fq;
        f32x4 acc[4];
#pragma unroll
        for (int mb = 0; mb < 4; ++mb) acc[mb] = (f32x4){0.f, 0.f, 0.f, 0.f};
#pragma unroll 8
        for (int ks = wid; ks < nks; ks += 8) {
            const bf16x8 b = *(const GAS bf16x8*)(Bb + 32 * ks);
#pragma unroll
            for (int mb = 0; mb < 4; ++mb) { const bf16x8 a = *(const GAS bf16x8*)(Ab + (size_t)(16 * mb) * lda + 32 * ks); acc[mb] = __builtin_amdgcn_mfma_f32_16x16x32_bf16(b, a, acc[mb], 0, 0, 0); } }
#pragma unroll
        for (int mb = 0; mb < 4; ++mb) red[(wid * 4 + mb) * 64 + lane] = acc[mb];
        __syncthreads();
        if (wid < 4) { f32x4 v = red[wid * 64 + lane];
#pragma unroll
            for (int w = 1; w < 8; ++w) v += red[(w * 4 + wid) * 64 + lane];
            f.sk(MPR + 16 * wid + fr, n0 + 4 * fq, v, pn); }
        __syncthreads();
    }
}
#if MK_CHECK
struct Ck { unsigned* errs; int gtid, NT, tid, bx, G; LAS char* lds; };
DI void ck_p0(const Ck& k, const Args& a, const bf16* XB, const bf16* MEMB, const bf16* CMK, const bf16* CMV) {
    for (int i = k.gtid; i < NTR * 64; i += k.NT) { const TrDesc d = make_desc(a.ws, i / 64);
        const int n = hsh(i) % (d.nblk * 32), kk = hsh(i + 7777) % d.ldt;
        const float ref = (kk < d.Kr && n < d.Nr) ? bfr(d.W[(size_t)kk * d.ldw + n]) : 0.f;
        chk(k.errs, 10, bf2f(d.WT[(size_t)n * d.ldt + kk]), ref, 1e-6f); }
    for (int i = k.gtid; i < 1024; i += k.NT) { const int row = hsh(i + 11) % MR, col = hsh(i + 13) % D;
        const float src = row < MPR ? inp(0)[(size_t)row * D + col] : inp(1)[(size_t)(row - MPR) * D + col];
        chk(k.errs, 11, bf2f(XB[(size_t)row * D + col]), bfr(src), 1e-6f);
        const int mr = hsh(i + 17) % 512; chk(k.errs, 11, bf2f(MEMB[(size_t)mr * D + col]), bfr(inp(2)[(size_t)mr * D + col]), 1e-6f);
        const size_t ci = hsh(i + 19) % (2u * DB * NMEM * MW); chk(k.errs, 11, bf2f(CMK[ci]), bfr(inp(10)[ci]), 1e-6f); chk(k.errs, 11, bf2f(CMV[ci]), bfr(inp(11)[ci]), 1e-6f); }
}
DI void ck_p1(const Ck& k, const Args& a, const bf16* XB, const bf16* Win, const bf16* PROJ, const float* LOW) {
    for (int i = k.gtid; i < 2048; i += k.NT) { const int row = (i & 7) ? hsh(i) % MR : MPR + hsh(i) % MSR, col = hsh(i + 5) % NIN;
        const float ref = naive_dot(XB + (size_t)row * D, Win + (size_t)col * D, D);
        chk(k.errs, 12, bf2f(PROJ[(size_t)row * NIN + col]), ref, 0.05f);
        if (col >= 1024 && col < 3072) { const int kv = col >= 2048, cc = col - 1024 - kv * 1024;
            const float o = row < MPR ? a.out[(kv ? O_SBVP : O_SBKP) + (size_t)row * SBW + cc] : a.out[(kv ? O_SBVS : O_SBKS) + (size_t)(row - MPR) * SBW + cc];
            chk(k.errs, 12, o, ref, 0.05f); } }
    for (int i = k.gtid; i < 1024; i += k.NT) { const int row = hsh(i + 3) % MR, j = i & 15; float s = 0.f;
        for (int c = 0; c < D; ++c) s += bf2f(XB[(size_t)row * D + c]) * bfr(inp(12)[(size_t)c * NIN_FULL + NIN + j]);
        chk(k.errs, 13, LOW[(size_t)row * 16 + j], s, 0.05f); }
}
DI void ck_sbp(const Ck& k, const Args& a, const bf16* PROJ, const bf16* ATT) {
    const int tl[12] = {0, 1, 2, 63, 64, 65, 255, 256, 1000, 2047, 3000, 4095};
    LAS float* zb = (LAS float*)k.lds;
    for (int i = k.bx; i < 24; i += k.G) { const int b = i & 1, h = (i * 3) & 7, t = tl[i % 12];
        const bf16* Q = PROJ + (size_t)(b * TP + t) * NIN + h * HD; const float bias = inp(13)[h];
        for (int s = k.tid; s < t; s += NTHREADS) { const float dot = naive_dot(Q, PROJ + (size_t)(b * TP + s) * NIN + SBW + h * HD, HD); zb[s] = (dot * 0.08838834764831845f + bias) * LOG2E; }
        __syncthreads();
        if (k.tid == 0) { float tail = 0.f; for (int s = t - 1; s >= 0; --s) { const float z = zb[s], l = lg2(1.f + ex2(z)); zb[s] = ex2(z - l - tail); tail += l; } }
        __syncthreads();
        if (k.tid < HD) { float o = 0.f; for (int s = 0; s < t; ++s) o += zb[s] * bf2f(PROJ[(size_t)(b * TP + s) * NIN + 2 * SBW + h * HD + k.tid]);
            chk(k.errs, 14, bf2f(ATT[(size_t)(b * TP + t) * D + h * HD + k.tid]), o, 0.02f); }
        __syncthreads(); }
}
DI void ck_sbs(const Ck& k, const Args& a, const bf16* PROJ, const bf16* ATT) {
    LAS float* zb = (LAS float*)k.lds; const int* pt = (const int*)inp(5);
    for (int i = k.bx; i < 16; i += k.G) { const int db = i & 7, h = (i * 5 + 1) & 7, q = (i * 3) & 7;
        const bf16* Q = PROJ + (size_t)(MPR + db * TS + q) * NIN + h * HD; const float bias = inp(13)[h]; const int nk = PAST + q;
        for (int s = k.tid; s < nk; s += NTHREADS) { float dot = 0.f;
            if (s < PAST) { const float* kr = inp(3) + ((size_t)pt[db * NPAGES + (s >> 7)] * PAGE + (s & 127)) * SBW + h * HD; for (int d = 0; d < HD; ++d) dot += bf2f(Q[d]) * bfr(kr[d]); }
            else dot = naive_dot(Q, PROJ + (size_t)(MPR + db * TS + (s - PAST)) * NIN + SBW + h * HD, HD);
            zb[s] = (dot * 0.08838834764831845f + bias) * LOG2E; }
        __syncthreads();
        if (k.tid == 0) { float tail = 0.f; for (int s = nk - 1; s >= 0; --s) { const float z = zb[s], l = lg2(1.f + ex2(z)); zb[s] = ex2(z - l - tail); tail += l; } }
        __syncthreads();
        if (k.tid < HD) { float o = 0.f;
            for (int s = 0; s < nk; ++s) { float v;
                if (s < PAST) v = bfr(inp(4)[((size_t)pt[db * NPAGES + (s >> 7)] * PAGE + (s & 127)) * SBW + h * HD + k.tid]); else v = bf2f(PROJ[(size_t)(MPR + db * TS + (s - PAST)) * NIN + 2 * SBW + h * HD + k.tid]);
                o += zb[s] * v; }
            chk(k.errs, 15, bf2f(ATT[(size_t)(MPR + db * TS + q) * D + h * HD + k.tid]), o, 0.02f); }
        __syncthreads(); }
}
DI void ck_gla(const Ck& k, const Args& a, const bf16* PROJ, const float* LOW, const float* GO) {
    const int wid = k.tid >> 6, lane = k.tid & 63; LAS float* sh = (LAS float*)k.lds + wid * 512;
    for (int i = k.bx * NWAVES + wid; i < 8; i += k.G * NWAVES) {
        int row0, T, h, dvg; float S[128]; const float* s_in = nullptr; const float* s_out;
        if (i < 4) { const int b = i & 1; h = (i * 3) & 3; dvg = (i + 1) & 3; row0 = b * TP; T = TP; s_out = a.out + O_GLAP + (size_t)(b * GH + h) * GDK * GDV; }
        else { const int db = (i * 3) & 7; h = i & 3; dvg = (i + 2) & 3; row0 = MPR + db * TS; T = TS; s_in = inp(6) + (size_t)(db * GH + h) * GDK * GDV; s_out = a.out + O_GLAS + (size_t)(db * GH + h) * GDK * GDV; }
        const int dv = dvg * 64 + lane;
#pragma unroll
        for (int c = 0; c < 128; ++c) S[c] = s_in ? s_in[(size_t)c * GDV + dv] : 0.f;
        for (int t = 0; t < T; ++t) { const size_t row = (size_t)(row0 + t);
#pragma unroll
            for (int cc = 0; cc < 2; ++cc) { const int c = lane + 64 * cc; float pre = inp(15)[h * GDK + c];
                for (int j = 0; j < 16; ++j) pre += LOW[row * 16 + j] * inp(14)[(size_t)j * GKW + h * GDK + c];
                sh[c] = expf(-softplusf_(-pre) * (1.f / 16.f)); sh[128 + c] = bf2f(PROJ[row * NIN + 3072 + h * GDK + c]) * 0.08838834764831845f; sh[256 + c] = bf2f(PROJ[row * NIN + 3584 + h * GDK + c]); }
            LDS_WAIT(); asm volatile("" ::: "memory");
            const float v = bf2f(PROJ[row * NIN + 4096 + h * GDV + dv]); float o = 0.f;
#pragma unroll
            for (int c = 0; c < 128; ++c) { S[c] = S[c] * sh[c] + sh[256 + c] * v; o += sh[128 + c] * S[c]; }
            LDS_WAIT(); asm volatile("" ::: "memory");
            chk(k.errs, 16, GO[row * GVW + h * GDV + dv], o, 1.0f); }
#pragma unroll
        for (int c = 0; c < 128; ++c) chk(k.errs, 17, s_out[(size_t)c * GDV + dv], S[c], 0.3f);
    }
}
DI void ck_gla_norm(const Ck& k, const Args& a, const bf16* PROJ, const float* GO, const bf16* ATT) {
    for (int i = k.gtid; i < 512; i += k.NT) { const int row = (i & 3) ? hsh(i) % MR : MPR + hsh(i) % MSR, h = i & 3, dv = hsh(i + 9) & 255; float ss = 0.f;
        for (int j = 0; j < GDV; ++j) { const float g = GO[(size_t)row * GVW + h * GDV + j]; ss += g * g; }
        const float ref = GO[(size_t)row * GVW + h * GDV + dv] / sqrtf(ss / GDV + GLA_EPS) * inp(16)[dv] * siluf_(bf2f(PROJ[(size_t)row * NIN + 5120 + h * GDV + dv]));
        chk(k.errs, 18, bf2f(ATT[(size_t)row * D + SBW + h * GDV + dv]), ref, 0.03f); }
}
template <class FA, class FG> DI void ck_gemm(const Ck& k, int id, int nrows_lo, int nrows, int N, int K, const bf16* Bt, FA fa, FG fg, float tol, unsigned salt) {
    for (int i = k.gtid; i < 1024; i += k.NT) { const int row = nrows_lo + hsh(i + salt) % nrows, col = hsh(i + salt + 99) % N;
        const float ref = naive_dot(fa(row, col), Bt + (size_t)col * K, K); chk(k.errs, id, fg(row, col, ref), 0.f, tol); }
}
DI void ck_ln(const Ck& k, int id, const bf16* HPRE, const float* gw, const float* gb, const bf16* of) {
    for (int i = k.gtid; i < 512; i += k.NT) { const int row = (i & 3) ? hsh(i + 1) % MR : MPR + hsh(i) % MSR, col = hsh(i + 2) % D; float s = 0.f, s2 = 0.f;
        for (int c = 0; c < D; ++c) s += bf2f(HPRE[(size_t)row * D + c]); const float mu = s / D;
        for (int c = 0; c < D; ++c) { const float d = bf2f(HPRE[(size_t)row * D + c]) - mu; s2 += d * d; }
        const float ref = (bf2f(HPRE[(size_t)row * D + col]) - mu) / sqrtf(s2 / D + LN_EPS) * gw[col] + gb[col];
        chk(k.errs, id, bf2f(of[(size_t)row * D + col]), ref, 0.03f); }
}
DI void ck_mem(const Ck& k, int id, const bf16* QM, const bf16* MEMKV, const bf16* CMK, const bf16* CMV, const bf16* OM, int L) {
    const int wid = k.tid >> 6, lane = k.tid & 63;
    for (int i = k.bx * NWAVES + wid; i < 64; i += k.G * NWAVES) { const int row = (i & 3) ? hsh(i + 31) % MR : MPR + hsh(i) % MSR, h = i & 3;
        const bf16 *Kp, *Vp; size_t ld;
        if (row < MPR) { Kp = MEMKV + (size_t)((row >> 12) * NMEM) * D + L * 1024 + h * HD; Vp = Kp + 512; ld = D; }
        else { const int db = (row - MPR) >> 3; Kp = CMK + (size_t)((L * DB + db) * NMEM) * MW + h * HD; Vp = CMV + (size_t)((L * DB + db) * NMEM) * MW + h * HD; ld = MW; }
        float s[4], mx = -1e30f;
        for (int j = 0; j < 4; ++j) { s[j] = naive_dot(QM + (size_t)row * MW + h * HD, Kp + (size_t)(lane + 64 * j) * ld, HD) * 0.08838834764831845f; mx = fmaxf(mx, s[j]); }
        for (int o = 1; o < 64; o <<= 1) mx = fmaxf(mx, __shfl_xor(mx, o));
        float den = 0.f; for (int j = 0; j < 4; ++j) { s[j] = expf(s[j] - mx); den += s[j]; } den = wave_sum(den);
        for (int d = 0; d < HD; ++d) { float acc = 0.f; for (int j = 0; j < 4; ++j) acc += bfr(s[j] / den) * bf2f(Vp[(size_t)(lane + 64 * j) * ld + d]); acc = wave_sum(acc);
            if (lane == 0) chk(k.errs, id, bf2f(OM[(size_t)row * MW + h * HD + d]), acc, 0.02f); } }
}
DI void ck_conv(const Ck& k, int id, const Args& a, const bf16* U, const bf16* ACT, int L) {
    for (int i = k.gtid; i < 2048; i += k.NT) { int row = (i & 3) ? hsh(i + 41) % MR : MPR + hsh(i) % MSR; if ((i & 15) == 5) row = (i & 16) ? TP : 1; const int c = hsh(i + 43) % FF;
        int t, sq; if (row < MPR) { t = row & (TP - 1); sq = -1; } else { t = (row - MPR) & 7; sq = (row - MPR) >> 3; }
        float cv[2];
        for (int half = 0; half < 2; ++half) { const int cc = c + half * FF; float acc = inp(39)[(size_t)L * F2 + cc];
            for (int tap = 0; tap < 3; ++tap) { const int ts = t - 2 + tap; float x = 0.f;
                if (ts >= 0) x = bf2f(U[(size_t)(row - 2 + tap) * F2 + cc]); else if (sq >= 0) x = inp(9)[((size_t)(L * DB + sq) * 2 + (ts + 2)) * F2 + cc];
                acc += inp(38)[((size_t)L * 3 + tap) * F2 + cc] * x; }
            cv[half] = acc; }
        chk(k.errs, id, bf2f(ACT[(size_t)row * FF + c]), siluf_(cv[1]) * cv[0], 0.03f); }
}
DI void ck_mix(const Ck& k, const Args& a, const bf16* XB, const bf16* MIX) {
    for (int i = k.gtid; i < 2048; i += k.NT) { int row = (i & 3) ? hsh(i + 51) % MR : MPR + hsh(i) % MSR; if ((i & 15) == 5) row = (i & 16) ? TP : 0; const int c = hsh(i + 53) % D, m = i % 6;
        int t, sq; if (row < MPR) { t = row & (TP - 1); sq = -1; } else { t = (row - MPR) & 7; sq = (row - MPR) >> 3; }
        const float x = bf2f(XB[(size_t)row * D + c]); const float xp = t > 0 ? bf2f(XB[(size_t)(row - 1) * D + c]) : (sq >= 0 ? inp(8)[(size_t)sq * D + c] : 0.f);
        chk(k.errs, 28, bf2f(MIX[((size_t)m * M + row) * D + c]), x + (xp - x) * inp(18)[(size_t)m * D + c], 0.02f); }
}
DI void ck_rwkv(const Ck& k, const Args& a, const bf16* PROJ, const float* L2, const float* Y, const float* BON) {
    const int wid = k.tid >> 6, lane = k.tid & 63; LAS float* sh = (LAS float*)k.lds + wid * 512;
    for (int i = k.bx * NWAVES + wid; i < 8; i += k.G * NWAVES) {
        int row0, T, h; const float* s_in = nullptr; const float* s_out;
        if (i < 3) { const int b = i & 1; h = (i * 11 + 5) & 31; row0 = b * TP; T = TP; s_out = a.out + O_RWP + (size_t)(b * RWH + h) * 4096; }
        else { const int db = (i * 3) & 7; h = (i * 7 + 2) & 31; row0 = MPR + db * TS; T = TS; s_in = inp(7) + (size_t)(db * RWH + h) * 4096; s_out = a.out + O_RWS + (size_t)(db * RWH + h) * 4096; }
        const int hc = h * 64 + lane; float S[64];
#pragma unroll
        for (int c = 0; c < 64; ++c) S[c] = s_in ? s_in[(size_t)lane * 64 + c] : 0.f;
        for (int t = 0; t < T; ++t) { const size_t row = (size_t)(row0 + t);
            const float r = bf2f(PROJ[row * NIN + hc]), kx = bf2f(PROJ[row * NIN + 2048 + hc]), v = bf2f(PROJ[row * NIN + 4096 + hc]);
            const float wpre = L2[row * 6144 + hc] + inp(20)[hc], apre = L2[row * 6144 + 2048 + hc] + inp(23)[hc];
            const float wlog = -logf(1.f + expf(-wpre)) - 0.5f, dec = expf(-expf(wlog)), aa = 1.f / (1.f + expf(-apre));
            float kk = kx * inp(28)[hc]; const float n2 = wave_sum(kk * kk); kk = kk / sqrtf(fmaxf(n2, 1e-24f));
            const float k2 = kx * (1.f + (aa - 1.f) * inp(29)[hc]);
            sh[lane] = dec; sh[64 + lane] = kk; sh[128 + lane] = kk * aa; sh[192 + lane] = k2; sh[256 + lane] = r;
            const float bon = wave_sum(r * k2 * inp(30)[hc]) * v;
            LDS_WAIT(); asm volatile("" ::: "memory");
            float sa = 0.f;
#pragma unroll
            for (int c = 0; c < 64; ++c) sa -= S[c] * sh[64 + c];
            float y = 0.f;
#pragma unroll
            for (int c = 0; c < 64; ++c) { S[c] = S[c] * sh[c] + sa * sh[128 + c] + v * sh[192 + c]; y += S[c] * sh[256 + c]; }
            LDS_WAIT(); asm volatile("" ::: "memory");
            chk(k.errs, 31, Y[row * D + hc], y, 0.05f); chk(k.errs, 33, BON[row * D + hc], bon, 0.02f); }
#pragma unroll
        for (int c = 0; c < 64; ++c) chk(k.errs, 32, s_out[(size_t)lane * 64 + c], S[c], 0.05f);
    }
}
DI void ck_post(const Ck& k, const Args& a, const float* Y, const float* BON, const float* G, const bf16* ATT) {
    for (int i = k.gtid; i < 1024; i += k.NT) { const int row = (i & 3) ? hsh(i + 61) % MR : MPR + hsh(i) % MSR, h = hsh(i + 63) & 31, c = hsh(i + 67) & 63; float s = 0.f, s2 = 0.f;
        for (int j = 0; j < 64; ++j) s += Y[(size_t)row * D + h * 64 + j]; const float mu = s / 64.f;
        for (int j = 0; j < 64; ++j) { const float d = Y[(size_t)row * D + h * 64 + j] - mu; s2 += d * d; }
        const size_t o = (size_t)row * D + h * 64 + c;
        const float ref = ((Y[o] - mu) / sqrtf(s2 / 64.f + RW_LN_EPS) * inp(31)[h * 64 + c] + inp(32)[h * 64 + c] + BON[o]) * G[(size_t)row * 6144 + h * 64 + c];
        chk(k.errs, 34, bf2f(ATT[o]), ref, 0.03f); }
}
#endif
#define PG8_SP2 true
#define PG8_ALIGN true
__global__ void __launch_bounds__(NTHREADS, 2) fwd(Args a) {
    LAS unsigned char* ldsu = (LAS unsigned char*)lds_raw; LAS char* lds = (LAS char*)lds_raw;
    const int wave0 = __builtin_amdgcn_readfirstlane((int)threadIdx.x >> 6);
    const int G = gridDim.x, bx = blockIdx.x, NGW = G * NWAVES, NT = G * NTHREADS;
#define PHV unsigned char* ws = ws_top; float* out = out_top; asm volatile("" : "+s"(ws), "+s"(out)); int tid = wave0 * 64 + lane_id(); const int lane = tid & 63, wave = __builtin_amdgcn_readfirstlane(tid >> 6), gw = bx * NWAVES + wave, gtid = bx * NTHREADS + tid; (void)lane; (void)gw; (void)gtid; (void)ws; (void)out
    volatile LAS unsigned* MISC = (volatile LAS unsigned*)(ldsu + MISC_OFF);
    if (threadIdx.x < 64) MISC[threadIdx.x] = 0u;
    if (threadIdx.x == 0) { volatile LAS unsigned long long* P = (volatile LAS unsigned long long*)(ldsu + PTRS_OFF);
#pragma unroll
        for (int i = 0; i < 43; ++i) P[i] = (unsigned long long)a.in[i]; }
    __syncthreads();
    unsigned char* const ws_top = a.ws; unsigned* ctl = (unsigned*)(ws_top + WS_CTL);
    XcdBarrier bar; bar.bar = ctl + CW_BAR; bar.x = 0; bar.st = nullptr;
    if (a.fused) bar = xcd_barrier_post(ctl + CW_BAR, MISC + 8);
    const int lo = a.ph_lo, hi = a.ph_hi;
#ifndef MK_REP_LO
#define MK_REP_LO 1000
#define MK_REP_HI 1000
#endif
#define REPL(k) for (int rep_ = ((k) >= MK_REP_LO && (k) < MK_REP_HI) ? 2 : 1; rep_ > 0; --rep_)
#ifndef MK_ONLY
#define MK_ONLY -1
#endif
#define IN(k) ((MK_ONLY < 0 || (k) == MK_ONLY) && lo <= (k) && (k) < hi)
#define INL(kb) ((MK_ONLY < 0 || (kb) == MK_ONLY) && lo <= (kb) + pb && (kb) + pb < hi)
#ifdef MK_TIME_A
#define STAMP(k) do { if (bx == 0 && threadIdx.x == 0) ctl[CW_ERR + 128 + (k)] = (unsigned)__builtin_amdgcn_s_memrealtime(); } while (0)
#else
#define STAMP(k) do { } while (0)
#endif
#define SEAM(k) do { if (lo <= (k) && (k) + 1 < hi) xcd_barrier(bar); STAMP((k) + 1); } while (0)
#define W_in ((bf16*)(ws + WS_WIN))
#define W_out ((bf16*)(ws + WS_WOUT))
#define W_rkv ((bf16*)(ws + WS_WRKV))
#define W_l2 ((bf16*)(ws + WS_WL2))
#define W_o ((bf16*)(ws + WS_WO))
#define W_q ((bf16*)(ws + WS_WQ))
#define W_kv ((bf16*)(ws + WS_WKV))
#define W_co ((bf16*)(ws + WS_WCO))
#define W_up ((bf16*)(ws + WS_WUP))
#define W_dn ((bf16*)(ws + WS_WDN))
#define W_low ((bf16*)(ws + WS_WLOW))
#define XB ((bf16*)(ws + WS_XB))
#define HPRE ((bf16*)(ws + WS_HPRE))
#define PROJ ((bf16*)(ws + WS_PROJ))
#define ATT ((bf16*)(ws + WS_ATT))
#define QM ((bf16*)(ws + WS_QM))
#define OM ((bf16*)(ws + WS_OM))
#define MEMB ((bf16*)(ws + WS_MEMB))
#define MEMKV ((bf16*)(ws + WS_MEMKV))
#define CMK ((bf16*)(ws + WS_CMK))
#define CMV ((bf16*)(ws + WS_CMV))
#define U ((bf16*)(ws + WS_U))
#define ACT ((bf16*)(ws + WS_ACT))
#define MIX ((bf16*)(ws + WS_MIX))
#define L1 ((bf16*)(ws + WS_L1))
#define L2 ((float*)(ws + WS_L2))
#define Y ((float*)(ws + WS_Y))
#define PREP ((float*)(ws + WS_PREP))
#define BON ((float*)(ws + WS_BON))
#define LOW ((float*)(ws + WS_LOW))
#define DST ((float*)(ws + WS_DST))
#define DEC ((float*)(ws + WS_DEC))
#define GO ((float*)(ws + WS_GO))
#define SIN ((bf16*)(ws + WS_SIN))
#define QDg ((bf16*)(ws + WS_QD))
#define PO ((float*)(ws + WS_PO))
#define PL ((float*)(ws + WS_PL))
    float* const out_top = a.out;
#if MK_CHECK
#define CK(k, stmt) do { if (IN(100 + (k))) { PHV; Ck ck{ctl + CW_ERR, gtid, NT, tid, bx, G, lds}; stmt; } } while (0)
#else
#define CK(k, stmt) do { } while (0)
#endif

    STAMP(0);
#define CONV_SLOT(DSC, LO, HI, FIRST) do { if (bx >= (FIRST)) { const TrDesc td_ = make_desc(ws, (DSC)); LAS float* scr_ = (LAS float*)(lds + wave * 16384); \
        const int hi_ = (HI) < 0 ? tr_items(DSC) : (HI); for (int it_ = (LO) + (bx - (FIRST)) * NWAVES + wave; it_ < hi_; it_ += (G - (FIRST)) * NWAVES) tr_item(td_, scr_, it_, lane); } } while (0)
    REPL(0) if (IN(0)) { PHV;
        LAS float* scr = (LAS float*)(lds + wave * 16384);
        { int base = 0;
            for (int d = 0; d < NTR; ++d) { if ((d >= 3 && d <= 12) || d == 14 || d == 18 || d == 20 || d == 22) continue;
                const int ni = tr_items(d); const TrDesc td = make_desc(ws, d);
                for (int it = gw; it < ni; it += NGW) tr_item(td, scr, it, lane);
                base += ni; } }
        for (int row = gw; row < MR; row += NGW) row_to_bf16(row < MPR ? inp(0) + (size_t)row * D : inp(1) + (size_t)(row - MPR) * D, XB + (size_t)row * D, nullptr, lane);
        for (int row = gw; row < 512; row += NGW) row_to_bf16(inp(2) + (size_t)row * D, MEMB + (size_t)row * D, nullptr, lane);
        for (int i = gtid; i < 2 * DB * NMEM * MW / 8; i += NT) { const f32x4 k0 = *(const GAS f32x4*)(inp(10) + (size_t)i * 8), k1 = *(const GAS f32x4*)(inp(10) + (size_t)i * 8 + 4);
            const f32x4 v0 = *(const GAS f32x4*)(inp(11) + (size_t)i * 8), v1 = *(const GAS f32x4*)(inp(11) + (size_t)i * 8 + 4);
            u32x4 wk = {pk2(k0.x, k0.y), pk2(k0.z, k0.w), pk2(k1.x, k1.y), pk2(k1.z, k1.w)}, wv = {pk2(v0.x, v0.y), pk2(v0.z, v0.w), pk2(v1.x, v1.y), pk2(v1.z, v1.w)};
            *(GAS u32x4*)(CMK + (size_t)i * 8) = wk; *(GAS u32x4*)(CMV + (size_t)i * 8) = wv; }
    }
    SEAM(0);
    CK(0, ck_p0(ck, a, XB, MEMB, CMK, CMV));

    for (int L = 0; L < 2; ++L) {
        const int pb = 16 * L;
        if (L == 0) {
            REPL(1) if (IN(1)) { PHV;
                pg8::Gemm g{XB, W_in, MPR, NIN, D, D}; pg8::StaticOrder S; S.init(MPR, NIN, G, bx);
                pg8::Epi8<FInProj> E{FInProj{PROJ, out}};
                pg8::gemm_phase<pg8::Epi8<FInProj>, pg8::StaticOrder, PG8_ALIGN, PG8_SP2>(ldsu, g, S, E, tid);
                skinny_gemm(lds, XB, D, W_in, NIN, D, S, E.f, G, bx, tid);
                if ((gw & 3) == 0) for (int t = gw >> 2; t < MR / 16; t += NGW >> 2) low_task(XB, W_low, LOW, t, lane);
            }
            SEAM(1);
            CK(1, ck_p1(ck, a, XB, W_in, PROJ, LOW));
            REPL(2) if (IN(2)) { PHV;
                const int half = G / 2;
#ifndef MK_REP_SBP
#define MK_REP_SBP 1
#endif
#ifndef MK_REP_G1
#define MK_REP_G1 1
#endif
                if (bx < half) { for (int rp = 0; rp < MK_REP_SBP; ++rp) for (int p = bx; p < 128; p += half) { const int bh = p >> 3, s = p & 7;
                        sbp_unit(lds, PROJ, ATT, inp(13)[bh & 7], bh >> 3, bh & 7, s, tid); sbp_unit(lds, PROJ, ATT, inp(13)[bh & 7], bh >> 3, bh & 7, 15 - s, tid); } }
                else { for (int rp = 0; rp < MK_REP_G1; ++rp) for (int u = bx - half; u < NUNITS_G; u += G - half) gla_g1(lds, u, PROJ, LOW, inp(14), inp(15), DST, DEC, GO, QDg, tid); }
                { const float* cK = inp(3); const float* cV = inp(4); const int* pt = (const int*)inp(5); const float* sbb = inp(13);
                  for (;;) { int idx = 0; if (lane == 0) idx = (int)atomicAdd(ctl + CW_Q, 1u); idx = __builtin_amdgcn_readfirstlane(idx); if (idx >= DB * NPAGES * SBH) break;
                      int ln = lane; asm volatile("" : "+v"(ln));
                      sbs_unit(lds + wave * 8192, PROJ, cK, cV, pt, sbb[idx & 7], PO, PL, idx >> 10, (idx >> 3) & 127, idx & 7, ln); } }
            }
            SEAM(2);
            REPL(3) if (IN(3)) { PHV;
                gla_g2(DST, DEC, SIN, inp(6), out + O_GLAP, out + O_GLAS, gtid, NT);
                if ((gw & 3) == 0) for (int i = gw >> 2; i < DB * SBH * TS; i += NGW >> 2) sbs_combine(PROJ, PO, PL, inp(13)[(i >> 3) & 7], ATT, i >> 6, (i >> 3) & 7, i & 7, lane);
            }
            SEAM(3);
            CK(3, ck_sbp(ck, a, PROJ, ATT)); CK(3, ck_sbs(ck, a, PROJ, ATT));
            REPL(4) if (IN(4)) { PHV; for (int u = bx; u < NUNITS_G; u += G) gla_g3(lds, u, PROJ, QDg, SIN, GO, inp(16), ATT, tid); }
            SEAM(4);
            CK(4, ck_gla(ck, a, PROJ, LOW, GO)); CK(4, ck_gla_norm(ck, a, PROJ, GO, ATT));
        } else {
            REPL(15) if (IN(15)) { PHV; rwkv_mix(XB, inp(18), inp(8), MIX, out + O_SHP, out + O_SHS, gtid, NT); }
            SEAM(15);
            CK(15, ck_mix(ck, a, XB, MIX));
            REPL(16) if (IN(16)) { PHV;
                pg8::Gemm g{MIX, W_rkv, MPR, 6912, D, D}; RkvOrder S; S.init(MPR, 6912, G, bx);
                pg8::Epi8<FRkv> E{FRkv{PROJ, L1}};
                pg8::gemm_phase<pg8::Epi8<FRkv>, RkvOrder, PG8_ALIGN, PG8_SP2>(ldsu, g, S, E, tid);
                skinny_gemm(lds, MIX, D, W_rkv, 6912, D, S, E.f, G, bx, tid);
                CONV_SLOT(20, 4400, -1, S.nwg % G);
            }
            SEAM(16);
            CK(16, ck_gemm(ck, 29, 0, MR, 6912, D, W_rkv, [&](int r, int c) { const int pn = c >> 8; const int idx = pn < 8 ? 0 : pn < 16 ? 2 : pn < 24 ? 3 : pn == 24 ? 1 : pn == 25 ? 4 : 5; return (const bf16*)(MIX + ((size_t)idx * M + r) * D); },
                [&](int r, int c, float ref) { const int pn = c >> 8; if (pn < 24) return bf2f(PROJ[(size_t)r * NIN + c]) - ref; const float x = pn == 24 ? tanhf(ref) : pn == 26 ? 1.f / (1.f + expf(-ref)) : ref; return bf2f(L1[(size_t)r * 768 + c - NIN]) - x; }, 0.05f, 160));
            REPL(17) if (IN(17)) { PHV;
                pg8::Gemm g{L1, W_l2, MPR, 6144, 256, 768}; L2Order S; S.init(MPR, 6144, G, bx);
                pg8::Epi4<FL2> E{FL2{L2}};
                pg8::gemm_phase<pg8::Epi4<FL2>, L2Order, PG8_ALIGN, PG8_SP2>(ldsu, g, S, E, tid);
                skinny_gemm(lds, L1, 768, W_l2, 6144, 256, S, E.f, G, bx, tid);
            }
            SEAM(17);
            CK(17, ck_gemm(ck, 30, 0, MR, 6144, 256, W_l2, [&](int r, int c) { return (const bf16*)(L1 + (size_t)r * 768 + (c >> 11) * 256); },
                [&](int r, int c, float ref) { return L2[(size_t)r * 6144 + c] - ref; }, 0.05f, 170));
            REPL(18) if (IN(18)) { PHV; rwkv_prep(PROJ, L2, inp(20), inp(23), inp(28), inp(29), inp(30), PREP, BON, gw, NGW, lane); }
            SEAM(18);
            REPL(19) if (IN(19)) { PHV; const RwC R{PREP, inp(7), Y, out + O_RWP, out + O_RWS};
                for (int u = bx; u < 256 + DB * RWH * 4; u += G) rwkv_unit(lds, u, R, tid); }
            SEAM(19);
            CK(19, ck_rwkv(ck, a, PROJ, L2, Y, BON));
            REPL(20) if (IN(20)) { PHV; rwkv_post(Y, BON, L2 + 4096, inp(31), inp(32), ATT, gw, NGW, lane); }
            SEAM(20);
            CK(20, ck_post(ck, a, Y, BON, L2 + 4096, ATT));
        }
        REPL(5 + pb) if (INL(5)) { PHV;
            pg8::Gemm g{ATT, L == 0 ? W_out : W_o, MPR, D, D, D}; pg8::StaticOrder S; S.init(MPR, D, G, bx);
            pg8::Epi8<FResid> E{FResid{XB, HPRE}};
            pg8::gemm_phase<pg8::Epi8<FResid>, pg8::StaticOrder, PG8_ALIGN, PG8_SP2>(ldsu, g, S, E, tid);
            skinny_gemm(lds, ATT, D, L == 0 ? W_out : W_o, D, D, S, E.f, G, bx, tid);
        }
        SEAM(5 + pb);
        CK(5 + pb, ck_gemm(ck, 19, 0, MR, D, D, L == 0 ? W_out : W_o, [&](int r, int) { return (const bf16*)(ATT + (size_t)r * D); },
            [&](int r, int c, float ref) { return bf2f(HPRE[(size_t)r * D + c]) - (ALPHA * bf2f(XB[(size_t)r * D + c]) + ref); }, 0.05f, 50));
        const float* lnw = inp(41) + (size_t)L * 3 * D; const float* lnb = inp(42) + (size_t)L * 3 * D;
        REPL(6 + pb) if (INL(6)) { PHV; ln_rows(HPRE, lnw, lnb, nullptr, nullptr, XB, gw, NGW, lane); }
        SEAM(6 + pb);
        CK(6 + pb, ck_ln(ck, 20, HPRE, lnw, lnb, XB));
        REPL(7 + pb) if (INL(7)) { PHV;
            { pg8::Gemm g{XB, W_q + (size_t)L * MW * D, MPR, MW, D, D}; pg8::StaticOrder S; S.init(MPR, MW, G, bx);
              pg8::Epi8<FBf16> E{FBf16{QM, MW}};
              pg8::gemm_phase<pg8::Epi8<FBf16>, pg8::StaticOrder, PG8_ALIGN, PG8_SP2>(ldsu, g, S, E, tid);
              skinny_gemm(lds, XB, D, W_q + (size_t)L * MW * D, MW, D, S, E.f, G, bx, tid); }
            if (L == 0) { pg8::Gemm g{MEMB, W_kv, 512, D, D, D}; pg8::StaticOrder S; S.init(512, D, G, (bx + G - 80) % G);
              pg8::Epi8<FMemKV> E{FMemKV{MEMKV, out}};
              pg8::gemm_phase<pg8::Epi8<FMemKV>, pg8::StaticOrder, PG8_ALIGN, PG8_SP2>(ldsu, g, S, E, tid); }
            { const int first = (G > 96) ? 96 : 0;
              if (L == 0) { for (int d = 3; d <= 12; ++d) CONV_SLOT(d, 0, -1, first); }
              else CONV_SLOT(22, 0, -1, first); }
        }
        SEAM(7 + pb);
        CK(7 + pb, ck_gemm(ck, 21, 0, MR, MW, D, W_q + (size_t)L * MW * D, [&](int r, int) { return (const bf16*)(XB + (size_t)r * D); }, [&](int r, int c, float ref) { return bf2f(QM[(size_t)r * MW + c]) - ref; }, 0.05f, 70));
        CK(7 + pb, ck_gemm(ck, 22, 0, 512, D, D, W_kv, [&](int r, int) { return (const bf16*)(MEMB + (size_t)r * D); },
            [&](int r, int c, float ref) { const float e1 = fabsf(bf2f(MEMKV[(size_t)r * D + c]) - ref); const int layer = c >> 10, kv = (c >> 9) & 1, cc = c & 511; const float e2 = fabsf(out[(kv ? O_MVP : O_MKP) + ((size_t)layer * 512 + r) * MW + cc] - ref); return e1 + e2; }, 0.05f, 75));
        REPL(8 + pb) if (INL(8)) { PHV;
            LAS float* xch = (LAS float*)(lds + XCH_OFF + wave * 256);
            for (int i = bx; i < 128 + DB * MH; i += G) {
                if (i < 128) { const int rt = i >> 2, h = i & 3, b = rt >> 4;
                    mem_unit(lds, xch, QM + (size_t)rt * 256 * MW + h * HD, MW, 256, MEMKV + (size_t)b * NMEM * D + L * 1024 + h * HD, MEMKV + (size_t)b * NMEM * D + L * 1024 + 512 + h * HD, D, OM + (size_t)rt * 256 * MW + h * HD, MW, tid); }
                else { const int su = i - 128, db = su >> 2, h = su & 3; const size_t kb = (size_t)((L * DB + db) * NMEM) * MW + h * HD;
                    mem_unit(lds, xch, QM + (size_t)(MPR + db * TS) * MW + h * HD, MW, TS, CMK + kb, CMV + kb, MW, OM + (size_t)(MPR + db * TS) * MW + h * HD, MW, tid); } }
        }
        SEAM(8 + pb);
        CK(8 + pb, ck_mem(ck, 23, QM, MEMKV, CMK, CMV, OM, L));
        REPL(9 + pb) if (INL(9)) { PHV;
            pg8::Gemm g{OM, W_co + (size_t)L * D * MW, MPR, D, MW, MW}; pg8::StaticOrder S; S.init(MPR, D, G, bx);
            pg8::Epi8<FResid> E{FResid{XB, HPRE}};
            pg8::gemm_phase<pg8::Epi8<FResid>, pg8::StaticOrder, PG8_ALIGN, PG8_SP2>(ldsu, g, S, E, tid);
            skinny_gemm(lds, OM, MW, W_co + (size_t)L * D * MW, D, MW, S, E.f, G, bx, tid);
        }
        SEAM(9 + pb);
        CK(9 + pb, ck_gemm(ck, 24, 0, MR, D, MW, W_co + (size_t)L * D * MW, [&](int r, int) { return (const bf16*)(OM + (size_t)r * MW); },
            [&](int r, int c, float ref) { return bf2f(HPRE[(size_t)r * D + c]) - (ALPHA * bf2f(XB[(size_t)r * D + c]) + ref); }, 0.05f, 90));
        REPL(10 + pb) if (INL(10)) { PHV; ln_rows(HPRE, lnw + D, lnb + D, nullptr, nullptr, XB, gw, NGW, lane); }
        SEAM(10 + pb);
        CK(10 + pb, ck_ln(ck, 20, HPRE, lnw + D, lnb + D, XB));
        REPL(11 + pb) if (INL(11)) { PHV;
            pg8::Gemm g{XB, W_up + (size_t)L * F2 * D, MPR, F2, D, D}; pg8::StaticOrder S; S.init(MPR, F2, G, bx);
            pg8::Epi8<FUp> E{FUp{U, out, L}};
            pg8::gemm_phase<pg8::Epi8<FUp>, pg8::StaticOrder, PG8_ALIGN, PG8_SP2>(ldsu, g, S, E, tid);
            skinny_gemm(lds, XB, D, W_up + (size_t)L * F2 * D, F2, D, S, E.f, G, bx, tid);
            if (L == 0) { const int first = S.nwg % G;
                CONV_SLOT(14, 0, -1, first); CONV_SLOT(18, 0, -1, first); CONV_SLOT(20, 0, 4400, first); }
        }
        SEAM(11 + pb);
        CK(11 + pb, ck_gemm(ck, 25, 0, MR, F2, D, W_up + (size_t)L * F2 * D, [&](int r, int) { return (const bf16*)(XB + (size_t)r * D); }, [&](int r, int c, float ref) { return bf2f(U[(size_t)r * F2 + c]) - ref; }, 0.05f, 110));
        REPL(12 + pb) if (INL(12)) { PHV; conv_gate(U, inp(38) + (size_t)L * 3 * F2, inp(39) + (size_t)L * F2, inp(9) + (size_t)L * DB * 2 * F2, ACT, gtid, NT); }
        SEAM(12 + pb);
        CK(12 + pb, ck_conv(ck, 26, a, U, ACT, L));
        REPL(13 + pb) if (INL(13)) { PHV;
            pg8::Gemm g{ACT, W_dn + (size_t)L * D * FF, MPR, D, FF, FF}; pg8::StaticOrder S; S.init(MPR, D, G, bx);
            pg8::Epi8<FResid> E{FResid{XB, HPRE}};
            pg8::gemm_phase<pg8::Epi8<FResid>, pg8::StaticOrder, PG8_ALIGN, PG8_SP2>(ldsu, g, S, E, tid);
            skinny_gemm(lds, ACT, FF, W_dn + (size_t)L * D * FF, D, FF, S, E.f, G, bx, tid);
        }
        SEAM(13 + pb);
        CK(13 + pb, ck_gemm(ck, 27, 0, MR, D, FF, W_dn + (size_t)L * D * FF, [&](int r, int) { return (const bf16*)(ACT + (size_t)r * FF); },
            [&](int r, int c, float ref) { return bf2f(HPRE[(size_t)r * D + c]) - (ALPHA * bf2f(XB[(size_t)r * D + c]) + ref); }, 0.05f, 130));
        REPL(14 + pb) if (INL(14)) { PHV;
            if (L == 0) ln_rows(HPRE, lnw + 2 * D, lnb + 2 * D, nullptr, nullptr, XB, gw, NGW, lane);
            else ln_rows(HPRE, lnw + 2 * D, lnb + 2 * D, out + O_YP, out + O_YS, nullptr, gw, NGW, lane);
        }
        SEAM(14 + pb);
    }
#ifdef MK_TIME_A
    xcd_barrier(bar);
    { const unsigned ta = ctl[CW_ERR + 128 + MK_TIME_A], tb = ctl[CW_ERR + 128 + MK_TIME_B]; const float us = (float)(tb - ta) * 0.01f; const float c = sqrtf(fmaxf(us, 1e-3f));
      for (size_t i = (size_t)bx * NTHREADS + threadIdx.x; i < (size_t)MPR * D; i += NT) out_top[O_YP + i] = c; }
#endif
#if MK_CHECK
    REPL(200) if (IN(200)) { PHV; if (gtid == 0) { unsigned code = 0; float mag = 0.f;
            for (int id = 10; id < 64; ++id) { const float e = __uint_as_float(ctl[CW_ERR + id]); if (e > 1.f && code == 0) { code = id; mag = e; } }
#ifdef MK_REPORT
            code = 1000; mag = __uint_as_float(ctl[CW_ERR + MK_REPORT]);
#endif
            ctl[CW_ERR + 100] = code; ctl[CW_ERR + 101] = __float_as_uint(mag); } }
    REPL(201) if (IN(201)) { PHV; const unsigned code = ctl[CW_ERR + 100]; const float mag = __uint_as_float(ctl[CW_ERR + 101]);
        if (code) { int ex = 4; float m = mag; while (m >= 10.f && ex < 30) { m *= 0.1f; ++ex; }
            float c2 = (float)code; for (int i = 0; i < ex; ++i) c2 *= 10.f; if (code == 1000) c2 = fmaxf(mag, 1e-5f) * 1e6f; const float c = sqrtf(c2);
            for (size_t i = gtid; i < (size_t)MPR * D; i += NT) out[O_YP + i] = c; } }
#endif
#undef IN
#undef CONV_SLOT
#undef W_in
#undef W_out
#undef W_rkv
#undef W_l2
#undef W_o
#undef W_q
#undef W_kv
#undef W_co
#undef W_up
#undef W_dn
#undef W_low
#undef XB
#undef HPRE
#undef PROJ
#undef ATT
#undef QM
#undef OM
#undef MEMB
#undef MEMKV
#undef CMK
#undef CMV
#undef U
#undef ACT
#undef MIX
#undef L1
#undef L2
#undef Y
#undef PREP
#undef BON
#undef LOW
#undef DST
#undef DEC
#undef GO
#undef SIN
#undef QDg
#undef PO
#undef PL
#undef PHV
#undef INL
#undef SEAM
#undef CK
}
#ifndef MK_FUSED
#define MK_FUSED 0
#endif
extern "C" void kernel_launch(void* const* d_in, const int* in_sizes, int n_in, void* d_out, int out_size, void* d_ws, size_t ws_size, hipStream_t stream) {
    static int grid = 0;
    if (grid == 0) {
        if (n_in != 43 || (size_t)out_size != O_END || ws_size < WS_TOTAL) { fprintf(stderr, "kernel_launch: unexpected problem shape (n_in %d, out %d, ws %zu); nothing launched\n", n_in, out_size, ws_size); grid = -1; return; }
        int dev = 0, cus = 0;
        if (hipGetDevice(&dev) != hipSuccess || hipDeviceGetAttribute(&cus, hipDeviceAttributeMultiprocessorCount, dev) != hipSuccess) { grid = -1; return; }
        if (hipFuncSetAttribute((const void*)fwd, hipFuncAttributeMaxDynamicSharedMemorySize, LDS_BYTES) != hipSuccess) { fprintf(stderr, "kernel_launch: hipFuncSetAttribute failed\n"); grid = -1; return; }
        int per_cu = 0;
        if (hipOccupancyMaxActiveBlocksPerMultiprocessor(&per_cu, (const void*)fwd, NTHREADS, LDS_BYTES) != hipSuccess || per_cu < 1) fprintf(stderr, "kernel_launch: occupancy query reports %d blocks per CU\n", per_cu);
        (void)hipGetLastError();
        grid = cus;
    }
    if (grid < 0) return;
    (void)hipMemsetAsync((char*)d_ws + WS_CTL, 0, CTL_ZERO_BYTES, stream);
    Args a{};
    for (int i = 0; i < 43; ++i) a.in[i] = (const float*)d_in[i];
    a.out = (float*)d_out; a.ws = (unsigned char*)d_ws;
#if MK_FUSED
    a.ph_lo = 0; a.ph_hi = NPH; a.fused = 1;
    hipLaunchKernelGGL(fwd, dim3(grid), dim3(NTHREADS), LDS_BYTES, stream, a);
#else
    a.fused = 0;
    for (int k = 0; k < NPH; ++k) {
        a.ph_lo = k; a.ph_hi = k + 1; hipLaunchKernelGGL(fwd, dim3(grid), dim3(NTHREADS), LDS_BYTES, stream, a);
#if MK_CHECK
        a.ph_lo = 100 + k; a.ph_hi = 101 + k; hipLaunchKernelGGL(fwd, dim3(grid), dim3(NTHREADS), LDS_BYTES, stream, a);
#endif
    }
#if MK_CHECK
    a.ph_lo = 200; a.ph_hi = 201; hipLaunchKernelGGL(fwd, dim3(grid), dim3(NTHREADS), LDS_BYTES, stream, a);
    a.ph_lo = 201; a.ph_hi = 202; hipLaunchKernelGGL(fwd, dim3(grid), dim3(NTHREADS), LDS_BYTES, stream, a);
#endif
#endif
    const hipError_t le = hipPeekAtLastError();
    if (le != hipSuccess) fprintf(stderr, "kernel_launch: launch failed: %s\n", hipGetErrorName(le));
}
```

```cpp
#define MK_CHECK 0
#define MK_FUSED 1

#include <hip/hip_runtime.h>
#include <cstdio>
#include <cstdint>

#define GAS __attribute__((address_space(1)))
#define LAS __attribute__((address_space(3)))
#define DI __device__ __forceinline__
typedef unsigned short bf16;
typedef short bf16x8 __attribute__((ext_vector_type(8)));
typedef short s16x4 __attribute__((ext_vector_type(4)));
typedef float f32x2 __attribute__((ext_vector_type(2)));
typedef float f32x4 __attribute__((ext_vector_type(4)));
typedef float f32x16 __attribute__((ext_vector_type(16)));
typedef unsigned u32x2 __attribute__((ext_vector_type(2)));
typedef unsigned u32x4 __attribute__((ext_vector_type(4)));

constexpr int D = 2048, TP = 4096, BP = 2, MPR = BP * TP;
constexpr int DB = 8, TS = 8, MSR = DB * TS;
constexpr int MR = MPR + MSR;
constexpr int M = MPR + 256;
constexpr int NPAGES = 128, PAGE = 128, PAST = 16384;
constexpr int SBH = 8, HD = 128, SBW = 1024;
constexpr int GH = 4, GDK = 128, GDV = 256, GKW = 512, GVW = 1024, GRANK = 16;
constexpr int NIN = 6144, NIN_FULL = 6160;
constexpr int RWH = 32, RWN = 64;
constexpr int NMEM = 256, MH = 4, MW = 512;
constexpr int FF = 5504, F2 = 11008;
constexpr float LN_EPS = 1e-5f, GLA_EPS = 1e-5f, RW_LN_EPS = 64e-5f;
constexpr float ALPHA = 1.4142135623730951f;
constexpr float LOG2E = 1.4426950408889634f;
constexpr int NUNITS_G = BP * 64 * GH + DB * GH;

constexpr size_t O_YP = 0, O_YS = O_YP + (size_t)MPR * D, O_SBKP = O_YS + (size_t)MSR * D, O_SBVP = O_SBKP + (size_t)MPR * SBW,
    O_GLAP = O_SBVP + (size_t)MPR * SBW, O_RWP = O_GLAP + (size_t)BP * GH * GDK * GDV, O_SHP = O_RWP + (size_t)BP * RWH * 64 * 64, O_CONVP = O_SHP + (size_t)BP * D,
    O_MKP = O_CONVP + (size_t)2 * BP * 2 * F2, O_MVP = O_MKP + (size_t)2 * BP * NMEM * MW, O_SBKS = O_MVP + (size_t)2 * BP * NMEM * MW, O_SBVS = O_SBKS + (size_t)MSR * SBW,
    O_GLAS = O_SBVS + (size_t)MSR * SBW, O_RWS = O_GLAS + (size_t)DB * GH * GDK * GDV, O_SHS = O_RWS + (size_t)DB * RWH * 64 * 64, O_CONVS = O_SHS + (size_t)DB * D,
    O_END = O_CONVS + (size_t)2 * DB * 2 * F2;

constexpr size_t MiB = 1u << 20;
constexpr size_t al(size_t x) { return (x + 255) & ~(size_t)255; }
constexpr size_t WS_CTL = 0, CTL_ZERO_BYTES = 1 * MiB;
constexpr size_t WS_WIN = 2 * MiB;
constexpr size_t WS_WOUT = WS_WIN + al((size_t)NIN * D * 2);
constexpr size_t WS_WRKV = WS_WOUT + al((size_t)D * D * 2);
constexpr size_t WS_WL2 = WS_WRKV + al((size_t)6912 * D * 2);
constexpr size_t WS_WO = WS_WL2 + al((size_t)6144 * 256 * 2);
constexpr size_t WS_WQ = WS_WO + al((size_t)D * D * 2);
constexpr size_t WS_WKV = WS_WQ + al((size_t)2 * MW * D * 2);
constexpr size_t WS_WCO = WS_WKV + al((size_t)2048 * D * 2);
constexpr size_t WS_WUP = WS_WCO + al((size_t)2 * D * MW * 2);
constexpr size_t WS_WDN = WS_WUP + al((size_t)2 * F2 * D * 2);
constexpr size_t WS_XB = WS_WDN + al((size_t)2 * D * FF * 2);
constexpr size_t WS_XF = WS_XB + al((size_t)M * D * 2);
constexpr size_t WS_HPRE = WS_XF + al((size_t)M * D * 4);
constexpr size_t WS_PROJ = WS_HPRE + al((size_t)M * D * 4);
constexpr size_t WS_ATT = WS_PROJ + al((size_t)M * NIN * 2);
constexpr size_t WS_QM = WS_ATT + al((size_t)M * D * 2);
constexpr size_t WS_OM = WS_QM + al((size_t)M * MW * 2);
constexpr size_t WS_MEMB = WS_OM + al((size_t)M * MW * 2);
constexpr size_t WS_MEMKV = WS_MEMB + al((size_t)512 * D * 2);
constexpr size_t WS_CMK = WS_MEMKV + al((size_t)512 * D * 2);
constexpr size_t WS_CMV = WS_CMK + al((size_t)2 * DB * NMEM * MW * 2);
constexpr size_t WS_U = WS_CMV + al((size_t)2 * DB * NMEM * MW * 2);
constexpr size_t WS_ACT = WS_U + al((size_t)M * F2 * 2);
constexpr size_t WS_MIX = WS_ACT + al((size_t)M * FF * 2);
constexpr size_t WS_L1 = WS_MIX + al((size_t)6 * M * D * 2);
constexpr size_t WS_L2 = WS_L1 + al((size_t)M * 768 * 2);
constexpr size_t WS_Y = WS_L2 + al((size_t)3 * M * D * 4);
constexpr size_t WS_BON = WS_Y + al((size_t)M * D * 4);
constexpr size_t WS_LOW = WS_BON + al((size_t)M * D * 4);
constexpr size_t WS_DST = WS_LOW + al((size_t)M * 16 * 4);
constexpr size_t WS_DEC = WS_DST + al((size_t)NUNITS_G * GDV * GDK * 4);
constexpr size_t WS_GO = WS_DEC + al((size_t)NUNITS_G * GDK * 4);
constexpr size_t WS_SIN = WS_GO + al((size_t)M * GVW * 4);
constexpr size_t WS_QD = WS_SIN + al((size_t)NUNITS_G * GDV * GDK * 2);
constexpr size_t WS_PO = WS_QD + al((size_t)M * GKW * 2);
constexpr size_t WS_PL = WS_PO + al((size_t)DB * NPAGES * SBH * TS * HD * 4);
constexpr size_t WS_END = WS_PL + al((size_t)DB * NPAGES * SBH * TS * 4);
constexpr int CW_BAR = 4096;
constexpr int CW_ERR = 16384;
constexpr int CW_Q = 8192;
namespace pg8 {
#define PG8_LAS __attribute__((address_space(3)))
typedef unsigned short bf16_t;
typedef short bf16x8 __attribute__((ext_vector_type(8)));
typedef float f32x4 __attribute__((ext_vector_type(4)));
typedef unsigned u32x4 __attribute__((ext_vector_type(4)));
constexpr int BM = 256, BK = 64, HALF = 128, HTB = HALF * BK * 2, STAGE_BYTES = 8 * HTB, NXCD = 8, WGM = 8;
__host__ __device__ __forceinline__ int lds_byte(int r, int c) { const int st = (r >> 4) * 2 + (c >> 5), rr = r & 15, cc = c & 31, ob = rr * 64 + cc * 2; return st * 1024 + (ob ^ (((ob >> 9) & 1) << 5)); }
__host__ __device__ __forceinline__ void stage_rc(int b, int& R, int& C) { const int st = b / 1024, sb = b % 1024, swz = sb ^ (((sb >> 9) & 1) << 5); R = (st >> 1) * 16 + swz / 64; C = (st & 1) * 32 + (swz % 64) / 2; }
__host__ __device__ __forceinline__ int perm32(int rho) { const int n = rho >> 4, i = rho & 15; return 8 * (i >> 2) + 4 * n + (i & 3); }
struct Unit { int pm, pn; };
struct Gemm { const bf16_t* A; const bf16_t* Bt; int M, N, K, lda; };
struct StaticOrder {
    int nM, nN, nwg, G, c;
    __host__ __device__ void init(int M, int N, int G_, int c_) { nM = M / BM; nN = N / BM; nwg = nM * nN; G = G_; c = c_; }
    __host__ __device__ bool next(int i, Unit& u) const {
        const long L = (long)i * G + c; if (L >= nwg) return false;
        int wgid = (int)L; { const int q = nwg / NXCD, r = nwg % NXCD, xcd = wgid % NXCD, off = wgid / NXCD; wgid = (xcd < r ? xcd * (q + 1) : r * (q + 1) + (xcd - r) * q) + off; }
        const int nig = WGM * nN, gid = wgid / nig, fm = gid * WGM, gsz = (nM - fm) < WGM ? (nM - fm) : WGM;
        u.pm = fm + ((wgid % nig) % gsz); u.pn = (wgid % nig) / gsz; return true;
    }
    __device__ __forceinline__ void a_ready(const Unit&) const {}
    __device__ __forceinline__ void done(const Unit&) const {}
    __device__ __forceinline__ size_t a_off(int) const { return 0; }
};
__device__ __forceinline__ unsigned cvt_pk_bf16(float lo, float hi) { unsigned r; asm volatile("v_cvt_pk_bf16_f32 %0, %1, %2" : "=v"(r) : "v"(lo), "v"(hi)); return r; }

template <class F> struct Epi8 {
    static constexpr bool PERM = true, AFTER_DRAIN = false; F f;
    __device__ __forceinline__ void operator()(const f32x4 (&acc)[2][2][4][2], const Unit& u, int wr, int wc, int fr, int fq) const {
        const int row0 = u.pm * BM + wr * 64 + fr, col0 = u.pn * BM + wc * 32 + 8 * fq;
#pragma unroll
        for (int ai = 0; ai < 2; ++ai)
#pragma unroll
            for (int m = 0; m < 4; ++m)
#pragma unroll
                for (int bj = 0; bj < 2; ++bj) f(row0 + ai * HALF + m * 16, col0 + bj * HALF, acc[ai][bj][m][0], acc[ai][bj][m][1], u.pn);
    }
};
template <class F> struct Epi4 {
    static constexpr bool PERM = false, AFTER_DRAIN = false; F f;
    __device__ __forceinline__ void operator()(const f32x4 (&acc)[2][2][4][2], const Unit& u, int wr, int wc, int fr, int fq) const {
        const int row0 = u.pm * BM + wr * 64 + fr, col0 = u.pn * BM + wc * 32 + 4 * fq;
#pragma unroll
        for (int ai = 0; ai < 2; ++ai)
#pragma unroll
            for (int m = 0; m < 4; ++m)
#pragma unroll
                for (int bj = 0; bj < 2; ++bj)
#pragma unroll
                    for (int n = 0; n < 2; ++n) f(row0 + ai * HALF + m * 16, col0 + bj * HALF + n * 16, acc[ai][bj][m][n], u.pn);
    }
};
template <class Epi, class Sched, bool ALIGN_EPI = false, bool SP2 = false>
__device__ __forceinline__ void gemm_phase(PG8_LAS unsigned char* lds, const Gemm g, const Sched& S, const Epi& E, const int tid) {
    const int wid = __builtin_amdgcn_readfirstlane(tid >> 6), lane = tid & 63, wr = wid >> 2, wc = wid & 3, fr = lane & 15, fq = lane >> 4;
    const int K = g.K, nt = K / BK;
    unsigned voffA[2], voffB[2];
#pragma unroll
    for (int i = 0; i < 2; ++i) { int R, C; stage_rc(tid * 16 + i * 8192, R, C); const int Rb = Epi::PERM ? ((R & ~31) + perm32(R & 31)) : R;
        voffA[i] = (unsigned)(R * g.lda + C) * 2u; voffB[i] = (unsigned)(Rb * K + C) * 2u; }
    const size_t kstep = (size_t)(BK * 2);
    const size_t hstepB = (size_t)HALF * K * 2, hstepA = (size_t)HALF * g.lda * 2;
    const size_t tstepB = 2 * hstepB, tstepA = 2 * hstepA;
    const unsigned ldsw = (unsigned)wid * 1024u;
    const int aoff = lds_byte(wr * 64 + fr, fq * 8), boff = lds_byte(wc * 32 + fr, fq * 8);
#define PG8_SA(b, h) (((b) * 2 + (h)) * HTB)
#define PG8_SB(b, h) ((4 + (b) * 2 + (h)) * HTB)
#define PG8_STAGE(bufoff, gbase, voff) do { _Pragma("unroll") for (int _i = 0; _i < 2; ++_i) \
        __builtin_amdgcn_global_load_lds((const unsigned*)((const char*)(gbase) + (voff)[_i]), (PG8_LAS unsigned*)(lds + (bufoff) + ldsw + _i * 8192), 16, 0, 0); } while (0)
#define PG8_LDA(dst, b, h) do { _Pragma("unroll") for (int m = 0; m < 4; ++m) _Pragma("unroll") for (int k = 0; k < 2; ++k) dst[m][k] = *(const PG8_LAS bf16x8*)(lds + PG8_SA(b, h) + aoff + m * 2048 + k * 1024); } while (0)
#define PG8_LDB(dst, b, h) do { _Pragma("unroll") for (int n = 0; n < 2; ++n) _Pragma("unroll") for (int k = 0; k < 2; ++k) dst[n][k] = *(const PG8_LAS bf16x8*)(lds + PG8_SB(b, h) + boff + n * 2048 + k * 1024); } while (0)
#define PG8_MMA(ai, bj, At, Bt) do { __builtin_amdgcn_s_setprio(1); _Pragma("unroll") for (int m = 0; m < 4; ++m) _Pragma("unroll") for (int n = 0; n < 2; ++n) _Pragma("unroll") for (int k = 0; k < 2; ++k) \
        acc[ai][bj][m][n] = __builtin_amdgcn_mfma_f32_16x16x32_bf16(Bt[n][k], At[m][k], acc[ai][bj][m][n], 0, 0, 0); __builtin_amdgcn_s_setprio(0); } while (0)
#define PG8_WAIT_V(n) asm volatile("s_waitcnt vmcnt(" #n ")" ::: "memory")
#define PG8_WAIT_L(n) asm volatile("s_waitcnt lgkmcnt(" #n ")" ::: "memory")
#define PG8_BAR __builtin_amdgcn_s_barrier()
#define PG8_SCHED __builtin_amdgcn_sched_barrier(0)
    Unit cur, nxt; int ui = 0;
    if (!S.next(0, cur)) return;
    f32x4 acc[2][2][4][2];
#pragma unroll
    for (int a = 0; a < 2; ++a)
#pragma unroll
        for (int b = 0; b < 2; ++b)
#pragma unroll
            for (int m = 0; m < 4; ++m)
#pragma unroll
                for (int n = 0; n < 2; ++n) acc[a][b][m][n] = (f32x4){0.f, 0.f, 0.f, 0.f};
    bf16x8 At[4][2], B0[2][2], B1[2][2];
    const char* cA = (const char*)g.A + S.a_off(cur.pn) + (size_t)cur.pm * tstepA; const char* cB = (const char*)g.Bt + (size_t)cur.pn * tstepB;
    S.a_ready(cur);
    if constexpr (SP2) {
        PG8_STAGE(PG8_SB(0, 0), cB, voffB); PG8_STAGE(PG8_SB(0, 1), cB + hstepB, voffB); PG8_STAGE(PG8_SA(0, 0), cA, voffA); PG8_STAGE(PG8_SA(0, 1), cA + hstepA, voffA);
        if (wr == 1) PG8_BAR;
        PG8_WAIT_V(2); PG8_BAR;
        PG8_STAGE(PG8_SB(1, 0), cB + kstep, voffB); PG8_STAGE(PG8_SA(1, 0), cA + kstep, voffA); PG8_STAGE(PG8_SB(1, 1), cB + hstepB + kstep, voffB);
        PG8_WAIT_V(6); PG8_BAR;
    } else {
        PG8_STAGE(PG8_SB(0, 0), cB, voffB); PG8_STAGE(PG8_SA(0, 0), cA, voffA); PG8_STAGE(PG8_SB(0, 1), cB + hstepB, voffB); PG8_STAGE(PG8_SA(0, 1), cA + hstepA, voffA);
        if (wr == 1) PG8_BAR;
        PG8_WAIT_V(4); PG8_BAR;
        PG8_STAGE(PG8_SB(1, 0), cB + kstep, voffB); PG8_STAGE(PG8_SA(1, 0), cA + kstep, voffA); PG8_STAGE(PG8_SB(1, 1), cB + hstepB + kstep, voffB);
        PG8_WAIT_V(6); PG8_BAR;
    }
    for (;;) {
        const bool has_next = S.next(ui + 1, nxt);
        const char* nA = has_next ? (const char*)g.A + S.a_off(nxt.pn) + (size_t)nxt.pm * tstepA : cA; const char* nB = has_next ? (const char*)g.Bt + (size_t)nxt.pn * tstepB : cB;
#pragma nounroll
        for (int t = 0; t < nt; t += 2) {
            const bool last = (t == nt - 2);
            const char* a1 = cA + (size_t)(t + 1) * kstep;
            const char* a2 = last ? nA : cA + (size_t)(t + 2) * kstep; const char* b2 = last ? nB : cB + (size_t)(t + 2) * kstep;
            const char* a3 = a2 + kstep; const char* b3 = b2 + kstep;
            if (last && has_next) S.a_ready(nxt);
            if constexpr (SP2) {
            PG8_LDB(B0, 0, 0); PG8_LDB(B1, 0, 1); PG8_SCHED; PG8_LDA(At, 0, 0); PG8_STAGE(PG8_SA(1, 1), a1 + hstepA, voffA);
            PG8_WAIT_V(8); PG8_WAIT_L(0); PG8_BAR; PG8_MMA(0, 0, At, B0); PG8_MMA(0, 1, At, B1); PG8_BAR; PG8_SCHED;
            PG8_LDA(At, 0, 1); PG8_STAGE(PG8_SB(0, 0), b2, voffB); PG8_STAGE(PG8_SB(0, 1), b2 + hstepB, voffB); PG8_STAGE(PG8_SA(0, 0), a2, voffA);
            PG8_WAIT_V(8); PG8_WAIT_L(0); PG8_BAR; PG8_MMA(1, 0, At, B0); PG8_MMA(1, 1, At, B1); PG8_BAR; PG8_SCHED;
            PG8_LDB(B0, 1, 0); PG8_LDB(B1, 1, 1); PG8_SCHED; PG8_LDA(At, 1, 0); PG8_STAGE(PG8_SA(0, 1), a2 + hstepA, voffA);
            PG8_WAIT_V(8); PG8_WAIT_L(0); PG8_BAR; PG8_MMA(0, 0, At, B0); PG8_MMA(0, 1, At, B1); PG8_BAR; PG8_SCHED;
            PG8_LDA(At, 1, 1); PG8_STAGE(PG8_SB(1, 0), b3, voffB); PG8_STAGE(PG8_SB(1, 1), b3 + hstepB, voffB); PG8_STAGE(PG8_SA(1, 0), a3, voffA);
            PG8_WAIT_V(8); PG8_WAIT_L(0); PG8_BAR; PG8_MMA(1, 0, At, B0); PG8_MMA(1, 1, At, B1); PG8_BAR; PG8_SCHED;
            } else {
            PG8_LDB(B0, 0, 0); PG8_SCHED; PG8_LDA(At, 0, 0); PG8_STAGE(PG8_SA(1, 1), a1 + hstepA, voffA);
            PG8_WAIT_L(8); PG8_BAR; PG8_WAIT_L(0); PG8_MMA(0, 0, At, B0); PG8_BAR; PG8_SCHED;
            PG8_LDB(B1, 0, 1); PG8_STAGE(PG8_SB(0, 0), b2, voffB);
            PG8_BAR; PG8_WAIT_L(0); PG8_MMA(0, 1, At, B1); PG8_BAR;
            PG8_LDA(At, 0, 1); PG8_STAGE(PG8_SA(0, 0), a2, voffA);
            PG8_BAR; PG8_WAIT_L(0); PG8_MMA(1, 0, At, B0); PG8_BAR; PG8_SCHED;
            PG8_STAGE(PG8_SB(0, 1), b2 + hstepB, voffB);
            PG8_WAIT_V(6); PG8_BAR; PG8_MMA(1, 1, At, B1); PG8_BAR;
            PG8_LDB(B0, 1, 0); PG8_SCHED; PG8_LDA(At, 1, 0); PG8_STAGE(PG8_SA(0, 1), a2 + hstepA, voffA);
            PG8_WAIT_L(8); PG8_BAR; PG8_WAIT_L(0); PG8_MMA(0, 0, At, B0); PG8_BAR; PG8_SCHED;
            PG8_LDB(B1, 1, 1); PG8_STAGE(PG8_SB(1, 0), b3, voffB);
            PG8_BAR; PG8_WAIT_L(0); PG8_MMA(0, 1, At, B1); PG8_BAR;
            PG8_LDA(At, 1, 1); PG8_STAGE(PG8_SA(1, 0), a3, voffA);
            PG8_BAR; PG8_WAIT_L(0); PG8_MMA(1, 0, At, B0); PG8_BAR; PG8_SCHED;
            PG8_STAGE(PG8_SB(1, 1), b3 + hstepB, voffB);
            PG8_WAIT_V(6); PG8_BAR; PG8_MMA(1, 1, At, B1); PG8_BAR;
            }
        }
        if constexpr (ALIGN_EPI) { if (wr == 0) PG8_BAR; }
        if constexpr (!Epi::AFTER_DRAIN) { E(acc, cur, wr, wc, fr, fq); S.done(cur); }
        if (!has_next) break;
#pragma unroll
        for (int a = 0; a < 2; ++a)
#pragma unroll
            for (int b = 0; b < 2; ++b)
#pragma unroll
                for (int m = 0; m < 4; ++m)
#pragma unroll
                    for (int n = 0; n < 2; ++n) acc[a][b][m][n] = (f32x4){0.f, 0.f, 0.f, 0.f};
        cur = nxt; cA = nA; cB = nB; ++ui;
        if constexpr (ALIGN_EPI) { if (wr == 1) PG8_BAR; }
    }
    PG8_WAIT_V(0);
    if constexpr (!ALIGN_EPI) { if (wr == 0) PG8_BAR; }
    PG8_BAR;
    if constexpr (Epi::AFTER_DRAIN) { E.fused(acc, cur, wr, wc, fr, fq, lds, wid, lane); S.done(cur); }
#undef PG8_SA
#undef PG8_SB
#undef PG8_STAGE
#undef PG8_LDA
#undef PG8_LDB
#undef PG8_MMA
#undef PG8_WAIT_V
#undef PG8_WAIT_L
#undef PG8_BAR
#undef PG8_SCHED
}}
#define XB_TMO      128
#define XB_XCNT(j)  (256  + 64 * (j))
#define XB_XSUB(j)  (1280 + 64 * (j))
#define XB_XGEN(j)  (2304 + 64 * (j))
#define XB_TOP      3328
#define XB_TOPGEN   3392
#define XCD_BAR_WORDS 3456
#define XB_SPIN_CAP (1u << 18)

__device__ __forceinline__ unsigned xb_ld(unsigned* p)              { return __hip_atomic_load(p, __ATOMIC_RELAXED, __HIP_MEMORY_SCOPE_AGENT); }
__device__ __forceinline__ unsigned xb_add(unsigned* p, unsigned v) { return __hip_atomic_fetch_add(p, v, __ATOMIC_RELAXED, __HIP_MEMORY_SCOPE_AGENT); }
__device__ __forceinline__ unsigned xb_xcc_id() { return (unsigned)__builtin_amdgcn_s_getreg((3 << 11) | 20) & 0xFu; }
#define XB_SPIN(cond, bar) do { unsigned _sp = 0; while (cond) { __builtin_amdgcn_s_sleep(1); \
    if ((++_sp & 255u) == 0u) { if (xb_ld(&(bar)[XB_TMO])) break; if (_sp > XB_SPIN_CAP) { atomicAdd(&(bar)[XB_TMO], 1u); break; } } } } while (0)

struct XcdBarrier {
    unsigned* bar; unsigned x;
    volatile LAS unsigned* st;
};

__device__ __forceinline__ XcdBarrier xcd_barrier_post(unsigned* bar, volatile LAS unsigned* st) {
    XcdBarrier b; b.bar = bar; b.x = xb_xcc_id(); b.st = st;
    if (threadIdx.x == 0) (void)xb_add(&bar[XB_XCNT(b.x)], 1u);
    return b;
}
__device__ __forceinline__ void xcd_barrier_complete(unsigned* bar, unsigned x, unsigned& nloc, unsigned& nx) {
    const unsigned G = gridDim.x * gridDim.y * gridDim.z;
    unsigned sum, cnt, mine, sp = 0u;
    for (;;) {
        sum = 0u; cnt = 0u; mine = 0u;
#pragma unroll
        for (unsigned j = 0; j < 16; ++j) { const unsigned c = xb_ld(&bar[XB_XCNT(j)]); sum += c; cnt += (c > 0u) ? 1u : 0u; mine = (j == x) ? c : mine; }
        if (sum == G) break;
        __builtin_amdgcn_s_sleep(1);
        if ((++sp & 255u) == 0u) { if (xb_ld(&bar[XB_TMO])) break; if (sp > XB_SPIN_CAP) { atomicAdd(&bar[XB_TMO], 1u); break; } }
    }
    nloc = mine > 0u ? mine : 1u; nx = cnt > 0u ? cnt : 1u;
}

__device__ __forceinline__ void xcd_barrier(const XcdBarrier& b) {
    asm volatile("s_waitcnt vmcnt(0)" ::: "memory");
    __syncthreads();
    if (threadIdx.x == 0) {
        unsigned* bar = b.bar;
        __builtin_amdgcn_s_waitcnt(0);
        unsigned nloc = b.st[0], nx = b.st[1];
        if (nloc == 0u) { xcd_barrier_complete(bar, b.x, nloc, nx); b.st[0] = nloc; b.st[1] = nx; }
        const unsigned old = xb_add(&bar[XB_XSUB(b.x)], 1u);
        const unsigned gen = old / nloc;
        if (old + 1u == (gen + 1u) * nloc) {
            __builtin_amdgcn_fence(__ATOMIC_RELEASE, "agent");
            asm volatile("s_waitcnt vmcnt(0)" ::: "memory");
            const unsigned og = xb_add(&bar[XB_TOP], 1u);
            const unsigned tg = og / nx;
            if (og + 1u == (tg + 1u) * nx) xb_add(&bar[XB_TOPGEN], 1u);
            else XB_SPIN(xb_ld(&bar[XB_TOPGEN]) == tg, bar);
            __builtin_amdgcn_fence(__ATOMIC_ACQUIRE, "agent");
            xb_add(&bar[XB_XGEN(b.x)], 1u);
            asm volatile("s_waitcnt vmcnt(0)" ::: "memory");
        } else {
            XB_SPIN(xb_ld(&bar[XB_XGEN(b.x)]) == gen, bar);
            __builtin_amdgcn_fence(__ATOMIC_ACQUIRE, "agent");
            asm volatile("s_waitcnt vmcnt(0)" ::: "memory");
        }
    }
    __syncthreads();
}

extern __shared__ __attribute__((aligned(16))) unsigned char lds_raw[];
constexpr int MISC_OFF = 131072, PTRS_OFF = MISC_OFF + 256, XCH_OFF = MISC_OFF + 1024, LDS_BYTES = 147456;
DI const float* inp(int k) {
    volatile LAS unsigned* P = (volatile LAS unsigned*)((LAS unsigned char*)lds_raw + PTRS_OFF);
    const unsigned lo = __builtin_amdgcn_readfirstlane(P[2 * k]), hi = __builtin_amdgcn_readfirstlane(P[2 * k + 1]);
    return (const float*)(((unsigned long long)hi << 32) | lo);
}
DI int lane_id() { int l; asm volatile("v_mbcnt_lo_u32_b32 %0, -1, 0\n\tv_mbcnt_hi_u32_b32 %0, -1, %0" : "=v"(l)); return l; }
#define LDS_WAIT() asm volatile("s_waitcnt lgkmcnt(0)" ::: "memory")
#define VM_WAIT() asm volatile("s_waitcnt vmcnt(0)" ::: "memory")
typedef __bf16 bf16x2_t __attribute__((ext_vector_type(2)));
DI unsigned pk2(float lo, float hi) { const f32x2 v = {lo, hi}; const bf16x2_t b = __builtin_convertvector(v, bf16x2_t); return __builtin_bit_cast(unsigned, b); }
DI float bf2f(unsigned short h) { return __uint_as_float(((unsigned)h) << 16); }
DI float bflo(unsigned w) { return __uint_as_float(w << 16); }
DI float bfhi(unsigned w) { return __uint_as_float(w & 0xffff0000u); }
DI float dpp_sum16(float x) {
    x += __int_as_float(__builtin_amdgcn_update_dpp(0, __float_as_int(x), 0xB1, 0xF, 0xF, true));
    x += __int_as_float(__builtin_amdgcn_update_dpp(0, __float_as_int(x), 0x4E, 0xF, 0xF, true));
    x += __int_as_float(__builtin_amdgcn_update_dpp(0, __float_as_int(x), 0x141, 0xF, 0xF, true));
    x += __int_as_float(__builtin_amdgcn_update_dpp(0, __float_as_int(x), 0x140, 0xF, 0xF, true));
    return x;
}
DI float wave_sum(float v) {
    v = dpp_sum16(v);
    const float a = __int_as_float(__builtin_amdgcn_readlane(__float_as_int(v), 0)), b = __int_as_float(__builtin_amdgcn_readlane(__float_as_int(v), 16));
    const float c = __int_as_float(__builtin_amdgcn_readlane(__float_as_int(v), 32)), d = __int_as_float(__builtin_amdgcn_readlane(__float_as_int(v), 48));
    return (a + b) + (c + d);
}
DI float ex2(float x) { return __builtin_amdgcn_exp2f(x); }
DI float lg2(float x) { return __builtin_amdgcn_logf(x); }
DI float rcpf_(float x) { return __builtin_amdgcn_rcpf(x); }
DI float sigmoidf_(float x) { return rcpf_(1.f + ex2(-x * LOG2E)); }
DI float siluf_(float x) { return x * sigmoidf_(x); }
DI float softplusf_(float x) { return fmaxf(x, 0.f) + lg2(1.f + ex2(-fabsf(x) * LOG2E)) * 0.6931471805599453f; }
DI float tanhf_(float x) { const float e = ex2(-2.f * fabsf(x) * LOG2E); const float t = (1.f - e) * rcpf_(1.f + e); return x < 0.f ? -t : t; }

struct TrDesc { const float* W; bf16* WT; int ldw, Kr, Nr, ldt, nblk, start; };
constexpr int NTR = 23;
DI void tr_load(const TrDesc& d, int item, int lane, float (&v)[32]) {
    const int kb = item / d.nblk, nb = item % d.nblk, k0 = 64 * kb, n = 32 * nb + (lane & 31);
#pragma unroll
    for (int i = 0; i < 32; ++i) { const int k = k0 + 2 * i + (lane >> 5); v[i] = (k < d.Kr && n < d.Nr) ? d.W[(size_t)k * d.ldw + n] : 0.f; }
}
DI void tr_finish(const TrDesc& d, LAS float* scr, int item, int lane, const float (&v)[32]) {
    const int kb = item / d.nblk, nb = item % d.nblk, k0 = 64 * kb, n0 = 32 * nb;
#pragma unroll
    for (int i = 0; i < 32; ++i) scr[(2 * i + (lane >> 5)) * 33 + (lane & 31)] = v[i];
    LDS_WAIT(); asm volatile("" ::: "memory");
    const int c = lane & 7;
#pragma unroll
    for (int j = 0; j < 4; ++j) { const int nn = (lane >> 3) + 8 * j; const LAS float* s = scr + (8 * c) * 33 + nn;
        u32x4 o; o.x = pk2(s[0 * 33], s[1 * 33]); o.y = pk2(s[2 * 33], s[3 * 33]); o.z = pk2(s[4 * 33], s[5 * 33]); o.w = pk2(s[6 * 33], s[7 * 33]);
        *(GAS u32x4*)(d.WT + (size_t)(n0 + nn) * d.ldt + k0 + 8 * c) = o; }
    LDS_WAIT(); asm volatile("" ::: "memory");
}
DI void tr_item(const TrDesc& d, LAS float* scr, int item, int lane) { float v[32]; tr_load(d, item, lane, v); tr_finish(d, scr, item, lane, v); }
DI void row_to_bf16(const float* src, bf16* ob, float* of, int lane) {
    const GAS f32x4* xr = (const GAS f32x4*)src + lane;
    GAS u32x2* o8 = (GAS u32x2*)ob + lane;
#pragma unroll
    for (int j = 0; j < 8; ++j) { const f32x4 v = xr[64 * j]; u32x2 w; w.x = pk2(v.x, v.y); w.y = pk2(v.z, v.w); o8[64 * j] = w;
        if (of) ((GAS f32x4*)of)[lane + 64 * j] = v; }
}
DI void ln_rows(const bf16* HB, const float* gwv, const float* gbv, float* of_p, float* of_s, bf16* ob, int gw, int NGW, int lane) {
    f32x4 g[8], b[8];
#pragma unroll
    for (int j = 0; j < 4; ++j) { const int c = 8 * (lane + 64 * j); g[2 * j] = *(const GAS f32x4*)(gwv + c); g[2 * j + 1] = *(const GAS f32x4*)(gwv + c + 4); b[2 * j] = *(const GAS f32x4*)(gbv + c); b[2 * j + 1] = *(const GAS f32x4*)(gbv + c + 4); }
    for (int rowa = gw; rowa < MR; rowa += 2 * NGW) {
        const int rowb = rowa + NGW; const bool hb = rowb < MR;
        u32x4 wa[4], wb[4];
#pragma unroll
        for (int j = 0; j < 4; ++j) { wa[j] = ((const GAS u32x4*)(HB + (size_t)rowa * D) + lane)[64 * j]; wb[j] = hb ? ((const GAS u32x4*)(HB + (size_t)rowb * D) + lane)[64 * j] : wa[j]; }
#pragma unroll
        for (int rr = 0; rr < 2; ++rr) { if (rr == 1 && !hb) break; const int row = rr ? rowb : rowa;
            f32x4 v[8]; float s = 0.f;
#pragma unroll
            for (int j = 0; j < 4; ++j) { const u32x4 w = rr ? wb[j] : wa[j]; v[2 * j] = (f32x4){bflo(w.x), bfhi(w.x), bflo(w.y), bfhi(w.y)}; v[2 * j + 1] = (f32x4){bflo(w.z), bfhi(w.z), bflo(w.w), bfhi(w.w)}; }
#pragma unroll
            for (int j = 0; j < 8; ++j) s += (v[j].x + v[j].y) + (v[j].z + v[j].w);
            const float mean = wave_sum(s) * (1.f / D); float s2 = 0.f;
#pragma unroll
            for (int j = 0; j < 8; ++j) { v[j] = v[j] - mean; s2 += (v[j].x * v[j].x + v[j].y * v[j].y) + (v[j].z * v[j].z + v[j].w * v[j].w); }
            const float rstd = 1.f / sqrtf(wave_sum(s2) * (1.f / D) + LN_EPS);
#pragma unroll
            for (int j = 0; j < 4; ++j) { const f32x4 o0 = v[2 * j] * rstd * g[2 * j] + b[2 * j], o1 = v[2 * j + 1] * rstd * g[2 * j + 1] + b[2 * j + 1]; const int c = 8 * (lane + 64 * j);
                if (ob) { u32x4 w = {pk2(o0.x, o0.y), pk2(o0.z, o0.w), pk2(o1.x, o1.y), pk2(o1.z, o1.w)}; *(GAS u32x4*)(ob + (size_t)row * D + c) = w; }
                if (of_p) { float* of = row < MPR ? of_p + (size_t)row * D : of_s + (size_t)(row - MPR) * D; *(GAS f32x4*)(of + c) = o0; *(GAS f32x4*)(of + c + 4) = o1; } } } }
}
#define KSWZ(row, colB) ((row) * 256 + ((colB) ^ (((row) & 7) << 4)))
#define SBAR() __builtin_amdgcn_sched_barrier(0)
#define MFMA32(a, b, c) __builtin_amdgcn_mfma_f32_32x32x16_bf16((a), (b), (c), 0, 0, 0)
DI int crow(int r, int hi) { return (r & 3) + 8 * (r >> 2) + 4 * hi; }
DI int v_st(int k, int c) { const int kk = (k & ~0xC) | ((k & 4) << 1) | ((k & 8) >> 1); return ((kk >> 3) * 4 + (c >> 5)) * 512 + ((kk & 7) * 32 + (c & 31)) * 2; }
DI int v_rd_base(int lane) { return ((lane & 3) << 3) | (((lane >> 2) & 3) << 6) | (((lane >> 4) & 1) << 5) | (((lane >> 5) & 1) << 8); }
constexpr int v_rd_off(int d0, int ks, int half) { return d0 * 512 + ks * 4096 + half * 2048; }
template <int OFF> DI s16x4 tr_read(unsigned vb) { s16x4 r; asm volatile("ds_read_b64_tr_b16 %0, %1 offset:%2" : "=&v"(r) : "v"(vb), "i"(OFF) : "memory"); return r; }
#define PKLH(L, H) (bf16x8){L[0], L[1], L[2], L[3], H[0], H[1], H[2], H[3]}
template <int D0, int KS> DI bf16x8 tr_frag(unsigned vb) { const s16x4 l = tr_read<v_rd_off(D0, KS, 0)>(vb), h = tr_read<v_rd_off(D0, KS, 1)>(vb); asm volatile("s_waitcnt lgkmcnt(0)" ::: "memory"); SBAR(); return PKLH(l, h); }
template <int D0> DI void pv_one(f32x16& od, unsigned vb, bf16x8 pa0, bf16x8 pa1, bf16x8 pa2, bf16x8 pa3) {
    const s16x4 l0 = tr_read<v_rd_off(D0, 0, 0)>(vb), h0 = tr_read<v_rd_off(D0, 0, 1)>(vb), l1 = tr_read<v_rd_off(D0, 1, 0)>(vb), h1 = tr_read<v_rd_off(D0, 1, 1)>(vb);
    const s16x4 l2 = tr_read<v_rd_off(D0, 2, 0)>(vb), h2 = tr_read<v_rd_off(D0, 2, 1)>(vb), l3 = tr_read<v_rd_off(D0, 3, 0)>(vb), h3 = tr_read<v_rd_off(D0, 3, 1)>(vb);
    asm volatile("s_waitcnt lgkmcnt(0)" ::: "memory"); SBAR();
    od = MFMA32(pa0, PKLH(l0, h0), od); od = MFMA32(pa1, PKLH(l1, h1), od); od = MFMA32(pa2, PKLH(l2, h2), od); od = MFMA32(pa3, PKLH(l3, h3), od);
}
DI void pv_d0(f32x16 (&o)[4], unsigned vb, bf16x8 pa0, bf16x8 pa1, bf16x8 pa2, bf16x8 pa3) {
    pv_one<0>(o[0], vb, pa0, pa1, pa2, pa3); pv_one<1>(o[1], vb, pa0, pa1, pa2, pa3); pv_one<2>(o[2], vb, pa0, pa1, pa2, pa3); pv_one<3>(o[3], vb, pa0, pa1, pa2, pa3);
}
DI void qkt(f32x16& p0, f32x16& p1, const LAS char* Ks, const bf16x8 (&qr)[8], int r32, int hi) {
#pragma unroll
    for (int i = 0; i < 16; ++i) { p0[i] = 0.f; p1[i] = 0.f; }
#pragma unroll
    for (int d0 = 0; d0 < 8; ++d0) { const int cb = (d0 * 16 + hi * 8) * 2;
        const bf16x8 b0 = *(const LAS bf16x8*)(Ks + KSWZ(r32, cb)), b1 = *(const LAS bf16x8*)(Ks + KSWZ(32 + r32, cb));
        p0 = MFMA32(b0, qr[d0], p0); p1 = MFMA32(b1, qr[d0], p1); }
}
#define PK4(P, BASE, OUT) do { unsigned a0_ = pk2(P[BASE + 0], P[BASE + 1]), a1_ = pk2(P[BASE + 2], P[BASE + 3]); \
    unsigned b0_ = pk2(P[BASE + 4], P[BASE + 5]), b1_ = pk2(P[BASE + 6], P[BASE + 7]); \
    auto r0_ = __builtin_amdgcn_permlane32_swap(a0_, b0_, false, false); auto r1_ = __builtin_amdgcn_permlane32_swap(a1_, b1_, false, false); \
    u32x4 w_ = {r0_[0], r1_[0], r0_[1], r1_[1]}; OUT = __builtin_bit_cast(bf16x8, w_); } while (0)
DI float swap_lo(float x, float& hi_out) { auto rr = __builtin_amdgcn_permlane32_swap(__float_as_uint(x), __float_as_uint(x), false, false); hi_out = __uint_as_float(rr[1]); return __uint_as_float(rr[0]); }

struct KVStage { bf16x8 k0, k1, v0, v1; };
DI void kv_load(KVStage& s, const bf16* Kp, const bf16* Vp, size_t ld, int key0, int sr, int sc) {
    s.k0 = *(const GAS bf16x8*)(Kp + (size_t)(key0 + sr) * ld + sc); s.k1 = *(const GAS bf16x8*)(Kp + (size_t)(key0 + 32 + sr) * ld + sc);
    s.v0 = *(const GAS bf16x8*)(Vp + (size_t)(key0 + sr) * ld + sc); s.v1 = *(const GAS bf16x8*)(Vp + (size_t)(key0 + 32 + sr) * ld + sc);
}
DI void kv_write(const KVStage& s, LAS char* Kl, LAS char* Vl, int sr, int sc) {
    *(LAS bf16x8*)(Vl + v_st(sr, sc)) = s.v0; *(LAS bf16x8*)(Vl + v_st(32 + sr, sc)) = s.v1;
    *(LAS bf16x8*)(Kl + KSWZ(sr, sc * 2)) = s.k0; *(LAS bf16x8*)(Kl + KSWZ(32 + sr, sc * 2)) = s.k1;
}

template <bool MASK> DI void sb_half_pre(f32x16& p, float (&l)[16], float C, float bias2, int key0, int tq, int hi) {
#pragma unroll
    for (int r = 0; r < 16; ++r) { const float z = fmaf(p[r], C, bias2); const float e = ex2(z); float ll = lg2(1.f + e); float lb = z - ll;
        if (MASK) { const bool vis = (key0 + crow(r, hi)) < tq; ll = vis ? ll : 0.f; lb = vis ? lb : -1e30f; }
        l[r] = ll; p[r] = lb; }
}
DI void sb_half_fin(f32x16& p, const float (&l)[16], const float (&gbase)[4]) {
#pragma unroll
    for (int g = 0; g < 4; ++g) { float t = gbase[g];
        p[4 * g + 3] = ex2(p[4 * g + 3] - t); t += l[4 * g + 3];
        p[4 * g + 2] = ex2(p[4 * g + 2] - t); t += l[4 * g + 2];
        p[4 * g + 1] = ex2(p[4 * g + 1] - t); t += l[4 * g + 1];
        p[4 * g + 0] = ex2(p[4 * g + 0] - t); }
}
template <bool MASK> DI void sb_half(f32x16& p0, float C, float bias2, float& carry, int key0, int tq, int hi) {
    float l0[16]; sb_half_pre<MASK>(p0, l0, C, bias2, key0, tq, hi);
    float Glo[4], Ghi[4];
#pragma unroll
    for (int g = 0; g < 4; ++g) { const float s0 = (l0[4 * g] + l0[4 * g + 1]) + (l0[4 * g + 2] + l0[4 * g + 3]); Glo[g] = swap_lo(s0, Ghi[g]); }
    float R = carry; float gb[4];
#pragma unroll
    for (int g = 3; g >= 0; --g) { gb[g] = R + (hi == 0 ? Ghi[g] : 0.f); R += Glo[g] + Ghi[g]; }
    carry = R;
    sb_half_fin(p0, l0, gb);
}
template <bool MASK> DI void sb_tile64(f32x16& p0, f32x16& p1, float C, float bias2, float& carry, int key0, int tq, int hi) {
    sb_half<MASK>(p1, C, bias2, carry, key0 + 32, tq, hi); sb_half<MASK>(p0, C, bias2, carry, key0, tq, hi);
}
DI void sb_tile32(f32x16& p0, float C, float bias2, float& carry, int hi) { sb_half<false>(p0, C, bias2, carry, 0, 0, hi); }

template <bool MASK> DI void sbl_half(f32x16& p, float C, float bias2, float& carryP, int key0, int tq, int hi) {
    float kp[16];
#pragma unroll
    for (int r = 0; r < 16; ++r) { const float z = fmaf(p[r], C, bias2); const float e = ex2(z); float k = rcpf_(1.f + e); float bta = e * k;
        if (MASK) { const bool vis = (key0 + crow(r, hi)) < tq; k = vis ? k : 1.f; bta = vis ? bta : 0.f; }
        kp[r] = k; p[r] = bta; }
    float Glo[4], Ghi[4];
#pragma unroll
    for (int g = 0; g < 4; ++g) { const float s0 = (kp[4 * g] * kp[4 * g + 1]) * (kp[4 * g + 2] * kp[4 * g + 3]); Glo[g] = swap_lo(s0, Ghi[g]); }
    float R = carryP; float gb[4];
#pragma unroll
    for (int g = 3; g >= 0; --g) { gb[g] = hi == 0 ? R * Ghi[g] : R; R *= Glo[g] * Ghi[g]; }
    carryP = R;
#pragma unroll
    for (int g = 0; g < 4; ++g) { float t = gb[g];
        p[4 * g + 3] *= t; t *= kp[4 * g + 3];
        p[4 * g + 2] *= t; t *= kp[4 * g + 2];
        p[4 * g + 1] *= t; t *= kp[4 * g + 1];
        p[4 * g + 0] *= t; }
}
template <bool MASK> DI void sbl_tile64(f32x16& p0, f32x16& p1, float C, float bias2, float& carryP, int key0, int tq, int hi) {
    sbl_half<MASK>(p1, C, bias2, carryP, key0 + 32, tq, hi); sbl_half<MASK>(p0, C, bias2, carryP, key0, tq, hi);
}

DI void sbp_unit(LAS char* lds, const bf16* PROJ, bf16* ATT, float bias, int b, int h, int qb, int tid) {
    const int wid = __builtin_amdgcn_readfirstlane(tid >> 6), lane = tid & 63, r32 = lane & 31, hi = lane >> 5;
    LAS char* Kl[2] = {lds, lds + 16384}; LAS char* Vl[2] = {lds + 32768, lds + 49152};
    const bf16* Qp = PROJ + (size_t)(b * TP) * NIN + h * HD; const bf16* Kp = Qp + SBW; const bf16* Vp = Qp + 2 * SBW;
    const int Q0 = qb * 256, tmin = Q0 + 32 * wid, tq = tmin + r32, tmax = tmin + 31;
    bf16x8 qr[8];
#pragma unroll
    for (int d0 = 0; d0 < 8; ++d0) qr[d0] = *(const GAS bf16x8*)(Qp + (size_t)tq * NIN + d0 * 16 + hi * 8);
    const float C = 0.08838834764831845f * LOG2E, bias2 = bias * LOG2E;
    f32x16 o[4];
#pragma unroll
    for (int d = 0; d < 4; ++d)
#pragma unroll
        for (int i = 0; i < 16; ++i) o[d][i] = 0.f;
    float carry = 1.f;
    const int sr = tid >> 4, sc = (tid & 15) * 8;
    const unsigned vb0 = (unsigned)(uintptr_t)Vl[0] + v_rd_base(lane), vb1 = (unsigned)(uintptr_t)Vl[1] + v_rd_base(lane);
    const int jmax = Q0 / 64 + 3;
    KVStage st; kv_load(st, Kp, Vp, NIN, jmax * 64, sr, sc); kv_write(st, Kl[0], Vl[0], sr, sc); __syncthreads();
    int cur = 0;
    for (int j = jmax; j >= 0; --j) {
        if (j > 0) kv_load(st, Kp, Vp, NIN, (j - 1) * 64, sr, sc);
        if (64 * j < tmax) {
            f32x16 p0, p1; bf16x8 pa0, pa1, pa2, pa3;
            qkt(p0, p1, cur ? Kl[1] : Kl[0], qr, r32, hi);
            if (64 * j + 63 >= tmin) sbl_tile64<true>(p0, p1, C, bias2, carry, 64 * j, tq, hi); else sbl_tile64<false>(p0, p1, C, bias2, carry, 64 * j, tq, hi);
            PK4(p0, 0, pa0); PK4(p0, 8, pa1); PK4(p1, 0, pa2); PK4(p1, 8, pa3);
            pv_d0(o, cur ? vb1 : vb0, pa0, pa1, pa2, pa3);
        }
        if (j > 0) kv_write(st, cur ? Kl[0] : Kl[1], cur ? Vl[0] : Vl[1], sr, sc);
        __syncthreads();
        cur ^= 1;
    }
    bf16* Ow = ATT + (size_t)(b * TP + tmin) * D + h * HD;
#pragma unroll
    for (int r = 0; r < 16; ++r) { const int orow = crow(r, hi);
#pragma unroll
        for (int d0 = 0; d0 < 4; ++d0) Ow[(size_t)orow * D + d0 * 32 + r32] = (bf16)(pk2(o[d0][r], 0.f) & 0xffffu); }
}

DI void mem_unit(LAS char* lds, LAS float* xch  , const bf16* Qp  , size_t ldq, int nq, const bf16* Kp, const bf16* Vp, size_t ldk, bf16* Op, size_t ldo, int tid) {
    const int wid = __builtin_amdgcn_readfirstlane(tid >> 6), lane = tid & 63, r32 = lane & 31, hi = lane >> 5;
    const int sr = tid >> 4, sc = (tid & 15) * 8;
#pragma unroll
    for (int t = 0; t < 4; ++t) { KVStage st; kv_load(st, Kp, Vp, ldk, t * 64, sr, sc); kv_write(st, lds + t * 16384, lds + 65536 + t * 16384, sr, sc); }
    __syncthreads();
    const int qrow = 32 * wid + r32;
    if (32 * wid < nq) {
        bf16x8 qr[8];
#pragma unroll
        for (int d0 = 0; d0 < 8; ++d0) { bf16x8 z = {0, 0, 0, 0, 0, 0, 0, 0}; qr[d0] = (qrow < nq) ? *(const GAS bf16x8*)(Qp + (size_t)qrow * ldq + d0 * 16 + hi * 8) : z; }
        const float C = 0.08838834764831845f * LOG2E;
        float m = -1e30f;
#pragma unroll
        for (int t = 0; t < 4; ++t) { f32x16 p0, p1; qkt(p0, p1, lds + t * 16384, qr, r32, hi);
#pragma unroll
            for (int r = 0; r < 16; ++r) m = fmaxf(m, fmaxf(p0[r], p1[r])); }
        { float mh; const float ml = swap_lo(m, mh); m = fmaxf(ml, mh); }
        const float mC = -m * C; float l = 0.f;
        f32x16 o[4];
#pragma unroll
        for (int d = 0; d < 4; ++d)
#pragma unroll
            for (int i = 0; i < 16; ++i) o[d][i] = 0.f;
#pragma unroll
        for (int t = 0; t < 4; ++t) { f32x16 p0, p1; bf16x8 pa0, pa1, pa2, pa3; qkt(p0, p1, lds + t * 16384, qr, r32, hi);
#pragma unroll
            for (int r = 0; r < 16; ++r) { p0[r] = ex2(fmaf(p0[r], C, mC)); p1[r] = ex2(fmaf(p1[r], C, mC)); l += p0[r] + p1[r]; }
            PK4(p0, 0, pa0); PK4(p0, 8, pa1); PK4(p1, 0, pa2); PK4(p1, 8, pa3);
            pv_d0(o, (unsigned)(uintptr_t)(lds + 65536 + t * 16384) + v_rd_base(lane), pa0, pa1, pa2, pa3); }
        { float lh; const float ll = swap_lo(l, lh); l = ll + lh; }
        if (hi == 0) xch[r32] = l;
        LDS_WAIT(); asm volatile("" ::: "memory");
#pragma unroll
        for (int r = 0; r < 16; ++r) { const int orow = 32 * wid + crow(r, hi); const float rl = rcpf_(xch[crow(r, hi)]);
            if (orow < nq) {
#pragma unroll
                for (int d0 = 0; d0 < 4; ++d0) Op[(size_t)orow * ldo + d0 * 32 + r32] = (bf16)(pk2(o[d0][r] * rl, 0.f) & 0xffffu); } }
    }
    __syncthreads();
}

DI void sbs_unit(LAS char* qlds  , const bf16* PROJ, const float* cK, const float* cV, const int* page_table, float bias, float* PO, float* PL, int db, int pg, int h, int lane) {
    const int r32 = lane & 31, hi = lane >> 5;
    const int phys = page_table[db * NPAGES + pg];
    const float* Kb = cK + (size_t)phys * PAGE * SBW + h * HD; const float* Vb = cV + (size_t)phys * PAGE * SBW + h * HD;
#pragma unroll
    for (int d0 = 0; d0 < 8; ++d0) { bf16x8 z = {0, 0, 0, 0, 0, 0, 0, 0}; const bf16x8 q = (r32 < TS) ? *(const GAS bf16x8*)(PROJ + (size_t)(MPR + db * TS + r32) * NIN + h * HD + d0 * 16 + hi * 8) : z;
        *(LAS bf16x8*)(qlds + d0 * 1024 + lane * 16) = q; }
    const float C = 0.08838834764831845f * LOG2E, bias2 = bias * LOG2E;
    f32x16 o[4];
#pragma unroll
    for (int d = 0; d < 4; ++d)
#pragma unroll
        for (int i = 0; i < 16; ++i) o[d][i] = 0.f;
    float carry = 0.f;
    f32x4 kraw[16];
#define SBS_LOADK(blk_) do { const GAS float* kr_ = (const GAS float*)(Kb + (size_t)((blk_) * 32 + r32) * SBW + 8 * hi); \
        _Pragma("unroll") for (int d0 = 0; d0 < 8; ++d0) { kraw[2 * d0] = *(const GAS f32x4*)(kr_ + 16 * d0); kraw[2 * d0 + 1] = *(const GAS f32x4*)(kr_ + 16 * d0 + 4); } } while (0)
#define SBS_LOADV(dst, ks_) do { const GAS float* vr_ = (const GAS float*)(Vb + (size_t)(key0 + 16 * (ks_) + 8 * hi) * SBW + r32); \
        _Pragma("unroll") for (int d0 = 0; d0 < 4; ++d0) _Pragma("unroll") for (int j = 0; j < 8; ++j) dst[d0][j] = vr_[(size_t)j * SBW + 32 * d0]; } while (0)
#define SBS_PV(src, pa_) do { _Pragma("unroll") for (int d0 = 0; d0 < 4; ++d0) { u32x4 w_ = {pk2(src[d0][0], src[d0][1]), pk2(src[d0][2], src[d0][3]), pk2(src[d0][4], src[d0][5]), pk2(src[d0][6], src[d0][7])}; \
        o[d0] = MFMA32(pa_, __builtin_bit_cast(bf16x8, w_), o[d0]); } } while (0)
#define SBS_BLOCK(blk_, NEXT) do { const int key0 = (blk_) * 32; float vA[4][8], vB[4][8]; \
        SBAR(); SBS_LOADV(vA, 0); SBAR(); \
        f32x16 p; _Pragma("unroll") for (int i = 0; i < 16; ++i) p[i] = 0.f; \
        _Pragma("unroll") for (int d0 = 0; d0 < 8; ++d0) { const f32x4 ka = kraw[2 * d0], kc = kraw[2 * d0 + 1]; \
            u32x4 w = {pk2(ka.x, ka.y), pk2(ka.z, ka.w), pk2(kc.x, kc.y), pk2(kc.z, kc.w)}; \
            const bf16x8 q = *(const LAS bf16x8*)(qlds + d0 * 1024 + lane * 16); \
            p = MFMA32(__builtin_bit_cast(bf16x8, w), q, p); } \
        SBAR(); SBS_LOADV(vB, 1); SBAR(); \
        sb_tile32(p, C, bias2, carry, hi); \
        bf16x8 pa0, pa1; PK4(p, 0, pa0); PK4(p, 8, pa1); \
        SBAR(); SBS_PV(vA, pa0); SBAR(); \
        if (NEXT) SBS_LOADK((blk_) - 1); \
        SBAR(); SBS_PV(vB, pa1); SBAR(); } while (0)
    SBS_LOADK(3);
#pragma nounroll
    for (int blk = 3; blk >= 1; --blk) SBS_BLOCK(blk, true);
    SBS_BLOCK(0, false);
#undef SBS_BLOCK
#undef SBS_LOADV
#undef SBS_PV
#undef SBS_LOADK
    const size_t ub = ((size_t)(db * NPAGES + pg) * SBH + h) * TS;
#pragma unroll
    for (int r = 0; r < 4; ++r) { const int q = crow(r, hi);
#pragma unroll
        for (int d0 = 0; d0 < 4; ++d0) PO[(ub + q) * HD + d0 * 32 + r32] = o[d0][r]; }
    if (lane < TS) PL[ub + lane] = carry;
}
DI void sbs_combine(const bf16* PROJ, const float* PO, const float* PL, float bias, bf16* ATT, int db, int h, int q, int lane) {
    const float C = 0.08838834764831845f * LOG2E, bias2 = bias * LOG2E;
    const size_t rowq = (size_t)(MPR + db * TS + q);
    const unsigned qw = *(const GAS unsigned*)(PROJ + rowq * NIN + h * HD + 2 * lane);
    const float q0 = bflo(qw), q1 = bfhi(qw);
    float o0 = 0.f, o1 = 0.f, carry = 0.f;
    for (int s = q - 1; s >= 0; --s) {
        const size_t rows = (size_t)(MPR + db * TS + s);
        const unsigned kw = *(const GAS unsigned*)(PROJ + rows * NIN + SBW + h * HD + 2 * lane), vw = *(const GAS unsigned*)(PROJ + rows * NIN + 2 * SBW + h * HD + 2 * lane);
        const float dot = wave_sum(q0 * bflo(kw) + q1 * bfhi(kw));
        const float z = fmaf(dot, C, bias2), e = ex2(z), ll = lg2(1.f + e), a = ex2(z - ll - carry);
        o0 = fmaf(a, bflo(vw), o0); o1 = fmaf(a, bfhi(vw), o1); carry += ll;
    }
    for (int pg0 = NPAGES - 16; pg0 >= 0; pg0 -= 16) {
        f32x2 po[16]; float pl[16];
#pragma unroll
        for (int i = 0; i < 16; ++i) { const size_t ub = ((size_t)(db * NPAGES + pg0 + 15 - i) * SBH + h) * TS + q; po[i] = *(const GAS f32x2*)(PO + ub * HD + 2 * lane); pl[i] = PL[ub]; }
#pragma unroll
        for (int i = 0; i < 16; ++i) { const float sc = ex2(-carry); o0 = fmaf(sc, po[i].x, o0); o1 = fmaf(sc, po[i].y, o1); carry += pl[i]; }
    }
    *(GAS unsigned*)(ATT + rowq * D + h * HD + 2 * lane) = pk2(o0, o1);
}
DI void gla_decode(int u, int& row0, int& h, int& nvalid) {
    if (u < 512) { const int b = u >> 8, rem = u & 255; h = rem & 3; row0 = b * TP + (rem >> 2) * 64; nvalid = 64; }
    else { const int su = u - 512; h = su & 3; row0 = MPR + (su >> 2) * TS; nvalid = TS; }
}
template <int KS> DI bf16x8 tr_frag_rt(unsigned vb) {
    const s16x4 l = tr_read<v_rd_off(0, KS, 0)>(vb), h = tr_read<v_rd_off(0, KS, 1)>(vb); asm volatile("s_waitcnt lgkmcnt(0)" ::: "memory"); SBAR(); return PKLH(l, h);
}
DI void gla_g1(LAS char* lds, int u, const bf16* PROJ, const float* LOW, const float* w_a2, const float* b_a, float* DST, float* DEC, float* GO, bf16* QDg, int tid) {
    int row0, h, nvalid; gla_decode(u, row0, h, nvalid);
    const int wid = __builtin_amdgcn_readfirstlane(tid >> 6), lane = tid & 63, r32 = lane & 31, hi = lane >> 5;
    LAS float* lowb = (LAS float*)lds; LAS float* gt = (LAS float*)(lds + 4096);
    LAS char* QDt = lds + 8192; LAS char* KDt = lds + 24576; LAS char* KEt = lds + 40960; LAS char* Vt0 = lds + 57344; LAS char* Vt1 = lds + 73728;
    if (tid < 256) { const int t = tid >> 2, j4 = (tid & 3) * 4; f32x4 v = {0.f, 0.f, 0.f, 0.f}; if (t < nvalid) v = *(const GAS f32x4*)(LOW + (size_t)(row0 + t) * 16 + j4); *(LAS f32x4*)(lowb + t * 16 + j4) = v; }
    { const int sr = tid >> 4, sc = (tid & 15) * 8; const bf16x8 z = {0, 0, 0, 0, 0, 0, 0, 0};
#pragma unroll
        for (int rr = 0; rr < 2; ++rr) { const int t = sr + 32 * rr; const bf16* vp = PROJ + (size_t)(row0 + t) * NIN + 4096 + h * GDV + sc;
            const bf16x8 a = (t < nvalid) ? *(const GAS bf16x8*)vp : z, b = (t < nvalid) ? *(const GAS bf16x8*)(vp + 128) : z;
            *(LAS bf16x8*)(Vt0 + v_st(t, sc)) = a; *(LAS bf16x8*)(Vt1 + v_st(t, sc)) = b; } }
    __syncthreads();
    const int c = tid & 127, tg = tid >> 7;
    float cs[16];
    { float wa[16];
#pragma unroll
        for (int j = 0; j < 16; ++j) wa[j] = w_a2[(size_t)j * GKW + h * GDK + c];
        const float ba = b_a[h * GDK + c]; float run = 0.f;
#pragma unroll
        for (int i = 0; i < 16; ++i) { const int t = 16 * tg + i; float pre = ba;
#pragma unroll
            for (int j4 = 0; j4 < 4; ++j4) { const f32x4 lw = *(const LAS f32x4*)(lowb + t * 16 + 4 * j4); pre += lw.x * wa[4 * j4] + lw.y * wa[4 * j4 + 1] + lw.z * wa[4 * j4 + 2] + lw.w * wa[4 * j4 + 3]; }
            const float la = (t < nvalid) ? -softplusf_(-pre) * (1.f / 16.f) : 0.f; run += la; cs[i] = run; }
        gt[tg * 128 + c] = run; }
    __syncthreads();
    { const float g0 = gt[c], g1 = gt[128 + c], g2 = gt[256 + c], g3 = gt[384 + c];
        const float off = (tg > 0 ? g0 : 0.f) + (tg > 1 ? g1 : 0.f) + (tg > 2 ? g2 : 0.f), blast = (g0 + g1) + (g2 + g3);
        if (tg == 0) DEC[(size_t)u * GDK + c] = ex2(blast * LOG2E);
#pragma unroll
        for (int i = 0; i < 16; ++i) { const int t = 16 * tg + i; const float b = cs[i] + off;
            float q = 0.f, k = 0.f;
            if (t < nvalid) { q = bf2f(PROJ[(size_t)(row0 + t) * NIN + 3072 + h * GDK + c]); k = bf2f(PROJ[(size_t)(row0 + t) * NIN + 3584 + h * GDK + c]); }
            const float eb = ex2(b * LOG2E), enb = ex2(-b * LOG2E), ele = ex2((blast - b) * LOG2E);
            const bf16 qd = (bf16)(pk2(q * 0.08838834764831845f * eb, 0.f) & 0xffffu), kd = (bf16)(pk2(k * enb, 0.f) & 0xffffu), ke = (bf16)(pk2(k * ele, 0.f) & 0xffffu);
            *(LAS bf16*)(QDt + KSWZ(t, 2 * c)) = qd; *(LAS bf16*)(KDt + KSWZ(t, 2 * c)) = kd; *(LAS bf16*)(KEt + v_st(t, c)) = ke;
            if (t < nvalid) QDg[(size_t)(row0 + t) * GKW + h * GDK + c] = qd; } }
    __syncthreads();
    if (wid < 4) { const int tblk = wid & 1, vt = wid >> 1;
        bf16x8 qr[8];
#pragma unroll
        for (int d0 = 0; d0 < 8; ++d0) qr[d0] = *(const LAS bf16x8*)(QDt + KSWZ(32 * tblk + r32, (d0 * 16 + hi * 8) * 2));
        f32x16 p0, p1; qkt(p0, p1, KDt, qr, r32, hi);
        const int t = 32 * tblk + r32;
#pragma unroll
        for (int r = 0; r < 16; ++r) { p0[r] = (crow(r, hi) <= t) ? p0[r] : 0.f; p1[r] = (32 + crow(r, hi) <= t) ? p1[r] : 0.f; }
        bf16x8 pa0, pa1, pa2, pa3; PK4(p0, 0, pa0); PK4(p0, 8, pa1); PK4(p1, 0, pa2); PK4(p1, 8, pa3);
        f32x16 o[4];
#pragma unroll
        for (int d = 0; d < 4; ++d)
#pragma unroll
            for (int i = 0; i < 16; ++i) o[d][i] = 0.f;
        pv_d0(o, (unsigned)(uintptr_t)(vt ? Vt1 : Vt0) + v_rd_base(lane), pa0, pa1, pa2, pa3);
#pragma unroll
        for (int r = 0; r < 16; ++r) { const int tt = 32 * tblk + crow(r, hi);
            if (tt < nvalid) {
#pragma unroll
                for (int d0 = 0; d0 < 4; ++d0) GO[(size_t)(row0 + tt) * GVW + h * GDV + 128 * vt + 32 * d0 + r32] = o[d0][r]; } } }
    { const unsigned va = (unsigned)(uintptr_t)((wid >> 2) ? Vt1 : Vt0) + v_rd_base(lane) + 512 * (wid & 3), kb = (unsigned)(uintptr_t)KEt + v_rd_base(lane);
        f32x16 acc[4];
#pragma unroll
        for (int d = 0; d < 4; ++d)
#pragma unroll
            for (int i = 0; i < 16; ++i) acc[d][i] = 0.f;
#define G1_KS(KS) do { const bf16x8 af = tr_frag_rt<KS>(va); \
        { const bf16x8 b0 = tr_frag_rt<KS>(kb), b1 = tr_frag_rt<KS>(kb + 512), b2 = tr_frag_rt<KS>(kb + 1024), b3 = tr_frag_rt<KS>(kb + 1536); \
          acc[0] = MFMA32(af, b0, acc[0]); acc[1] = MFMA32(af, b1, acc[1]); acc[2] = MFMA32(af, b2, acc[2]); acc[3] = MFMA32(af, b3, acc[3]); } } while (0)
        G1_KS(0); G1_KS(1); G1_KS(2); G1_KS(3);
#undef G1_KS
#pragma unroll
        for (int r = 0; r < 16; ++r) { const int dv = 32 * wid + crow(r, hi);
#pragma unroll
            for (int c0 = 0; c0 < 4; ++c0) DST[((size_t)u * GDV + dv) * GDK + 32 * c0 + r32] = acc[c0][r]; } }
    __syncthreads();
}
DI void gla_g2(const float* DST, const float* DEC, bf16* SIN, const float* state_gla, float* gla_p, float* gla_s, int gtid, int nthreads) {
    for (int e = gtid; e < 8 * 16384; e += nthreads) {
        const int chain = e >> 14, pr = e & 16383, idx = pr * 2, b = chain >> 2, h = chain & 3, c = idx & 127, dv = idx >> 7;
        float s0 = 0.f, s1 = 0.f;
        for (int n = 0; n < 64; ++n) { const size_t u = (size_t)b * 256 + n * 4 + h;
            *(GAS unsigned*)(SIN + u * 32768 + idx) = pk2(s0, s1);
            const f32x2 d = *(const GAS f32x2*)(DST + u * 32768 + idx), dc = *(const GAS f32x2*)(DEC + u * GDK + c);
            s0 = fmaf(s0, dc.x, d.x); s1 = fmaf(s1, dc.y, d.y); }
        float* o = gla_p + ((size_t)chain * GDK + c) * GDV + dv; o[0] = s0; o[GDV] = s1;
    }
    for (int e = gtid; e < 32 * 16384; e += nthreads) {
        const int chain = e >> 14, pr = e & 16383, idx = pr * 2, c = idx & 127, dv = idx >> 7; const size_t u = 512 + chain;
        const float* si = state_gla + ((size_t)chain * GDK + c) * GDV + dv;
        float s0 = si[0], s1 = si[GDV];
        *(GAS unsigned*)(SIN + u * 32768 + idx) = pk2(s0, s1);
        const f32x2 d = *(const GAS f32x2*)(DST + u * 32768 + idx), dc = *(const GAS f32x2*)(DEC + u * GDK + c);
        s0 = fmaf(s0, dc.x, d.x); s1 = fmaf(s1, dc.y, d.y);
        float* o = gla_s + ((size_t)chain * GDK + c) * GDV + dv; o[0] = s0; o[GDV] = s1;
    }
}
DI void gla_g3(LAS char* lds, int u, const bf16* PROJ, const bf16* QDg, const bf16* SIN, float* GO, const float* norm_w, bf16* ATT, int tid) {
    int row0, h, nvalid; gla_decode(u, row0, h, nvalid);
    const int wid = __builtin_amdgcn_readfirstlane(tid >> 6), lane = tid & 63, r32 = lane & 31, hi = lane >> 5;
    const int tblk = wid & 1, dq = wid >> 1;
    LAS float* ob = (LAS float*)lds;
    { const int t = 32 * tblk + r32; const bf16x8 z = {0, 0, 0, 0, 0, 0, 0, 0};
        f32x16 acc[2];
#pragma unroll
        for (int d = 0; d < 2; ++d)
#pragma unroll
            for (int i = 0; i < 16; ++i) acc[d][i] = 0.f;
#pragma unroll
        for (int ks = 0; ks < 8; ++ks) {
            const bf16x8 af = (t < nvalid) ? *(const GAS bf16x8*)(QDg + (size_t)(row0 + t) * GKW + h * GDK + 16 * ks + 8 * hi) : z;
#pragma unroll
            for (int nb = 0; nb < 2; ++nb) { const int dv = 64 * dq + 32 * nb + r32;
                const bf16x8 bfr = *(const GAS bf16x8*)(SIN + ((size_t)u * GDV + dv) * GDK + 16 * ks + 8 * hi);
                acc[nb] = MFMA32(af, bfr, acc[nb]); } }
#pragma unroll
        for (int r = 0; r < 16; ++r) { const int tt = 32 * tblk + crow(r, hi);
#pragma unroll
            for (int nb = 0; nb < 2; ++nb) { const int dv = 64 * dq + 32 * nb + r32;
                const float g = (tt < nvalid) ? GO[(size_t)(row0 + tt) * GVW + h * GDV + dv] : 0.f;
                ob[tt * 260 + dv] = acc[nb][r] + g;
#if MK_CHECK
                if (tt < nvalid) GO[(size_t)(row0 + tt) * GVW + h * GDV + dv] = acc[nb][r] + g;
#endif
            } } }
    __syncthreads();
    for (int i = 0; i < 8; ++i) { const int t = 8 * wid + i;
        if (t < nvalid) {
            const f32x4 v = *(const LAS f32x4*)(ob + t * 260 + 4 * lane);
            const float ss = wave_sum((v.x * v.x + v.y * v.y) + (v.z * v.z + v.w * v.w));
            const float rms = 1.f / sqrtf(ss * (1.f / GDV) + GLA_EPS);
            const f32x4 nw = *(const GAS f32x4*)(norm_w + 4 * lane);
            const u32x2 gw = *(const GAS u32x2*)(PROJ + (size_t)(row0 + t) * NIN + 5120 + h * GDV + 4 * lane);
            const float o0 = v.x * rms * nw.x * siluf_(bflo(gw.x)), o1 = v.y * rms * nw.y * siluf_(bfhi(gw.x)), o2 = v.z * rms * nw.z * siluf_(bflo(gw.y)), o3 = v.w * rms * nw.w * siluf_(bfhi(gw.y));
            u32x2 w; w.x = pk2(o0, o1); w.y = pk2(o2, o3);
            *(GAS u32x2*)(ATT + (size_t)(row0 + t) * D + SBW + h * GDV + 4 * lane) = w; } }
    __syncthreads();
}
constexpr int RCH = 16;
struct RwC { const float* PREP; const float* state_in; float* Y; float* rw_p; float* rw_s; };
DI void rwkv_prep(const bf16* PROJ, const float* L2, const float* w0, const float* a0, const float* k_k, const float* k_a, const float* r_k, float* PREP, float* BON, int gw, int NGW, int lane) {
    const int hg = gw & 7, hc = hg * 256 + lane * 4, h = hg * 4 + (lane >> 4), c4 = (lane & 15) * 4;
    const f32x4 cw0 = *(const GAS f32x4*)(w0 + hc), ca0 = *(const GAS f32x4*)(a0 + hc), ckk = *(const GAS f32x4*)(k_k + hc), cka = *(const GAS f32x4*)(k_a + hc), crk = *(const GAS f32x4*)(r_k + hc);
    constexpr int NB = 4;
    for (size_t row0 = (size_t)(gw >> 3); row0 < (size_t)MR; row0 += (size_t)NB * (NGW >> 3)) {
        u32x2 rwq[NB], kwq[NB], vwq[NB]; f32x4 wpq[NB], apq[NB]; bool ok[NB];
#pragma unroll
        for (int i = 0; i < NB; ++i) { const size_t row = row0 + (size_t)i * (NGW >> 3); ok[i] = row < (size_t)MR; const size_t rr = ok[i] ? row : row0;
            rwq[i] = *(const GAS u32x2*)(PROJ + rr * NIN + hc); kwq[i] = *(const GAS u32x2*)(PROJ + rr * NIN + 2048 + hc); vwq[i] = *(const GAS u32x2*)(PROJ + rr * NIN + 4096 + hc);
            wpq[i] = *(const GAS f32x4*)(L2 + rr * 6144 + hc); apq[i] = *(const GAS f32x4*)(L2 + rr * 6144 + 2048 + hc); }
#pragma unroll
        for (int i = 0; i < NB; ++i) { if (!ok[i]) break; const size_t row = row0 + (size_t)i * (NGW >> 3);
            const u32x2 rw_ = rwq[i], kw_ = kwq[i], vw_ = vwq[i]; const f32x4 wp = wpq[i], ap = apq[i];
            const f32x4 r = {bflo(rw_.x), bfhi(rw_.x), bflo(rw_.y), bfhi(rw_.y)}, k = {bflo(kw_.x), bfhi(kw_.x), bflo(kw_.y), bfhi(kw_.y)}, v = {bflo(vw_.x), bfhi(vw_.x), bflo(vw_.y), bfhi(vw_.y)};
            f32x4 dec, a, kk, k2;
#pragma unroll
            for (int j = 0; j < 4; ++j) { const float wlog = -softplusf_(-(wp[j] + cw0[j])) - 0.5f; dec[j] = ex2(-ex2(wlog * LOG2E) * LOG2E); a[j] = sigmoidf_(ap[j] + ca0[j]); kk[j] = k[j] * ckk[j]; k2[j] = k[j] * (1.f + (a[j] - 1.f) * cka[j]); }
            const float n2 = dpp_sum16((kk.x * kk.x + kk.y * kk.y) + (kk.z * kk.z + kk.w * kk.w)); const float rn = 1.f / sqrtf(fmaxf(n2, 1e-24f)); kk = kk * rn;
            const float bs = dpp_sum16((r.x * k2.x * crk.x + r.y * k2.y * crk.y) + (r.z * k2.z * crk.z + r.w * k2.w * crk.w));
            float* o = PREP + (row * RWH + h) * 384 + c4;
            *(GAS f32x4*)o = dec; *(GAS f32x4*)(o + 64) = kk; *(GAS f32x4*)(o + 128) = kk * a; *(GAS f32x4*)(o + 192) = k2; *(GAS f32x4*)(o + 256) = r; *(GAS f32x4*)(o + 320) = v;
            *(GAS f32x4*)(BON + row * D + hc) = v * bs; } }
}
DI void rwkv_unit(LAS char* lds, int u, const RwC& R, int tid) {
    const int wid = __builtin_amdgcn_readfirstlane(tid >> 6), lane = tid & 63;
    int row0, T, h, qt; const float* s_in = nullptr; float* s_out;
    if (u < 256) { const int hd = (u & 7) + 8 * (u >> 5), b = hd >> 5; h = hd & 31; qt = (u >> 3) & 3; row0 = b * TP; T = TP; s_out = R.rw_p + (size_t)(b * RWH + h) * 4096; }
    else { const int su = u - 256, db = su >> 7; h = (su >> 2) & 31; qt = su & 3; row0 = MPR + db * TS; T = TS; s_in = R.state_in + (size_t)(db * RWH + h) * 4096; s_out = R.rw_s + (size_t)(db * RWH + h) * 4096; }
    LAS float* inb = (LAS float*)lds;
    LAS float* ybuf = (LAS float*)(lds + 2 * RCH * 6 * 64 * 4);
    const int nch = (T + RCH - 1) / RCH;
    const int vrow = 16 * qt + 4 * wid + (lane >> 4), j4 = (lane & 15) * 4;
    f32x2 Sa = {0.f, 0.f}, Sb = {0.f, 0.f};
    if (wid < 4 && s_in) { const f32x4 S0 = *(const GAS f32x4*)(s_in + (size_t)vrow * 64 + j4); Sa = (f32x2){S0.x, S0.y}; Sb = (f32x2){S0.z, S0.w}; }
    f32x4 sg0[6], sg1[6], sg2[6];
    const int sl = (wid - 4) * 64 + lane;
#define RW_LOAD(ci, SG) do { const int t0_ = (ci) * RCH; \
        _Pragma("unroll") for (int i_ = 0; i_ < 6; ++i_) { const int pc = sl + 256 * i_, tk = pc / 96, wi = pc - tk * 96; SG[i_] = (f32x4){0.f, 0.f, 0.f, 0.f}; \
            if (t0_ + tk < T) SG[i_] = *(const GAS f32x4*)(R.PREP + ((size_t)(row0 + t0_ + tk) * RWH + h) * 384 + wi * 4); } } while (0)
#define RW_PROC(ci, SG) do { LAS float* ib_ = inb + ((ci) & 1) * (RCH * 6 * 64); \
        _Pragma("unroll") for (int i_ = 0; i_ < 6; ++i_) { const int pc = sl + 256 * i_; *(LAS f32x4*)(ib_ + pc * 4) = SG[i_]; } } while (0)
#define RW_YOUT(ci) do { const int t0_ = (ci) * RCH; const int nst_ = (T - t0_) < RCH ? (T - t0_) : RCH; const LAS float* yb_ = ybuf + ((ci) & 1) * (RCH * 256); \
        for (int idx = (wid - 4) * 64 + lane; idx < nst_ * 16; idx += 256) { const int tt = idx >> 4, rl = idx & 15; const LAS f32x4* p_ = (const LAS f32x4*)(yb_ + idx * 16); \
            const f32x4 a_ = p_[0], b_ = p_[1], c_ = p_[2], d_ = p_[3]; \
            R.Y[(size_t)(row0 + t0_ + tt) * D + h * 64 + 16 * qt + rl] = ((a_.x + a_.y) + (a_.z + a_.w)) + ((b_.x + b_.y) + (b_.z + b_.w)) + ((c_.x + c_.y) + (c_.z + c_.w)) + ((d_.x + d_.y) + (d_.z + d_.w)); } } while (0)
#define RW_LD(X, tt) do { const LAS float* p_ = ib + (tt) * 384; X##w = *(const LAS f32x4*)(p_ + j4); X##k = *(const LAS f32x4*)(p_ + 64 + j4); X##b = *(const LAS f32x4*)(p_ + 128 + j4); \
                X##q = *(const LAS f32x4*)(p_ + 192 + j4); X##r = *(const LAS f32x4*)(p_ + 256 + j4); X##v = p_[320 + vrow]; } while (0)
#define RW_STEP(X, tt) do { f32x2 d_ = Sa * (f32x2){X##k.x, X##k.y}; d_ = Sb * (f32x2){X##k.z, X##k.w} + d_; \
                const float sa = -dpp_sum16(d_.x + d_.y); \
                const f32x2 ta_ = (f32x2){X##b.x, X##b.y} * sa + (f32x2){X##q.x, X##q.y} * X##v, tb_ = (f32x2){X##b.z, X##b.w} * sa + (f32x2){X##q.z, X##q.w} * X##v; \
                Sa = Sa * (f32x2){X##w.x, X##w.y} + ta_; Sb = Sb * (f32x2){X##w.z, X##w.w} + tb_; \
                f32x2 y_ = Sa * (f32x2){X##r.x, X##r.y}; y_ = Sb * (f32x2){X##r.z, X##r.w} + y_; \
                yb[(tt) * 256 + wid * 64 + lane] = y_.x + y_.y; } while (0)
#define RW_SCAN(ci_) do { const int t0 = (ci_) * RCH; const int nst = (T - t0) < RCH ? (T - t0) : RCH; const LAS float* ib = inb + ((ci_) & 1) * (RCH * 6 * 64); LAS float* yb = ybuf + ((ci_) & 1) * (RCH * 256); \
        f32x4 Aw, Ak, Ab, Aq, Ar, Bw, Bk, Bb, Bq, Br, Cw, Ck, Cb, Cq, Cr; float Av, Bv, Cv; \
        if (nst == RCH) { RW_LD(A, 0); RW_LD(B, 1);        \
            _Pragma("unroll") for (int tt = 0; tt < RCH; tt += 3) { if (tt + 2 < RCH) RW_LD(C, tt + 2); RW_STEP(A, tt); if (tt + 3 < RCH) RW_LD(A, tt + 3); if (tt + 1 < RCH) RW_STEP(B, tt + 1); \
                if (tt + 4 < RCH) RW_LD(B, tt + 4); if (tt + 2 < RCH) RW_STEP(C, tt + 2); } } \
        else { for (int tt = 0; tt < nst; ++tt) { RW_LD(A, tt); RW_STEP(A, tt); } } } while (0)
    if (wid >= 4) { RW_LOAD(0, sg0); RW_PROC(0, sg0); if (nch > 1) RW_LOAD(1, sg1); if (nch > 2) RW_LOAD(2, sg2); if (nch > 3) RW_LOAD(3, sg0); }
    __syncthreads();
#define RW_ITER(ci, SG) do { if (wid >= 4) { if ((ci) + 1 < nch) RW_PROC((ci) + 1, SG); if ((ci) + 4 < nch) RW_LOAD((ci) + 4, SG); if ((ci) > 0) RW_YOUT((ci) - 1); } else { RW_SCAN(ci); } \
        asm volatile("s_waitcnt lgkmcnt(0)" ::: "memory"); __builtin_amdgcn_s_barrier(); asm volatile("" ::: "memory"); } while (0)
    for (int c3 = 0; c3 < nch; c3 += 3) {
        RW_ITER(c3, sg1);
        if (c3 + 1 < nch) RW_ITER(c3 + 1, sg2);
        if (c3 + 2 < nch) RW_ITER(c3 + 2, sg0);
    }
    if (wid >= 4) RW_YOUT(nch - 1);
    else *(GAS f32x4*)(s_out + (size_t)vrow * 64 + j4) = (f32x4){Sa.x, Sa.y, Sb.x, Sb.y};
    __syncthreads();
#undef RW_LOAD
#undef RW_ITER
#undef RW_SCAN
#undef RW_PROC
#undef RW_STEP
#undef RW_LD
#undef RW_YOUT
}
DI void rwkv_post(const float* Y, const float* BON, const float* G  , const float* ln_w, const float* ln_b, bf16* ATT, int gw, int NGW, int lane) {
    const int hc = (gw & 7) * 256 + lane * 4;
    const f32x4 lw = *(const GAS f32x4*)(ln_w + hc), lb = *(const GAS f32x4*)(ln_b + hc);
    for (size_t row0 = (size_t)(gw >> 3); row0 < (size_t)MR; row0 += (size_t)(NGW >> 1)) {
        f32x4 ya[4], ba[4], ga[4]; bool ok[4];
#pragma unroll
        for (int i = 0; i < 4; ++i) { const size_t row = row0 + (size_t)i * (NGW >> 3); ok[i] = row < (size_t)MR; const size_t rr = ok[i] ? row : row0;
            ya[i] = *(const GAS f32x4*)(Y + rr * D + hc); ba[i] = *(const GAS f32x4*)(BON + rr * D + hc); ga[i] = *(const GAS f32x4*)(G + rr * 6144 + hc); }
#pragma unroll
        for (int i = 0; i < 4; ++i) { if (!ok[i]) break; const size_t row = row0 + (size_t)i * (NGW >> 3); const f32x4 y = ya[i];
            const float mu = dpp_sum16((y.x + y.y) + (y.z + y.w)) * (1.f / 64.f); const f32x4 d = y - mu;
            const float var = dpp_sum16((d.x * d.x + d.y * d.y) + (d.z * d.z + d.w * d.w)) * (1.f / 64.f); const float rs = 1.f / sqrtf(var + RW_LN_EPS);
            const f32x4 out = (d * rs * lw + lb + ba[i]) * ga[i];
            u32x2 w; w.x = pk2(out.x, out.y); w.y = pk2(out.z, out.w); *(GAS u32x2*)(ATT + row * D + hc) = w; } }
}
DI void rwkv_mix(const bf16* XB, const float* mix, const float* shift_in, bf16* MIX, float* sh_p, float* sh_s, int gtid, int nthreads) {
    constexpr int RUN = 16, NRUN = MPR / RUN + DB;
    for (int it = gtid; it < NRUN * (D / 8); it += nthreads) { const int run = it >> 8, c = (it & 255) * 8;
        int row0, nrow, sq; if (run < MPR / RUN) { row0 = run * RUN; nrow = RUN; sq = -1; } else { sq = run - MPR / RUN; row0 = MPR + sq * TS; nrow = TS; }
        const int t0 = row0 < MPR ? (row0 & (TP - 1)) : 0;
        f32x4 mw[6][2];
#pragma unroll
        for (int m = 0; m < 6; ++m) { mw[m][0] = *(const GAS f32x4*)(mix + (size_t)m * D + c); mw[m][1] = *(const GAS f32x4*)(mix + (size_t)m * D + c + 4); }
        f32x4 p0 = {0.f, 0.f, 0.f, 0.f}, p1 = {0.f, 0.f, 0.f, 0.f};
        if (t0 > 0) { const u32x4 w = *(const GAS u32x4*)(XB + (size_t)(row0 - 1) * D + c); p0 = (f32x4){bflo(w.x), bfhi(w.x), bflo(w.y), bfhi(w.y)}; p1 = (f32x4){bflo(w.z), bfhi(w.z), bflo(w.w), bfhi(w.w)}; }
        else if (sq >= 0) { p0 = *(const GAS f32x4*)(shift_in + (size_t)sq * D + c); p1 = *(const GAS f32x4*)(shift_in + (size_t)sq * D + c + 4); }
        for (int i0 = 0; i0 < nrow; i0 += 8) {
            u32x4 xq[8];
#pragma unroll
            for (int i = 0; i < 8; ++i) xq[i] = *(const GAS u32x4*)(XB + (size_t)(row0 + i0 + i) * D + c);
#pragma unroll
            for (int i = 0; i < 8; ++i) { const int row = row0 + i0 + i; const u32x4 xw = xq[i];
                const f32x4 x0 = {bflo(xw.x), bfhi(xw.x), bflo(xw.y), bfhi(xw.y)}, x1 = {bflo(xw.z), bfhi(xw.z), bflo(xw.w), bfhi(xw.w)};
                const f32x4 d0 = p0 - x0, d1 = p1 - x1;
#pragma unroll
                for (int m = 0; m < 6; ++m) { const f32x4 a = x0 + d0 * mw[m][0], b = x1 + d1 * mw[m][1]; u32x4 w = {pk2(a.x, a.y), pk2(a.z, a.w), pk2(b.x, b.y), pk2(b.z, b.w)};
                    *(GAS u32x4*)(MIX + ((size_t)m * M + row) * D + c) = w; }
                p0 = x0; p1 = x1; } }
        const int last = row0 + nrow - 1;
        if (sq >= 0) { float* o = sh_s + (size_t)sq * D + c; *(GAS f32x4*)o = p0; *(GAS f32x4*)(o + 4) = p1; }
        else if ((last & (TP - 1)) == TP - 1) { float* o = sh_p + (size_t)(last >> 12) * D + c; *(GAS f32x4*)o = p0; *(GAS f32x4*)(o + 4) = p1; }
    }
}
DI void conv_rowload(const bf16* p, float (&x)[8]) { const u32x4 w = *(const GAS u32x4*)p; x[0] = bflo(w.x); x[1] = bfhi(w.x); x[2] = bflo(w.y); x[3] = bfhi(w.y); x[4] = bflo(w.z); x[5] = bfhi(w.z); x[6] = bflo(w.w); x[7] = bfhi(w.w); }
DI void conv_gate(const bf16* U, const float* cw, const float* cb, const float* conv0_s  , bf16* ACT, int gtid, int nthreads) {
    constexpr int RUN = 32, NRUN = MPR / RUN + DB, NCH = FF / 8;
    for (int it = gtid; it < NRUN * NCH; it += nthreads) { const int run = it / NCH, c = (it - run * NCH) * 8;
        int row0, nrow, sq; if (run < MPR / RUN) { row0 = run * RUN; nrow = RUN; sq = -1; } else { sq = run - MPR / RUN; row0 = MPR + sq * TS; nrow = TS; }
        const int t0 = row0 < MPR ? (row0 & (TP - 1)) : 0;
        float w[2][3][8], bsv[2][8], h1[2][8], h2[2][8];
#pragma unroll
        for (int hf = 0; hf < 2; ++hf) { const int cc = c + hf * FF;
#pragma unroll
            for (int tap = 0; tap < 3; ++tap) { const f32x4 a = *(const GAS f32x4*)(cw + (size_t)tap * F2 + cc), b = *(const GAS f32x4*)(cw + (size_t)tap * F2 + cc + 4);
                w[hf][tap][0] = a.x; w[hf][tap][1] = a.y; w[hf][tap][2] = a.z; w[hf][tap][3] = a.w; w[hf][tap][4] = b.x; w[hf][tap][5] = b.y; w[hf][tap][6] = b.z; w[hf][tap][7] = b.w; }
            { const f32x4 a = *(const GAS f32x4*)(cb + cc), b = *(const GAS f32x4*)(cb + cc + 4); bsv[hf][0] = a.x; bsv[hf][1] = a.y; bsv[hf][2] = a.z; bsv[hf][3] = a.w; bsv[hf][4] = b.x; bsv[hf][5] = b.y; bsv[hf][6] = b.z; bsv[hf][7] = b.w; }
            if (t0 > 0) { conv_rowload(U + (size_t)(row0 - 1) * F2 + cc, h1[hf]); conv_rowload(U + (size_t)(row0 - 2) * F2 + cc, h2[hf]); }
            else if (sq >= 0) { const float* s = conv0_s + (size_t)sq * 2 * F2 + cc;
#pragma unroll
                for (int i = 0; i < 8; ++i) { h2[hf][i] = s[i]; h1[hf][i] = s[F2 + i]; } }
            else {
#pragma unroll
                for (int i = 0; i < 8; ++i) { h1[hf][i] = 0.f; h2[hf][i] = 0.f; } } }
        for (int i0 = 0; i0 < nrow; i0 += 8) {
            u32x4 xv[8], xg[8];
#pragma unroll
            for (int i = 0; i < 8; ++i) { xv[i] = *(const GAS u32x4*)(U + (size_t)(row0 + i0 + i) * F2 + c); xg[i] = *(const GAS u32x4*)(U + (size_t)(row0 + i0 + i) * F2 + c + FF); }
#pragma unroll
            for (int i = 0; i < 8; ++i) { const int row = row0 + i0 + i; float x[2][8], o[8];
                { const u32x4 w_ = xv[i]; x[0][0] = bflo(w_.x); x[0][1] = bfhi(w_.x); x[0][2] = bflo(w_.y); x[0][3] = bfhi(w_.y); x[0][4] = bflo(w_.z); x[0][5] = bfhi(w_.z); x[0][6] = bflo(w_.w); x[0][7] = bfhi(w_.w); }
                { const u32x4 w_ = xg[i]; x[1][0] = bflo(w_.x); x[1][1] = bfhi(w_.x); x[1][2] = bflo(w_.y); x[1][3] = bfhi(w_.y); x[1][4] = bflo(w_.z); x[1][5] = bfhi(w_.z); x[1][6] = bflo(w_.w); x[1][7] = bfhi(w_.w); }
#pragma unroll
                for (int j = 0; j < 8; ++j) { const float val = bsv[0][j] + w[0][0][j] * h2[0][j] + w[0][1][j] * h1[0][j] + w[0][2][j] * x[0][j];
                    const float gat = bsv[1][j] + w[1][0][j] * h2[1][j] + w[1][1][j] * h1[1][j] + w[1][2][j] * x[1][j];
                    o[j] = siluf_(gat) * val; h2[0][j] = h1[0][j]; h1[0][j] = x[0][j]; h2[1][j] = h1[1][j]; h1[1][j] = x[1][j]; }
                u32x4 wv = {pk2(o[0], o[1]), pk2(o[2], o[3]), pk2(o[4], o[5]), pk2(o[6], o[7])};
                *(GAS u32x4*)(ACT + (size_t)row * FF + c) = wv; } }
    }
}
#ifndef MK_CHECK
#define MK_CHECK 0
#endif
#if MK_CHECK
DI void chk(unsigned* errs, int id, float got, float ref, float tol) {
    float e = fabsf(got - ref) / tol; if (!(e < 1e30f)) e = 1e30f;
    atomicMax(errs + id, __float_as_uint(e));
}
DI unsigned hsh(unsigned x) { x ^= x >> 16; x *= 0x7feb352dU; x ^= x >> 15; x *= 0x846ca68bU; x ^= x >> 16; return x; }
DI float naive_dot(const bf16* a, const bf16* b, int K) { float s = 0.f; for (int k = 0; k < K; ++k) s += bf2f(a[k]) * bf2f(b[k]); return s; }
DI float bfr(float x) { return bflo(pk2(x, 0.f) & 0xffffu); }
#endif
constexpr int NWAVES = 8, NTHREADS = 512;
constexpr size_t WS_WLOW = WS_END;
constexpr size_t WS_DBG = WS_WLOW + al((size_t)32 * D * 2);
constexpr size_t WS_PREP = WS_DBG + 4 * MiB;
constexpr size_t WS_TOTAL = WS_PREP + al((size_t)M * RWH * 384 * 4);
constexpr int NPH = 31;
struct Args { const float* in[43]; float* out; unsigned char* ws; int ph_lo, ph_hi, fused, pad; };
struct TrRow { int in_idx; long in_off; long ws_off; int ldw, Kr, Nr, ldt, npad; };
__device__ const TrRow TR_TABLE[NTR] = {
    {12, 0, (long)WS_WIN, NIN_FULL, D, NIN, D, NIN},
    {12, NIN, (long)WS_WLOW, NIN_FULL, D, 16, D, 32},
    {17, 0, (long)WS_WOUT, D, D, D, D, D},
    {19, 0, (long)WS_WRKV, D, D, D, D, D}, {19, (long)D * D, (long)(WS_WRKV + (size_t)D * D * 2), D, D, D, D, D}, {19, 2L * D * D, (long)(WS_WRKV + (size_t)2 * D * D * 2), D, D, D, D, D},
    {21, 0, (long)(WS_WRKV + (size_t)6144 * D * 2), 96, D, 96, D, 256}, {24, 0, (long)(WS_WRKV + (size_t)6400 * D * 2), 96, D, 96, D, 256}, {26, 0, (long)(WS_WRKV + (size_t)6656 * D * 2), 256, D, 256, D, 256},
    {22, 0, (long)WS_WL2, D, 96, D, 256, D}, {25, 0, (long)(WS_WL2 + (size_t)2048 * 256 * 2), D, 96, D, 256, D}, {27, 0, (long)(WS_WL2 + (size_t)4096 * 256 * 2), D, 256, D, 256, D},
    {33, 0, (long)WS_WO, D, D, D, D, D},
    {34, 0, (long)WS_WQ, MW, D, MW, D, MW}, {34, (long)D * MW, (long)(WS_WQ + (size_t)MW * D * 2), MW, D, MW, D, MW},
    {35, 0, (long)WS_WKV, 1024, D, 1024, D, 1024}, {35, (long)D * 1024, (long)(WS_WKV + (size_t)1024 * D * 2), 1024, D, 1024, D, 1024},
    {36, 0, (long)WS_WCO, D, MW, D, MW, D}, {36, (long)MW * D, (long)(WS_WCO + (size_t)D * MW * 2), D, MW, D, MW, D},
    {37, 0, (long)WS_WUP, F2, D, F2, D, F2}, {37, (long)D * F2, (long)(WS_WUP + (size_t)F2 * D * 2), F2, D, F2, D, F2},
    {40, 0, (long)WS_WDN, D, FF, D, FF, D}, {40, (long)FF * D, (long)(WS_WDN + (size_t)D * FF * 2), D, FF, D, FF, D},
};
DI int tr_items(int d) { return (TR_TABLE[d].ldt / 64) * (TR_TABLE[d].npad / 32); }
DI TrDesc make_desc(unsigned char* ws, int d) { const TrRow r = TR_TABLE[d]; TrDesc t; t.W = inp(r.in_idx) + r.in_off; t.WT = (bf16*)(ws + r.ws_off); t.ldw = r.ldw; t.Kr = r.Kr; t.Nr = r.Nr; t.ldt = r.ldt; t.nblk = r.npad / 32; t.start = 0; return t; }

struct FInProj { bf16* PROJ; float* out;
    DI void operator()(int row, int col, f32x4 v0, f32x4 v1, int pn) const {
        u32x4 w = {pk2(v0.x, v0.y), pk2(v0.z, v0.w), pk2(v1.x, v1.y), pk2(v1.z, v1.w)};
        *(GAS u32x4*)(PROJ + (size_t)row * NIN + col) = w;
        if (pn >= 4 && pn < 12 && row < MR) { const int kv = col >= 2048; const int cc = col - 1024 - kv * 1024;
            float* o = row < MPR ? out + (kv ? O_SBVP : O_SBKP) + (size_t)row * SBW + cc : out + (kv ? O_SBVS : O_SBKS) + (size_t)(row - MPR) * SBW + cc;
            *(GAS f32x4*)o = v0; *(GAS f32x4*)(o + 4) = v1; } }
    DI void sk(int row, int col, f32x4 v, int pn) const {
        u32x2 w = {pk2(v.x, v.y), pk2(v.z, v.w)}; *(GAS u32x2*)(PROJ + (size_t)row * NIN + col) = w;
        if (pn >= 4 && pn < 12) { const int kv = col >= 2048; const int cc = col - 1024 - kv * 1024; *(GAS f32x4*)(out + (kv ? O_SBVS : O_SBKS) + (size_t)(row - MPR) * SBW + cc) = v; } } };
struct FResid { const bf16* XB; bf16* HB;
    DI void operator()(int row, int col, f32x4 v0, f32x4 v1, int) const { const u32x4 x = *(const GAS u32x4*)(XB + (size_t)row * D + col);
        u32x4 w = {pk2(bflo(x.x) * ALPHA + v0.x, bfhi(x.x) * ALPHA + v0.y), pk2(bflo(x.y) * ALPHA + v0.z, bfhi(x.y) * ALPHA + v0.w), pk2(bflo(x.z) * ALPHA + v1.x, bfhi(x.z) * ALPHA + v1.y), pk2(bflo(x.w) * ALPHA + v1.z, bfhi(x.w) * ALPHA + v1.w)};
        *(GAS u32x4*)(HB + (size_t)row * D + col) = w; }
    DI void sk(int row, int col, f32x4 v, int) const { const u32x2 x = *(const GAS u32x2*)(XB + (size_t)row * D + col);
        u32x2 w = {pk2(bflo(x.x) * ALPHA + v.x, bfhi(x.x) * ALPHA + v.y), pk2(bflo(x.y) * ALPHA + v.z, bfhi(x.y) * ALPHA + v.w)}; *(GAS u32x2*)(HB + (size_t)row * D + col) = w; } };
struct FBf16 { bf16* O; int ld;
    DI void operator()(int row, int col, f32x4 v0, f32x4 v1, int) const { u32x4 w = {pk2(v0.x, v0.y), pk2(v0.z, v0.w), pk2(v1.x, v1.y), pk2(v1.z, v1.w)}; *(GAS u32x4*)(O + (size_t)row * ld + col) = w; }
    DI void sk(int row, int col, f32x4 v, int) const { u32x2 w = {pk2(v.x, v.y), pk2(v.z, v.w)}; *(GAS u32x2*)(O + (size_t)row * ld + col) = w; } };
struct FMemKV { bf16* MEMKV; float* out;
    DI void operator()(int row, int col, f32x4 v0, f32x4 v1, int) const { u32x4 w = {pk2(v0.x, v0.y), pk2(v0.z, v0.w), pk2(v1.x, v1.y), pk2(v1.z, v1.w)}; *(GAS u32x4*)(MEMKV + (size_t)row * D + col) = w;
        const int layer = col >> 10, kv = (col >> 9) & 1, cc = col & 511; float* o = out + (kv ? O_MVP : O_MKP) + ((size_t)layer * 512 + row) * MW + cc; *(GAS f32x4*)o = v0; *(GAS f32x4*)(o + 4) = v1; } };
struct FUp { bf16* U; float* out; int layer;
    DI void operator()(int row, int col, f32x4 v0, f32x4 v1, int) const { u32x4 w = {pk2(v0.x, v0.y), pk2(v0.z, v0.w), pk2(v1.x, v1.y), pk2(v1.z, v1.w)}; *(GAS u32x4*)(U + (size_t)row * F2 + col) = w;
        float* o = nullptr;
        if (row < MPR) { const int t = row & (TP - 1); if (t >= TP - 2) o = out + O_CONVP + ((size_t)(layer * BP + (row >> 12)) * 2 + (t - (TP - 2))) * F2 + col; }
        else if (row < MR) { const int t = (row - MPR) & 7; if (t >= TS - 2) o = out + O_CONVS + ((size_t)(layer * DB + ((row - MPR) >> 3)) * 2 + (t - (TS - 2))) * F2 + col; }
        if (o) { *(GAS f32x4*)o = v0; *(GAS f32x4*)(o + 4) = v1; } }
    DI void sk(int row, int col, f32x4 v, int) const { u32x2 w = {pk2(v.x, v.y), pk2(v.z, v.w)}; *(GAS u32x2*)(U + (size_t)row * F2 + col) = w;
        const int t = (row - MPR) & 7; if (t >= TS - 2) *(GAS f32x4*)(out + O_CONVS + ((size_t)(layer * DB + ((row - MPR) >> 3)) * 2 + (t - (TS - 2))) * F2 + col) = v; } };
struct FRkv { bf16* PROJ; bf16* L1;
    DI void operator()(int row, int col, f32x4 v0, f32x4 v1, int pn) const {
        if (pn < 24) { u32x4 w = {pk2(v0.x, v0.y), pk2(v0.z, v0.w), pk2(v1.x, v1.y), pk2(v1.z, v1.w)}; *(GAS u32x4*)(PROJ + (size_t)row * NIN + col) = w; }
        else { float x[8] = {v0.x, v0.y, v0.z, v0.w, v1.x, v1.y, v1.z, v1.w};
#pragma unroll
            for (int i = 0; i < 8; ++i) x[i] = pn == 24 ? tanhf_(x[i]) : (pn == 26 ? sigmoidf_(x[i]) : x[i]);
            u32x4 w = {pk2(x[0], x[1]), pk2(x[2], x[3]), pk2(x[4], x[5]), pk2(x[6], x[7])}; *(GAS u32x4*)(L1 + (size_t)row * 768 + (col - NIN)) = w; } }
    DI void sk(int row, int col, f32x4 v, int pn) const {
        if (pn < 24) { u32x2 w = {pk2(v.x, v.y), pk2(v.z, v.w)}; *(GAS u32x2*)(PROJ + (size_t)row * NIN + col) = w; }
        else { float x[4] = {v.x, v.y, v.z, v.w};
#pragma unroll
            for (int i = 0; i < 4; ++i) x[i] = pn == 24 ? tanhf_(x[i]) : (pn == 26 ? sigmoidf_(x[i]) : x[i]);
            u32x2 w = {pk2(x[0], x[1]), pk2(x[2], x[3])}; *(GAS u32x2*)(L1 + (size_t)row * 768 + (col - NIN)) = w; } } };
struct FL2 { float* L2;
    DI void operator()(int row, int col, f32x4 v, int) const { *(GAS f32x4*)(L2 + (size_t)row * 6144 + col) = v; }
    DI void sk(int row, int col, f32x4 v, int pn) const { (*this)(row, col, v, pn); } };
struct RkvOrder : pg8::StaticOrder { DI size_t a_off(int pn) const { const int idx = pn < 8 ? 0 : pn < 16 ? 2 : pn < 24 ? 3 : pn == 24 ? 1 : pn == 25 ? 4 : 5; return (size_t)idx * M * D * 2; } };
struct L2Order : pg8::StaticOrder { DI size_t a_off(int pn) const { return (size_t)(pn >> 3) * 256 * 2; } };

DI void low_task(const bf16* XB, const bf16* Wlow_t, float* LOW, int task, int lane) {
    const int fr = lane & 15, fq = lane >> 4; const size_t row = (size_t)task * 16 + fr;
    f32x4 acc = {0.f, 0.f, 0.f, 0.f};
#pragma unroll 8
    for (int ks = 0; ks < 64; ++ks) { const bf16x8 a = *(const GAS bf16x8*)(XB + row * D + 32 * ks + 8 * fq), b = *(const GAS bf16x8*)(Wlow_t + (size_t)fr * D + 32 * ks + 8 * fq);
        acc = __builtin_amdgcn_mfma_f32_16x16x32_bf16(b, a, acc, 0, 0, 0); }
    *(GAS f32x4*)(LOW + row * 16 + 4 * fq) = acc;
}

template <class F, class Sched> DI void skinny_gemm(LAS char* lds, const bf16* A, int lda, const bf16* Bt, int N, int K, const Sched& S, const F& f, int G, int bx, int tid) {
    const int wid = __builtin_amdgcn_readfirstlane(tid >> 6), lane = tid & 63, fr = lane & 15, fq = lane >> 4;
    LAS f32x4* red = (LAS f32x4*)lds;
    const int nstrips = N / 16, nks = K / 32;
    for (int s = G - 1 - bx; s < nstrips; s += G) {
        const int n0 = s * 16, pn = n0 >> 8;
        const bf16* Ab = (const bf16*)((const char*)A + S.a_off(pn)) + (size_t)(MPR + fr) * lda + 8 * fq;
        const bf16* Bb = Bt + (size_t)(n0 + fr) * K + 8 * fq;
        f32x4 acc[4];
#pragma unroll
        for (int mb = 0; mb < 4; ++mb) acc[mb] = (f32x4){0.f, 0.f, 0.f, 0.f};
#pragma unroll 8
        for (int ks = wid; ks < nks; ks += 8) {
            const bf16x8 b = *(const GAS bf16x8*)(Bb + 32 * ks);
#pragma unroll
            for (int mb = 0; mb < 4; ++mb) { const bf16x8 a = *(const GAS bf16x8*)(Ab + (size_t)(16 * mb) * lda + 32 * ks); acc[mb] = __builtin_amdgcn_mfma_f32_16x16x32_bf16(b, a, acc[mb], 0, 0, 0); } }
#pragma unroll
        for (int mb = 0; mb < 4; ++mb) red[(wid * 4 + mb) * 64 + lane] = acc[mb];
        __syncthreads();
        if (wid < 4) { f32x4 v = red[wid * 64 + lane];
#pragma unroll
            for (int w = 1; w < 8; ++w) v += red[(w * 4 + wid) * 64 + lane];
            f.sk(MPR + 16 * wid + fr, n0 + 4 * fq, v, pn); }
        __syncthreads();
    }
}
#if MK_CHECK
struct Ck { unsigned* errs; int gtid, NT, tid, bx, G; LAS char* lds; };
DI void ck_p0(const Ck& k, const Args& a, const bf16* XB, const bf16* MEMB, const bf16* CMK, const bf16* CMV) {
    for (int i = k.gtid; i < NTR * 64; i += k.NT) { const TrDesc d = make_desc(a.ws, i / 64);
        const int n = hsh(i) % (d.nblk * 32), kk = hsh(i + 7777) % d.ldt;
        const float ref = (kk < d.Kr && n < d.Nr) ? bfr(d.W[(size_t)kk * d.ldw + n]) : 0.f;
        chk(k.errs, 10, bf2f(d.WT[(size_t)n * d.ldt + kk]), ref, 1e-6f); }
    for (int i = k.gtid; i < 1024; i += k.NT) { const int row = hsh(i + 11) % MR, col = hsh(i + 13) % D;
        const float src = row < MPR ? inp(0)[(size_t)row * D + col] : inp(1)[(size_t)(row - MPR) * D + col];
        chk(k.errs, 11, bf2f(XB[(size_t)row * D + col]), bfr(src), 1e-6f);
        const int mr = hsh(i + 17) % 512; chk(k.errs, 11, bf2f(MEMB[(size_t)mr * D + col]), bfr(inp(2)[(size_t)mr * D + col]), 1e-6f);
        const size_t ci = hsh(i + 19) % (2u * DB * NMEM * MW); chk(k.errs, 11, bf2f(CMK[ci]), bfr(inp(10)[ci]), 1e-6f); chk(k.errs, 11, bf2f(CMV[ci]), bfr(inp(11)[ci]), 1e-6f); }
}
DI void ck_p1(const Ck& k, const Args& a, const bf16* XB, const bf16* Win, const bf16* PROJ, const float* LOW) {
    for (int i = k.gtid; i < 2048; i += k.NT) { const int row = (i & 7) ? hsh(i) % MR : MPR + hsh(i) % MSR, col = hsh(i + 5) % NIN;
        const float ref = naive_dot(XB + (size_t)row * D, Win + (size_t)col * D, D);
        chk(k.errs, 12, bf2f(PROJ[(size_t)row * NIN + col]), ref, 0.05f);
        if (col >= 1024 && col < 3072) { const int kv = col >= 2048, cc = col - 1024 - kv * 1024;
            const float o = row < MPR ? a.out[(kv ? O_SBVP : O_SBKP) + (size_t)row * SBW + cc] : a.out[(kv ? O_SBVS : O_SBKS) + (size_t)(row - MPR) * SBW + cc];
            chk(k.errs, 12, o, ref, 0.05f); } }
    for (int i = k.gtid; i < 1024; i += k.NT) { const int row = hsh(i + 3) % MR, j = i & 15; float s = 0.f;
        for (int c = 0; c < D; ++c) s += bf2f(XB[(size_t)row * D + c]) * bfr(inp(12)[(size_t)c * NIN_FULL + NIN + j]);
        chk(k.errs, 13, LOW[(size_t)row * 16 + j], s, 0.05f); }
}
DI void ck_sbp(const Ck& k, const Args& a, const bf16* PROJ, const bf16* ATT) {
    const int tl[12] = {0, 1, 2, 63, 64, 65, 255, 256, 1000, 2047, 3000, 4095};
    LAS float* zb = (LAS float*)k.lds;
    for (int i = k.bx; i < 24; i += k.G) { const int b = i & 1, h = (i * 3) & 7, t = tl[i % 12];
        const bf16* Q = PROJ + (size_t)(b * TP + t) * NIN + h * HD; const float bias = inp(13)[h];
        for (int s = k.tid; s < t; s += NTHREADS) { const float dot = naive_dot(Q, PROJ + (size_t)(b * TP + s) * NIN + SBW + h * HD, HD); zb[s] = (dot * 0.08838834764831845f + bias) * LOG2E; }
        __syncthreads();
        if (k.tid == 0) { float tail = 0.f; for (int s = t - 1; s >= 0; --s) { const float z = zb[s], l = lg2(1.f + ex2(z)); zb[s] = ex2(z - l - tail); tail += l; } }
        __syncthreads();
        if (k.tid < HD) { float o = 0.f; for (int s = 0; s < t; ++s) o += zb[s] * bf2f(PROJ[(size_t)(b * TP + s) * NIN + 2 * SBW + h * HD + k.tid]);
            chk(k.errs, 14, bf2f(ATT[(size_t)(b * TP + t) * D + h * HD + k.tid]), o, 0.02f); }
        __syncthreads(); }
}
DI void ck_sbs(const Ck& k, const Args& a, const bf16* PROJ, const bf16* ATT) {
    LAS float* zb = (LAS float*)k.lds; const int* pt = (const int*)inp(5);
    for (int i = k.bx; i < 16; i += k.G) { const int db = i & 7, h = (i * 5 + 1) & 7, q = (i * 3) & 7;
        const bf16* Q = PROJ + (size_t)(MPR + db * TS + q) * NIN + h * HD; const float bias = inp(13)[h]; const int nk = PAST + q;
        for (int s = k.tid; s < nk; s += NTHREADS) { float dot = 0.f;
            if (s < PAST) { const float* kr = inp(3) + ((size_t)pt[db * NPAGES + (s >> 7)] * PAGE + (s & 127)) * SBW + h * HD; for (int d = 0; d < HD; ++d) dot += bf2f(Q[d]) * bfr(kr[d]); }
            else dot = naive_dot(Q, PROJ + (size_t)(MPR + db * TS + (s - PAST)) * NIN + SBW + h * HD, HD);
            zb[s] = (dot * 0.08838834764831845f + bias) * LOG2E; }
        __syncthreads();
        if (k.tid == 0) { float tail = 0.f; for (int s = nk - 1; s >= 0; --s) { const float z = zb[s], l = lg2(1.f + ex2(z)); zb[s] = ex2(z - l - tail); tail += l; } }
        __syncthreads();
        if (k.tid < HD) { float o = 0.f;
            for (int s = 0; s < nk; ++s) { float v;
                if (s < PAST) v = bfr(inp(4)[((size_t)pt[db * NPAGES + (s >> 7)] * PAGE + (s & 127)) * SBW + h * HD + k.tid]); else v = bf2f(PROJ[(size_t)(MPR + db * TS + (s - PAST)) * NIN + 2 * SBW + h * HD + k.tid]);
                o += zb[s] * v; }
            chk(k.errs, 15, bf2f(ATT[(size_t)(MPR + db * TS + q) * D + h * HD + k.tid]), o, 0.02f); }
        __syncthreads(); }
}
DI void ck_gla(const Ck& k, const Args& a, const bf16* PROJ, const float* LOW, const float* GO) {
    const int wid = k.tid >> 6, lane = k.tid & 63; LAS float* sh = (LAS float*)k.lds + wid * 512;
    for (int i = k.bx * NWAVES + wid; i < 8; i += k.G * NWAVES) {
        int row0, T, h, dvg; float S[128]; const float* s_in = nullptr; const float* s_out;
        if (i < 4) { const int b = i & 1; h = (i * 3) & 3; dvg = (i + 1) & 3; row0 = b * TP; T = TP; s_out = a.out + O_GLAP + (size_t)(b * GH + h) * GDK * GDV; }
        else { const int db = (i * 3) & 7; h = i & 3; dvg = (i + 2) & 3; row0 = MPR + db * TS; T = TS; s_in = inp(6) + (size_t)(db * GH + h) * GDK * GDV; s_out = a.out + O_GLAS + (size_t)(db * GH + h) * GDK * GDV; }
        const int dv = dvg * 64 + lane;
#pragma unroll
        for (int c = 0; c < 128; ++c) S[c] = s_in ? s_in[(size_t)c * GDV + dv] : 0.f;
        for (int t = 0; t < T; ++t) { const size_t row = (size_t)(row0 + t);
#pragma unroll
            for (int cc = 0; cc < 2; ++cc) { const int c = lane + 64 * cc; float pre = inp(15)[h * GDK + c];
                for (int j = 0; j < 16; ++j) pre += LOW[row * 16 + j] * inp(14)[(size_t)j * GKW + h * GDK + c];
                sh[c] = expf(-softplusf_(-pre) * (1.f / 16.f)); sh[128 + c] = bf2f(PROJ[row * NIN + 3072 + h * GDK + c]) * 0.08838834764831845f; sh[256 + c] = bf2f(PROJ[row * NIN + 3584 + h * GDK + c]); }
            LDS_WAIT(); asm volatile("" ::: "memory");
            const float v = bf2f(PROJ[row * NIN + 4096 + h * GDV + dv]); float o = 0.f;
#pragma unroll
            for (int c = 0; c < 128; ++c) { S[c] = S[c] * sh[c] + sh[256 + c] * v; o += sh[128 + c] * S[c]; }
            LDS_WAIT(); asm volatile("" ::: "memory");
            chk(k.errs, 16, GO[row * GVW + h * GDV + dv], o, 1.0f); }
#pragma unroll
        for (int c = 0; c < 128; ++c) chk(k.errs, 17, s_out[(size_t)c * GDV + dv], S[c], 0.3f);
    }
}
DI void ck_gla_norm(const Ck& k, const Args& a, const bf16* PROJ, const float* GO, const bf16* ATT) {
    for (int i = k.gtid; i < 512; i += k.NT) { const int row = (i & 3) ? hsh(i) % MR : MPR + hsh(i) % MSR, h = i & 3, dv = hsh(i + 9) & 255; float ss = 0.f;
        for (int j = 0; j < GDV; ++j) { const float g = GO[(size_t)row * GVW + h * GDV + j]; ss += g * g; }
        const float ref = GO[(size_t)row * GVW + h * GDV + dv] / sqrtf(ss / GDV + GLA_EPS) * inp(16)[dv] * siluf_(bf2f(PROJ[(size_t)row * NIN + 5120 + h * GDV + dv]));
        chk(k.errs, 18, bf2f(ATT[(size_t)row * D + SBW + h * GDV + dv]), ref, 0.03f); }
}
template <class FA, class FG> DI void ck_gemm(const Ck& k, int id, int nrows_lo, int nrows, int N, int K, const bf16* Bt, FA fa, FG fg, float tol, unsigned salt) {
    for (int i = k.gtid; i < 1024; i += k.NT) { const int row = nrows_lo + hsh(i + salt) % nrows, col = hsh(i + salt + 99) % N;
        const float ref = naive_dot(fa(row, col), Bt + (size_t)col * K, K); chk(k.errs, id, fg(row, col, ref), 0.f, tol); }
}
DI void ck_ln(const Ck& k, int id, const bf16* HPRE, const float* gw, const float* gb, const bf16* of) {
    for (int i = k.gtid; i < 512; i += k.NT) { const int row = (i & 3) ? hsh(i + 1) % MR : MPR + hsh(i) % MSR, col = hsh(i + 2) % D; float s = 0.f, s2 = 0.f;
        for (int c = 0; c < D; ++c) s += bf2f(HPRE[(size_t)row * D + c]); const float mu = s / D;
        for (int c = 0; c < D; ++c) { const float d = bf2f(HPRE[(size_t)row * D + c]) - mu; s2 += d * d; }
        const float ref = (bf2f(HPRE[(size_t)row * D + col]) - mu) / sqrtf(s2 / D + LN_EPS) * gw[col] + gb[col];
        chk(k.errs, id, bf2f(of[(size_t)row * D + col]), ref, 0.03f); }
}
DI void ck_mem(const Ck& k, int id, const bf16* QM, const bf16* MEMKV, const bf16* CMK, const bf16* CMV, const bf16* OM, int L) {
    const int wid = k.tid >> 6, lane = k.tid & 63;
    for (int i = k.bx * NWAVES + wid; i < 64; i += k.G * NWAVES) { const int row = (i & 3) ? hsh(i + 31) % MR : MPR + hsh(i) % MSR, h = i & 3;
        const bf16 *Kp, *Vp; size_t ld;
        if (row < MPR) { Kp = MEMKV + (size_t)((row >> 12) * NMEM) * D + L * 1024 + h * HD; Vp = Kp + 512; ld = D; }
        else { const int db = (row - MPR) >> 3; Kp = CMK + (size_t)((L * DB + db) * NMEM) * MW + h * HD; Vp = CMV + (size_t)((L * DB + db) * NMEM) * MW + h * HD; ld = MW; }
        float s[4], mx = -1e30f;
        for (int j = 0; j < 4; ++j) { s[j] = naive_dot(QM + (size_t)row * MW + h * HD, Kp + (size_t)(lane + 64 * j) * ld, HD) * 0.08838834764831845f; mx = fmaxf(mx, s[j]); }
        for (int o = 1; o < 64; o <<= 1) mx = fmaxf(mx, __shfl_xor(mx, o));
        float den = 0.f; for (int j = 0; j < 4; ++j) { s[j] = expf(s[j] - mx); den += s[j]; } den = wave_sum(den);
        for (int d = 0; d < HD; ++d) { float acc = 0.f; for (int j = 0; j < 4; ++j) acc += bfr(s[j] / den) * bf2f(Vp[(size_t)(lane + 64 * j) * ld + d]); acc = wave_sum(acc);
            if (lane == 0) chk(k.errs, id, bf2f(OM[(size_t)row * MW + h * HD + d]), acc, 0.02f); } }
}
DI void ck_conv(const Ck& k, int id, const Args& a, const bf16* U, const bf16* ACT, int L) {
    for (int i = k.gtid; i < 2048; i += k.NT) { int row = (i & 3) ? hsh(i + 41) % MR : MPR + hsh(i) % MSR; if ((i & 15) == 5) row = (i & 16) ? TP : 1; const int c = hsh(i + 43) % FF;
        int t, sq; if (row < MPR) { t = row & (TP - 1); sq = -1; } else { t = (row - MPR) & 7; sq = (row - MPR) >> 3; }
        float cv[2];
        for (int half = 0; half < 2; ++half) { const int cc = c + half * FF; float acc = inp(39)[(size_t)L * F2 + cc];
            for (int tap = 0; tap < 3; ++tap) { const int ts = t - 2 + tap; float x = 0.f;
                if (ts >= 0) x = bf2f(U[(size_t)(row - 2 + tap) * F2 + cc]); else if (sq >= 0) x = inp(9)[((size_t)(L * DB + sq) * 2 + (ts + 2)) * F2 + cc];
                acc += inp(38)[((size_t)L * 3 + tap) * F2 + cc] * x; }
            cv[half] = acc; }
        chk(k.errs, id, bf2f(ACT[(size_t)row * FF + c]), siluf_(cv[1]) * cv[0], 0.03f); }
}
DI void ck_mix(const Ck& k, const Args& a, const bf16* XB, const bf16* MIX) {
    for (int i = k.gtid; i < 2048; i += k.NT) { int row = (i & 3) ? hsh(i + 51) % MR : MPR + hsh(i) % MSR; if ((i & 15) == 5) row = (i & 16) ? TP : 0; const int c = hsh(i + 53) % D, m = i % 6;
        int t, sq; if (row < MPR) { t = row & (TP - 1); sq = -1; } else { t = (row - MPR) & 7; sq = (row - MPR) >> 3; }
        const float x = bf2f(XB[(size_t)row * D + c]); const float xp = t > 0 ? bf2f(XB[(size_t)(row - 1) * D + c]) : (sq >= 0 ? inp(8)[(size_t)sq * D + c] : 0.f);
        chk(k.errs, 28, bf2f(MIX[((size_t)m * M + row) * D + c]), x + (xp - x) * inp(18)[(size_t)m * D + c], 0.02f); }
}
DI void ck_rwkv(const Ck& k, const Args& a, const bf16* PROJ, const float* L2, const float* Y, const float* BON) {
    const int wid = k.tid >> 6, lane = k.tid & 63; LAS float* sh = (LAS float*)k.lds + wid * 512;
    for (int i = k.bx * NWAVES + wid; i < 8; i += k.G * NWAVES) {
        int row0, T, h; const float* s_in = nullptr; const float* s_out;
        if (i < 3) { const int b = i & 1; h = (i * 11 + 5) & 31; row0 = b * TP; T = TP; s_out = a.out + O_RWP + (size_t)(b * RWH + h) * 4096; }
        else { const int db = (i * 3) & 7; h = (i * 7 + 2) & 31; row0 = MPR + db * TS; T = TS; s_in = inp(7) + (size_t)(db * RWH + h) * 4096; s_out = a.out + O_RWS + (size_t)(db * RWH + h) * 4096; }
        const int hc = h * 64 + lane; float S[64];
#pragma unroll
        for (int c = 0; c < 64; ++c) S[c] = s_in ? s_in[(size_t)lane * 64 + c] : 0.f;
        for (int t = 0; t < T; ++t) { const size_t row = (size_t)(row0 + t);
            const float r = bf2f(PROJ[row * NIN + hc]), kx = bf2f(PROJ[row * NIN + 2048 + hc]), v = bf2f(PROJ[row * NIN + 4096 + hc]);
            const float wpre = L2[row * 6144 + hc] + inp(20)[hc], apre = L2[row * 6144 + 2048 + hc] + inp(23)[hc];
            const float wlog = -logf(1.f + expf(-wpre)) - 0.5f, dec = expf(-expf(wlog)), aa = 1.f / (1.f + expf(-apre));
            float kk = kx * inp(28)[hc]; const float n2 = wave_sum(kk * kk); kk = kk / sqrtf(fmaxf(n2, 1e-24f));
            const float k2 = kx * (1.f + (aa - 1.f) * inp(29)[hc]);
            sh[lane] = dec; sh[64 + lane] = kk; sh[128 + lane] = kk * aa; sh[192 + lane] = k2; sh[256 + lane] = r;
            const float bon = wave_sum(r * k2 * inp(30)[hc]) * v;
            LDS_WAIT(); asm volatile("" ::: "memory");
            float sa = 0.f;
#pragma unroll
            for (int c = 0; c < 64; ++c) sa -= S[c] * sh[64 + c];
            float y = 0.f;
#pragma unroll
            for (int c = 0; c < 64; ++c) { S[c] = S[c] * sh[c] + sa * sh[128 + c] + v * sh[192 + c]; y += S[c] * sh[256 + c]; }
            LDS_WAIT(); asm volatile("" ::: "memory");
            chk(k.errs, 31, Y[row * D + hc], y, 0.05f); chk(k.errs, 33, BON[row * D + hc], bon, 0.02f); }
#pragma unroll
        for (int c = 0; c < 64; ++c) chk(k.errs, 32, s_out[(size_t)lane * 64 + c], S[c], 0.05f);
    }
}
DI void ck_post(const Ck& k, const Args& a, const float* Y, const float* BON, const float* G, const bf16* ATT) {
    for (int i = k.gtid; i < 1024; i += k.NT) { const int row = (i & 3) ? hsh(i + 61) % MR : MPR + hsh(i) % MSR, h = hsh(i + 63) & 31, c = hsh(i + 67) & 63; float s = 0.f, s2 = 0.f;
        for (int j = 0; j < 64; ++j) s += Y[(size_t)row * D + h * 64 + j]; const float mu = s / 64.f;
        for (int j = 0; j < 64; ++j) { const float d = Y[(size_t)row * D + h * 64 + j] - mu; s2 += d * d; }
        const size_t o = (size_t)row * D + h * 64 + c;
        const float ref = ((Y[o] - mu) / sqrtf(s2 / 64.f + RW_LN_EPS) * inp(31)[h * 64 + c] + inp(32)[h * 64 + c] + BON[o]) * G[(size_t)row * 6144 + h * 64 + c];
        chk(k.errs, 34, bf2f(ATT[o]), ref, 0.03f); }
}
#endif
#define PG8_SP2 true
#define PG8_ALIGN true
__global__ void __launch_bounds__(NTHREADS, 2) fwd(Args a) {
    LAS unsigned char* ldsu = (LAS unsigned char*)lds_raw; LAS char* lds = (LAS char*)lds_raw;
    const int wave0 = __builtin_amdgcn_readfirstlane((int)threadIdx.x >> 6);
    const int G = gridDim.x, bx = blockIdx.x, NGW = G * NWAVES, NT = G * NTHREADS;
#define PHV unsigned char* ws = ws_top; float* out = out_top; asm volatile("" : "+s"(ws), "+s"(out)); int tid = wave0 * 64 + lane_id(); const int lane = tid & 63, wave = __builtin_amdgcn_readfirstlane(tid >> 6), gw = bx * NWAVES + wave, gtid = bx * NTHREADS + tid; (void)lane; (void)gw; (void)gtid; (void)ws; (void)out
    volatile LAS unsigned* MISC = (volatile LAS unsigned*)(ldsu + MISC_OFF);
    if (threadIdx.x < 64) MISC[threadIdx.x] = 0u;
    if (threadIdx.x == 0) { volatile LAS unsigned long long* P = (volatile LAS unsigned long long*)(ldsu + PTRS_OFF);
#pragma unroll
        for (int i = 0; i < 43; ++i) P[i] = (unsigned long long)a.in[i]; }
    __syncthreads();
    unsigned char* const ws_top = a.ws; unsigned* ctl = (unsigned*)(ws_top + WS_CTL);
    XcdBarrier bar; bar.bar = ctl + CW_BAR; bar.x = 0; bar.st = nullptr;
    if (a.fused) bar = xcd_barrier_post(ctl + CW_BAR, MISC + 8);
    const int lo = a.ph_lo, hi = a.ph_hi;
#ifndef MK_REP_LO
#define MK_REP_LO 1000
#define MK_REP_HI 1000
#endif
#define REPL(k) for (int rep_ = ((k) >= MK_REP_LO && (k) < MK_REP_HI) ? 2 : 1; rep_ > 0; --rep_)
#ifndef MK_ONLY
#define MK_ONLY -1
#endif
#define IN(k) ((MK_ONLY < 0 || (k) == MK_ONLY) && lo <= (k) && (k) < hi)
#define INL(kb) ((MK_ONLY < 0 || (kb) == MK_ONLY) && lo <= (kb) + pb && (kb) + pb < hi)
#ifdef MK_TIME_A
#define STAMP(k) do { if (bx == 0 && threadIdx.x == 0) ctl[CW_ERR + 128 + (k)] = (unsigned)__builtin_amdgcn_s_memrealtime(); } while (0)
#else
#define STAMP(k) do { } while (0)
#endif
#define SEAM(k) do { if (lo <= (k) && (k) + 1 < hi) xcd_barrier(bar); STAMP((k) + 1); } while (0)
#define W_in ((bf16*)(ws + WS_WIN))
#define W_out ((bf16*)(ws + WS_WOUT))
#define W_rkv ((bf16*)(ws + WS_WRKV))
#define W_l2 ((bf16*)(ws + WS_WL2))
#define W_o ((bf16*)(ws + WS_WO))
#define W_q ((bf16*)(ws + WS_WQ))
#define W_kv ((bf16*)(ws + WS_WKV))
#define W_co ((bf16*)(ws + WS_WCO))
#define W_up ((bf16*)(ws + WS_WUP))
#define W_dn ((bf16*)(ws + WS_WDN))
#define W_low ((bf16*)(ws + WS_WLOW))
#define XB ((bf16*)(ws + WS_XB))
#define HPRE ((bf16*)(ws + WS_HPRE))
#define PROJ ((bf16*)(ws + WS_PROJ))
#define ATT ((bf16*)(ws + WS_ATT))
#define QM ((bf16*)(ws + WS_QM))
#define OM ((bf16*)(ws + WS_OM))
#define MEMB ((bf16*)(ws + WS_MEMB))
#define MEMKV ((bf16*)(ws + WS_MEMKV))
#define CMK ((bf16*)(ws + WS_CMK))
#define CMV ((bf16*)(ws + WS_CMV))
#define U ((bf16*)(ws + WS_U))
#define ACT ((bf16*)(ws + WS_ACT))
#define MIX ((bf16*)(ws + WS_MIX))
#define L1 ((bf16*)(ws + WS_L1))
#define L2 ((float*)(ws + WS_L2))
#define Y ((float*)(ws + WS_Y))
#define PREP ((float*)(ws + WS_PREP))
#define BON ((float*)(ws + WS_BON))
#define LOW ((float*)(ws + WS_LOW))
#define DST ((float*)(ws + WS_DST))
#define DEC ((float*)(ws + WS_DEC))
#define GO ((float*)(ws + WS_GO))
#define SIN ((bf16*)(ws + WS_SIN))
#define QDg ((bf16*)(ws + WS_QD))
#define PO ((float*)(ws + WS_PO))
#define PL ((float*)(ws + WS_PL))
    float* const out_top = a.out;
#if MK_CHECK
#define CK(k, stmt) do { if (IN(100 + (k))) { PHV; Ck ck{ctl + CW_ERR, gtid, NT, tid, bx, G, lds}; stmt; } } while (0)
#else
#define CK(k, stmt) do { } while (0)
#endif

    STAMP(0);
#define CONV_SLOT(DSC, LO, HI, FIRST) do { if (bx >= (FIRST)) { const TrDesc td_ = make_desc(ws, (DSC)); LAS float* scr_ = (LAS float*)(lds + wave * 16384); \
        const int hi_ = (HI) < 0 ? tr_items(DSC) : (HI); for (int it_ = (LO) + (bx - (FIRST)) * NWAVES + wave; it_ < hi_; it_ += (G - (FIRST)) * NWAVES) tr_item(td_, scr_, it_, lane); } } while (0)
    REPL(0) if (IN(0)) { PHV;
        LAS float* scr = (LAS float*)(lds + wave * 16384);
        { int base = 0;
            for (int d = 0; d < NTR; ++d) { if ((d >= 3 && d <= 12) || d == 14 || d == 18 || d == 20 || d == 22) continue;
                const int ni = tr_items(d); const TrDesc td = make_desc(ws, d);
                for (int it = gw; it < ni; it += NGW) tr_item(td, scr, it, lane);
                base += ni; } }
        for (int row = gw; row < MR; row += NGW) row_to_bf16(row < MPR ? inp(0) + (size_t)row * D : inp(1) + (size_t)(row - MPR) * D, XB + (size_t)row * D, nullptr, lane);
        for (int row = gw; row < 512; row += NGW) row_to_bf16(inp(2) + (size_t)row * D, MEMB + (size_t)row * D, nullptr, lane);
        for (int i = gtid; i < 2 * DB * NMEM * MW / 8; i += NT) { const f32x4 k0 = *(const GAS f32x4*)(inp(10) + (size_t)i * 8), k1 = *(const GAS f32x4*)(inp(10) + (size_t)i * 8 + 4);
            const f32x4 v0 = *(const GAS f32x4*)(inp(11) + (size_t)i * 8), v1 = *(const GAS f32x4*)(inp(11) + (size_t)i * 8 + 4);
            u32x4 wk = {pk2(k0.x, k0.y), pk2(k0.z, k0.w), pk2(k1.x, k1.y), pk2(k1.z, k1.w)}, wv = {pk2(v0.x, v0.y), pk2(v0.z, v0.w), pk2(v1.x, v1.y), pk2(v1.z, v1.w)};
            *(GAS u32x4*)(CMK + (size_t)i * 8) = wk; *(GAS u32x4*)(CMV + (size_t)i * 8) = wv; }
    }
    SEAM(0);
    CK(0, ck_p0(ck, a, XB, MEMB, CMK, CMV));

    for (int L = 0; L < 2; ++L) {
        const int pb = 16 * L;
        if (L == 0) {
            REPL(1) if (IN(1)) { PHV;
                pg8::Gemm g{XB, W_in, MPR, NIN, D, D}; pg8::StaticOrder S; S.init(MPR, NIN, G, bx);
                pg8::Epi8<FInProj> E{FInProj{PROJ, out}};
                pg8::gemm_phase<pg8::Epi8<FInProj>, pg8::StaticOrder, PG8_ALIGN, PG8_SP2>(ldsu, g, S, E, tid);
                skinny_gemm(lds, XB, D, W_in, NIN, D, S, E.f, G, bx, tid);
                if ((gw & 3) == 0) for (int t = gw >> 2; t < MR / 16; t += NGW >> 2) low_task(XB, W_low, LOW, t, lane);
            }
            SEAM(1);
            CK(1, ck_p1(ck, a, XB, W_in, PROJ, LOW));
            REPL(2) if (IN(2)) { PHV;
                const int half = G / 2;
#ifndef MK_REP_SBP
#define MK_REP_SBP 1
#endif
#ifndef MK_REP_G1
#define MK_REP_G1 1
#endif
                if (bx < half) { for (int rp = 0; rp < MK_REP_SBP; ++rp) for (int p = bx; p < 128; p += half) { const int bh = p >> 3, s = p & 7;
                        sbp_unit(lds, PROJ, ATT, inp(13)[bh & 7], bh >> 3, bh & 7, s, tid); sbp_unit(lds, PROJ, ATT, inp(13)[bh & 7], bh >> 3, bh & 7, 15 - s, tid); } }
                else { for (int rp = 0; rp < MK_REP_G1; ++rp) for (int u = bx - half; u < NUNITS_G; u += G - half) gla_g1(lds, u, PROJ, LOW, inp(14), inp(15), DST, DEC, GO, QDg, tid); }
                { const float* cK = inp(3); const float* cV = inp(4); const int* pt = (const int*)inp(5); const float* sbb = inp(13);
                  for (;;) { int idx = 0; if (lane == 0) idx = (int)atomicAdd(ctl + CW_Q, 1u); idx = __builtin_amdgcn_readfirstlane(idx); if (idx >= DB * NPAGES * SBH) break;
                      int ln = lane; asm volatile("" : "+v"(ln));
                      sbs_unit(lds + wave * 8192, PROJ, cK, cV, pt, sbb[idx & 7], PO, PL, idx >> 10, (idx >> 3) & 127, idx & 7, ln); } }
            }
            SEAM(2);
            REPL(3) if (IN(3)) { PHV;
                gla_g2(DST, DEC, SIN, inp(6), out + O_GLAP, out + O_GLAS, gtid, NT);
                if ((gw & 3) == 0) for (int i = gw >> 2; i < DB * SBH * TS; i += NGW >> 2) sbs_combine(PROJ, PO, PL, inp(13)[(i >> 3) & 7], ATT, i >> 6, (i >> 3) & 7, i & 7, lane);
            }
            SEAM(3);
            CK(3, ck_sbp(ck, a, PROJ, ATT)); CK(3, ck_sbs(ck, a, PROJ, ATT));
            REPL(4) if (IN(4)) { PHV; for (int u = bx; u < NUNITS_G; u += G) gla_g3(lds, u, PROJ, QDg, SIN, GO, inp(16), ATT, tid); }
            SEAM(4);
            CK(4, ck_gla(ck, a, PROJ, LOW, GO)); CK(4, ck_gla_norm(ck, a, PROJ, GO, ATT));
        } else {
            REPL(15) if (IN(15)) { PHV; rwkv_mix(XB, inp(18), inp(8), MIX, out + O_SHP, out + O_SHS, gtid, NT); }
            SEAM(15);
            CK(15, ck_mix(ck, a, XB, MIX));
            REPL(16) if (IN(16)) { PHV;
                pg8::Gemm g{MIX, W_rkv, MPR, 6912, D, D}; RkvOrder S; S.init(MPR, 6912, G, bx);
                pg8::Epi8<FRkv> E{FRkv{PROJ, L1}};
                pg8::gemm_phase<pg8::Epi8<FRkv>, RkvOrder, PG8_ALIGN, PG8_SP2>(ldsu, g, S, E, tid);
                skinny_gemm(lds, MIX, D, W_rkv, 6912, D, S, E.f, G, bx, tid);
                CONV_SLOT(20, 4400, -1, S.nwg % G);
            }
            SEAM(16);
            CK(16, ck_gemm(ck, 29, 0, MR, 6912, D, W_rkv, [&](int r, int c) { const int pn = c >> 8; const int idx = pn < 8 ? 0 : pn < 16 ? 2 : pn < 24 ? 3 : pn == 24 ? 1 : pn == 25 ? 4 : 5; return (const bf16*)(MIX + ((size_t)idx * M + r) * D); },
                [&](int r, int c, float ref) { const int pn = c >> 8; if (pn < 24) return bf2f(PROJ[(size_t)r * NIN + c]) - ref; const float x = pn == 24 ? tanhf(ref) : pn == 26 ? 1.f / (1.f + expf(-ref)) : ref; return bf2f(L1[(size_t)r * 768 + c - NIN]) - x; }, 0.05f, 160));
            REPL(17) if (IN(17)) { PHV;
                pg8::Gemm g{L1, W_l2, MPR, 6144, 256, 768}; L2Order S; S.init(MPR, 6144, G, bx);
                pg8::Epi4<FL2> E{FL2{L2}};
                pg8::gemm_phase<pg8::Epi4<FL2>, L2Order, PG8_ALIGN, PG8_SP2>(ldsu, g, S, E, tid);
                skinny_gemm(lds, L1, 768, W_l2, 6144, 256, S, E.f, G, bx, tid);
            }
            SEAM(17);
            CK(17, ck_gemm(ck, 30, 0, MR, 6144, 256, W_l2, [&](int r, int c) { return (const bf16*)(L1 + (size_t)r * 768 + (c >> 11) * 256); },
                [&](int r, int c, float ref) { return L2[(size_t)r * 6144 + c] - ref; }, 0.05f, 170));
            REPL(18) if (IN(18)) { PHV; rwkv_prep(PROJ, L2, inp(20), inp(23), inp(28), inp(29), inp(30), PREP, BON, gw, NGW, lane); }
            SEAM(18);
            REPL(19) if (IN(19)) { PHV; const RwC R{PREP, inp(7), Y, out + O_RWP, out + O_RWS};
                for (int u = bx; u < 256 + DB * RWH * 4; u += G) rwkv_unit(lds, u, R, tid); }
            SEAM(19);
            CK(19, ck_rwkv(ck, a, PROJ, L2, Y, BON));
            REPL(20) if (IN(20)) { PHV; rwkv_post(Y, BON, L2 + 4096, inp(31), inp(32), ATT, gw, NGW, lane); }
            SEAM(20);
            CK(20, ck_post(ck, a, Y, BON, L2 + 4096, ATT));
        }
        REPL(5 + pb) if (INL(5)) { PHV;
            pg8::Gemm g{ATT, L == 0 ? W_out : W_o, MPR, D, D, D}; pg8::StaticOrder S; S.init(MPR, D, G, bx);
            pg8::Epi8<FResid> E{FResid{XB, HPRE}};
            pg8::gemm_phase<pg8::Epi8<FResid>, pg8::StaticOrder, PG8_ALIGN, PG8_SP2>(ldsu, g, S, E, tid);
            skinny_gemm(lds, ATT, D, L == 0 ? W_out : W_o, D, D, S, E.f, G, bx, tid);
        }
        SEAM(5 + pb);
        CK(5 + pb, ck_gemm(ck, 19, 0, MR, D, D, L == 0 ? W_out : W_o, [&](int r, int) { return (const bf16*)(ATT + (size_t)r * D); },
            [&](int r, int c, float ref) { return bf2f(HPRE[(size_t)r * D + c]) - (ALPHA * bf2f(XB[(size_t)r * D + c]) + ref); }, 0.05f, 50));
        const float* lnw = inp(41) + (size_t)L * 3 * D; const float* lnb = inp(42) + (size_t)L * 3 * D;
        REPL(6 + pb) if (INL(6)) { PHV; ln_rows(HPRE, lnw, lnb, nullptr, nullptr, XB, gw, NGW, lane); }
        SEAM(6 + pb);
        CK(6 + pb, ck_ln(ck, 20, HPRE, lnw, lnb, XB));
        REPL(7 + pb) if (INL(7)) { PHV;
            { pg8::Gemm g{XB, W_q + (size_t)L * MW * D, MPR, MW, D, D}; pg8::StaticOrder S; S.init(MPR, MW, G, bx);
              pg8::Epi8<FBf16> E{FBf16{QM, MW}};
              pg8::gemm_phase<pg8::Epi8<FBf16>, pg8::StaticOrder, PG8_ALIGN, PG8_SP2>(ldsu, g, S, E, tid);
              skinny_gemm(lds, XB, D, W_q + (size_t)L * MW * D, MW, D, S, E.f, G, bx, tid); }
            if (L == 0) { pg8::Gemm g{MEMB, W_kv, 512, D, D, D}; pg8::StaticOrder S; S.init(512, D, G, (bx + G - 80) % G);
              pg8::Epi8<FMemKV> E{FMemKV{MEMKV, out}};
              pg8::gemm_phase<pg8::Epi8<FMemKV>, pg8::StaticOrder, PG8_ALIGN, PG8_SP2>(ldsu, g, S, E, tid); }
            { const int first = (G > 96) ? 96 : 0;
              if (L == 0) { for (int d = 3; d <= 12; ++d) CONV_SLOT(d, 0, -1, first); }
              else CONV_SLOT(22, 0, -1, first); }
        }
        SEAM(7 + pb);
        CK(7 + pb, ck_gemm(ck, 21, 0, MR, MW, D, W_q + (size_t)L * MW * D, [&](int r, int) { return (const bf16*)(XB + (size_t)r * D); }, [&](int r, int c, float ref) { return bf2f(QM[(size_t)r * MW + c]) - ref; }, 0.05f, 70));
        CK(7 + pb, ck_gemm(ck, 22, 0, 512, D, D, W_kv, [&](int r, int) { return (const bf16*)(MEMB + (size_t)r * D); },
            [&](int r, int c, float ref) { const float e1 = fabsf(bf2f(MEMKV[(size_t)r * D + c]) - ref); const int layer = c >> 10, kv = (c >> 9) & 1, cc = c & 511; const float e2 = fabsf(out[(kv ? O_MVP : O_MKP) + ((size_t)layer * 512 + r) * MW + cc] - ref); return e1 + e2; }, 0.05f, 75));
        REPL(8 + pb) if (INL(8)) { PHV;
            LAS float* xch = (LAS float*)(lds + XCH_OFF + wave * 256);
            for (int i = bx; i < 128 + DB * MH; i += G) {
                if (i < 128) { const int rt = i >> 2, h = i & 3, b = rt >> 4;
                    mem_unit(lds, xch, QM + (size_t)rt * 256 * MW + h * HD, MW, 256, MEMKV + (size_t)b * NMEM * D + L * 1024 + h * HD, MEMKV + (size_t)b * NMEM * D + L * 1024 + 512 + h * HD, D, OM + (size_t)rt * 256 * MW + h * HD, MW, tid); }
                else { const int su = i - 128, db = su >> 2, h = su & 3; const size_t kb = (size_t)((L * DB + db) * NMEM) * MW + h * HD;
                    mem_unit(lds, xch, QM + (size_t)(MPR + db * TS) * MW + h * HD, MW, TS, CMK + kb, CMV + kb, MW, OM + (size_t)(MPR + db * TS) * MW + h * HD, MW, tid); } }
        }
        SEAM(8 + pb);
        CK(8 + pb, ck_mem(ck, 23, QM, MEMKV, CMK, CMV, OM, L));
        REPL(9 + pb) if (INL(9)) { PHV;
            pg8::Gemm g{OM, W_co + (size_t)L * D * MW, MPR, D, MW, MW}; pg8::StaticOrder S; S.init(MPR, D, G, bx);
            pg8::Epi8<FResid> E{FResid{XB, HPRE}};
            pg8::gemm_phase<pg8::Epi8<FResid>, pg8::StaticOrder, PG8_ALIGN, PG8_SP2>(ldsu, g, S, E, tid);
            skinny_gemm(lds, OM, MW, W_co + (size_t)L * D * MW, D, MW, S, E.f, G, bx, tid);
        }
        SEAM(9 + pb);
        CK(9 + pb, ck_gemm(ck, 24, 0, MR, D, MW, W_co + (size_t)L * D * MW, [&](int r, int) { return (const bf16*)(OM + (size_t)r * MW); },
            [&](int r, int c, float ref) { return bf2f(HPRE[(size_t)r * D + c]) - (ALPHA * bf2f(XB[(size_t)r * D + c]) + ref); }, 0.05f, 90));
        REPL(10 + pb) if (INL(10)) { PHV; ln_rows(HPRE, lnw + D, lnb + D, nullptr, nullptr, XB, gw, NGW, lane); }
        SEAM(10 + pb);
        CK(10 + pb, ck_ln(ck, 20, HPRE, lnw + D, lnb + D, XB));
        REPL(11 + pb) if (INL(11)) { PHV;
            pg8::Gemm g{XB, W_up + (size_t)L * F2 * D, MPR, F2, D, D}; pg8::StaticOrder S; S.init(MPR, F2, G, bx);
            pg8::Epi8<FUp> E{FUp{U, out, L}};
            pg8::gemm_phase<pg8::Epi8<FUp>, pg8::StaticOrder, PG8_ALIGN, PG8_SP2>(ldsu, g, S, E, tid);
            skinny_gemm(lds, XB, D, W_up + (size_t)L * F2 * D, F2, D, S, E.f, G, bx, tid);
            if (L == 0) { const int first = S.nwg % G;
                CONV_SLOT(14, 0, -1, first); CONV_SLOT(18, 0, -1, first); CONV_SLOT(20, 0, 4400, first); }
        }
        SEAM(11 + pb);
        CK(11 + pb, ck_gemm(ck, 25, 0, MR, F2, D, W_up + (size_t)L * F2 * D, [&](int r, int) { return (const bf16*)(XB + (size_t)r * D); }, [&](int r, int c, float ref) { return bf2f(U[(size_t)r * F2 + c]) - ref; }, 0.05f, 110));
        REPL(12 + pb) if (INL(12)) { PHV; conv_gate(U, inp(38) + (size_t)L * 3 * F2, inp(39) + (size_t)L * F2, inp(9) + (size_t)L * DB * 2 * F2, ACT, gtid, NT); }
        SEAM(12 + pb);
        CK(12 + pb, ck_conv(ck, 26, a, U, ACT, L));
        REPL(13 + pb) if (INL(13)) { PHV;
            pg8::Gemm g{ACT, W_dn + (size_t)L * D * FF, MPR, D, FF, FF}; pg8::StaticOrder S; S.init(MPR, D, G, bx);
            pg8::Epi8<FResid> E{FResid{XB, HPRE}};
            pg8::gemm_phase<pg8::Epi8<FResid>, pg8::StaticOrder, PG8_ALIGN, PG8_SP2>(ldsu, g, S, E, tid);
            skinny_gemm(lds, ACT, FF, W_dn + (size_t)L * D * FF, D, FF, S, E.f, G, bx, tid);
        }
        SEAM(13 + pb);
        CK(13 + pb, ck_gemm(ck, 27, 0, MR, D, FF, W_dn + (size_t)L * D * FF, [&](int r, int) { return (const bf16*)(ACT + (size_t)r * FF); },
            [&](int r, int c, float ref) { return bf2f(HPRE[(size_t)r * D + c]) - (ALPHA * bf2f(XB[(size_t)r * D + c]) + ref); }, 0.05f, 130));
        REPL(14 + pb) if (INL(14)) { PHV;
            if (L == 0) ln_rows(HPRE, lnw + 2 * D, lnb + 2 * D, nullptr, nullptr, XB, gw, NGW, lane);
            else ln_rows(HPRE, lnw + 2 * D, lnb + 2 * D, out + O_YP, out + O_YS, nullptr, gw, NGW, lane);
        }
        SEAM(14 + pb);
    }
#ifdef MK_TIME_A
    xcd_barrier(bar);
    { const unsigned ta = ctl[CW_ERR + 128 + MK_TIME_A], tb = ctl[CW_ERR + 128 + MK_TIME_B]; const float us = (float)(tb - ta) * 0.01f; const float c = sqrtf(fmaxf(us, 1e-3f));
      for (size_t i = (size_t)bx * NTHREADS + threadIdx.x; i < (size_t)MPR * D; i += NT) out_top[O_YP + i] = c; }
#endif
#if MK_CHECK
    REPL(200) if (IN(200)) { PHV; if (gtid == 0) { unsigned code = 0; float mag = 0.f;
            for (int id = 10; id < 64; ++id) { const float e = __uint_as_float(ctl[CW_ERR + id]); if (e > 1.f && code == 0) { code = id; mag = e; } }
#ifdef MK_REPORT
            code = 1000; mag = __uint_as_float(ctl[CW_ERR + MK_REPORT]);
#endif
            ctl[CW_ERR + 100] = code; ctl[CW_ERR + 101] = __float_as_uint(mag); } }
    REPL(201) if (IN(201)) { PHV; const unsigned code = ctl[CW_ERR + 100]; const float mag = __uint_as_float(ctl[CW_ERR + 101]);
        if (code) { int ex = 4; float m = mag; while (m >= 10.f && ex < 30) { m *= 0.1f; ++ex; }
            float c2 = (float)code; for (int i = 0; i < ex; ++i) c2 *= 10.f; if (code == 1000) c2 = fmaxf(mag, 1e-5f) * 1e6f; const float c = sqrtf(c2);
            for (size_t i = gtid; i < (size_t)MPR * D; i += NT) out[O_YP + i] = c; } }
#endif
#undef IN
#undef CONV_SLOT
#undef W_in
#undef W_out
#undef W_rkv
#undef W_l2
#undef W_o
#undef W_q
#undef W_kv
#undef W_co
#undef W_up
#undef W_dn
#undef W_low
#undef XB
#undef HPRE
#undef PROJ
#undef ATT
#undef QM
#undef OM
#undef MEMB
#undef MEMKV
#undef CMK
#undef CMV
#undef U
#undef ACT
#undef MIX
#undef L1
#undef L2
#undef Y
#undef PREP
#undef BON
#undef LOW
#undef DST
#undef DEC
#undef GO
#undef SIN
#undef QDg
#undef PO
#undef PL
#undef PHV
#undef INL
#undef SEAM
#undef CK
}
#ifndef MK_FUSED
#define MK_FUSED 0
#endif
extern "C" void kernel_launch(void* const* d_in, const int* in_sizes, int n_in, void* d_out, int out_size, void* d_ws, size_t ws_size, hipStream_t stream) {
    static int grid = 0;
    if (grid == 0) {
        if (n_in != 43 || (size_t)out_size != O_END || ws_size < WS_TOTAL) { fprintf(stderr, "kernel_launch: unexpected problem shape (n_in %d, out %d, ws %zu); nothing launched\n", n_in, out_size, ws_size); grid = -1; return; }
        int dev = 0, cus = 0;
        if (hipGetDevice(&dev) != hipSuccess || hipDeviceGetAttribute(&cus, hipDeviceAttributeMultiprocessorCount, dev) != hipSuccess) { grid = -1; return; }
        if (hipFuncSetAttribute((const void*)fwd, hipFuncAttributeMaxDynamicSharedMemorySize, LDS_BYTES) != hipSuccess) { fprintf(stderr, "kernel_launch: hipFuncSetAttribute failed\n"); grid = -1; return; }
        int per_cu = 0;
        if (hipOccupancyMaxActiveBlocksPerMultiprocessor(&per_cu, (const void*)fwd, NTHREADS, LDS_BYTES) != hipSuccess || per_cu < 1) fprintf(stderr, "kernel_launch: occupancy query reports %d blocks per CU\n", per_cu);
        (void)hipGetLastError();
        grid = cus;
    }
    if (grid < 0) return;
    (void)hipMemsetAsync((char*)d_ws + WS_CTL, 0, CTL_ZERO_BYTES, stream);
    Args a{};
    for (int i = 0; i < 43; ++i) a.in[i] = (const float*)d_in[i];
    a.out = (float*)d_out; a.ws = (unsigned char*)d_ws;
#if MK_FUSED
    a.ph_lo = 0; a.ph_hi = NPH; a.fused = 1;
    hipLaunchKernelGGL(fwd, dim3(grid), dim3(NTHREADS), LDS_BYTES, stream, a);
#else
    a.fused = 0;
    for (int k = 0; k < NPH; ++k) {
        a.ph_lo = k; a.ph_hi = k + 1; hipLaunchKernelGGL(fwd, dim3(grid), dim3(NTHREADS), LDS_BYTES, stream, a);
#if MK_CHECK
        a.ph_lo = 100 + k; a.ph_hi = 101 + k; hipLaunchKernelGGL(fwd, dim3(grid), dim3(NTHREADS), LDS_BYTES, stream, a);
#endif
    }
#if MK_CHECK
    a.ph_lo = 200; a.ph_hi = 201; hipLaunchKernelGGL(fwd, dim3(grid), dim3(NTHREADS), LDS_BYTES, stream, a);
    a.ph_lo = 201; a.ph_hi = 202; hipLaunchKernelGGL(fwd, dim3(grid), dim3(NTHREADS), LDS_BYTES, stream, a);
#endif
#endif
    const hipError_t le = hipPeekAtLastError();
    if (le != hipSuccess) fprintf(stderr, "kernel_launch: launch failed: %s\n", hipGetErrorName(le));
}
```
